# Optimizing an MI355X kernel written in HIP

```python
import math
import jax, jax.numpy as jnp
from jax import lax
import numpy as np

D_MODEL = 1024
BATCH = 4
SEQ = 8192
DEPTH = 2

S5_GROUP = 16
S5_GROUPS = 24
S5_WIDTH = S5_GROUP * S5_GROUPS
S5_STATE = 64
M2_HEADDIM = 64
M2_INNER = 512
M2_HEADS = M2_INNER // M2_HEADDIM
M2_GROUPS = 2
M2_STATE = 128
M2_CONV = 4
M2_CHUNK = 128
M2_CONV_DIM = M2_INNER + 2 * M2_GROUPS * M2_STATE
MLA_HEADS = 8
MLA_Q_RANK = 256
MLA_KV_RANK = 128
MLA_NOPE = 64
MLA_ROPE = 32
MLA_V = 64
MLA_WIDTH = MLA_HEADS * MLA_V
ATTN_BLOCK = 128
ROPE_THETA = 10000.0
PEER_HEADS = 8
PEER_NKEYS = 128
PEER_EXPERTS = PEER_NKEYS * PEER_NKEYS
PEER_KEY_DIM = 256
PEER_TOPK = 16
PEER_TOKEN_BLOCK = 128
N_BRANCHES = 3
IN_SPLITS = (S5_WIDTH, M2_INNER, M2_CONV_DIM, M2_HEADS, MLA_Q_RANK, MLA_KV_RANK, MLA_ROPE, N_BRANCHES * D_MODEL)
IN_WIDTH = sum(IN_SPLITS)
DN_ALPHA = (2 * DEPTH) ** 0.25
DN_BETA = (8 * DEPTH) ** -0.25
LN_EPS = 1e-5
RMS_EPS = 1e-6

kernel_name = "hybrid_s5_ssd_mla_peer_deepnorm"

F32 = jnp.float32


def layer_norm(x, g, b):
    xf = x.astype(F32)
    mu = jnp.mean(xf, -1, keepdims=True)
    var = jnp.mean(jnp.square(xf - mu), -1, keepdims=True)
    return ((xf - mu) * lax.rsqrt(var + LN_EPS) * g.astype(F32) + b.astype(F32)).astype(x.dtype)


def rms_norm(x, g):
    xf = x.astype(F32)
    y = xf * lax.rsqrt(jnp.mean(jnp.square(xf), -1, keepdims=True) + RMS_EPS) * g.astype(F32)
    return y.astype(x.dtype)


def _cplx_scan_op(e1, e2):
    ar1, ai1, br1, bi1 = e1
    ar2, ai2, br2, bi2 = e2
    return (ar1 * ar2 - ai1 * ai2,
            ar1 * ai2 + ai1 * ar2,
            ar2 * br1 - ai2 * bi1 + br2,
            ar2 * bi1 + ai2 * br1 + bi2)


def s5_mixer(u, a_re, a_im, log_dt, b_re, b_im, c_re, c_im, d, w_glu):
    bsz, seq, _ = u.shape
    uf = u.astype(F32)
    ug = uf.reshape(bsz, seq, S5_GROUPS, S5_GROUP)
    lr, li = a_re.astype(F32), a_im.astype(F32)
    dt = jnp.exp(log_dt.astype(F32))[:, None]
    mag = jnp.exp(lr * dt)
    abar_re = mag * jnp.cos(li * dt)
    abar_im = mag * jnp.sin(li * dt)
    nr, ni = abar_re - 1.0, abar_im
    den = lr * lr + li * li
    coef_re = ((nr * lr + ni * li) / den)[..., None]
    coef_im = ((ni * lr - nr * li) / den)[..., None]
    br, bi = b_re.astype(F32), b_im.astype(F32)
    bbar_re = coef_re * br - coef_im * bi
    bbar_im = coef_re * bi + coef_im * br
    bu_re = jnp.einsum('bsgh,gph->bsgp', ug, bbar_re)
    bu_im = jnp.einsum('bsgh,gph->bsgp', ug, bbar_im)
    ar = jnp.broadcast_to(abar_re, bu_re.shape)
    ai = jnp.broadcast_to(abar_im, bu_re.shape)
    _, _, xr, xi = lax.associative_scan(_cplx_scan_op, (ar, ai, bu_re, bu_im), axis=1)
    y = (jnp.einsum('bsgp,ghp->bsgh', xr, c_re.astype(F32))
         - jnp.einsum('bsgp,ghp->bsgh', xi, c_im.astype(F32)))
    y = y.reshape(bsz, seq, S5_WIDTH) + d.astype(F32) * uf
    z = jax.nn.gelu(y)
    out = z * jax.nn.sigmoid(z @ w_glu.astype(F32))
    return out.astype(u.dtype)


def causal_depthwise_conv(x, w, b):
    k = w.shape[0]
    y = lax.conv_general_dilated(x, w.astype(x.dtype)[:, None, :], window_strides=(1,),
                                 padding=((k - 1, 0),), dimension_numbers=('NWC', 'WIO', 'NWC'),
                                 feature_group_count=x.shape[-1])
    return y + b.astype(x.dtype)


def ssd_chunked(x, a, b, c):
    bsz, seq, h, p = x.shape
    n = b.shape[-1]
    L = M2_CHUNK
    nc = seq // L
    x = x.reshape(bsz, nc, L, h, p)
    b = b.reshape(bsz, nc, L, h, n)
    c = c.reshape(bsz, nc, L, h, n)
    a_cum = jnp.cumsum(a.reshape(bsz, nc, L, h).transpose(0, 3, 1, 2), axis=-1)
    causal = jnp.tril(jnp.ones((L, L), dtype=bool))
    seg = a_cum[..., :, None] - a_cum[..., None, :]
    decay = jnp.exp(jnp.where(causal, seg, -jnp.inf))
    scores = jnp.einsum('bclhn,bcshn->bhcls', c, b) * decay
    y_diag = jnp.einsum('bhcls,bcshp->bclhp', scores, x)
    decay_states = jnp.exp(a_cum[..., -1:] - a_cum)
    states = jnp.einsum('bclhn,bhcl,bclhp->bchpn', b, decay_states, x)
    chunk_decay = jnp.exp(a_cum[..., -1])

    def step(carry, inp):
        st, dec = inp
        return carry * dec[..., None, None] + st, carry

    init = jnp.zeros((bsz, h, p, n), F32)
    _, prev = lax.scan(step, init, (states.transpose(1, 0, 2, 3, 4), chunk_decay.transpose(2, 0, 1)))
    prev = prev.transpose(1, 0, 2, 3, 4)
    y_off = jnp.einsum('bclhn,bchpn,bhcl->bclhp', c, prev, jnp.exp(a_cum))
    return (y_diag + y_off).reshape(bsz, seq, h, p)


def mamba2_mixer(z, xbc, dt_raw, conv_w, conv_b, dt_bias, a_log, d, norm_w):
    bsz, seq, _ = z.shape
    xbc = jax.nn.silu(causal_depthwise_conv(xbc, conv_w, conv_b)).astype(F32)
    xs, bm, cm = jnp.split(xbc, [M2_INNER, M2_INNER + M2_GROUPS * M2_STATE], axis=-1)
    xs = xs.reshape(bsz, seq, M2_HEADS, M2_HEADDIM)
    rep = M2_HEADS // M2_GROUPS
    bm = jnp.repeat(bm.reshape(bsz, seq, M2_GROUPS, M2_STATE), rep, axis=2)
    cm = jnp.repeat(cm.reshape(bsz, seq, M2_GROUPS, M2_STATE), rep, axis=2)
    dt = jax.nn.softplus(dt_raw.astype(F32) + dt_bias.astype(F32))
    a = -jnp.exp(a_log.astype(F32))
    y = ssd_chunked(xs * dt[..., None], a * dt, bm, cm)
    y = y + d.astype(F32)[:, None] * xs
    y = y.reshape(bsz, seq, M2_INNER) * jax.nn.silu(z.astype(F32))
    y = y.reshape(bsz, seq, M2_GROUPS, M2_INNER // M2_GROUPS)
    y = y * lax.rsqrt(jnp.mean(y * y, -1, keepdims=True) + RMS_EPS)
    y = y.reshape(bsz, seq, M2_INNER) * norm_w.astype(F32)
    return y.astype(z.dtype)


def rope(x, cos, sin):
    x1, x2 = jnp.split(x, 2, axis=-1)
    return jnp.concatenate([x1 * cos - x2 * sin, x2 * cos + x1 * sin], axis=-1)


def mla_mixer(c_q, c_kv, k_rope, positions, q_norm, w_uq, kv_norm, w_ukv):
    bsz, seq, _ = c_q.shape
    inv_freq = 1.0 / (ROPE_THETA ** (jnp.arange(0, MLA_ROPE, 2, dtype=F32) / MLA_ROPE))
    ang = positions.astype(F32)[..., None] * inv_freq
    cos, sin = jnp.cos(ang), jnp.sin(ang)
    q = (rms_norm(c_q, q_norm) @ w_uq).astype(F32).reshape(bsz, seq, MLA_HEADS, MLA_NOPE + MLA_ROPE)
    scale = (MLA_NOPE + MLA_ROPE) ** -0.5
    q_nope = q[..., :MLA_NOPE] * scale
    q_rope = rope(q[..., MLA_NOPE:], cos[:, :, None], sin[:, :, None]) * scale
    kv = (rms_norm(c_kv, kv_norm) @ w_ukv).astype(F32).reshape(bsz, seq, MLA_HEADS, MLA_NOPE + MLA_V)
    k_nope, v = kv[..., :MLA_NOPE], kv[..., MLA_NOPE:]
    k_r = rope(k_rope.astype(F32), cos, sin)
    nb = seq // ATTN_BLOCK
    qn_b = q_nope.reshape(bsz, nb, ATTN_BLOCK, MLA_HEADS, MLA_NOPE).transpose(1, 0, 2, 3, 4)
    qr_b = q_rope.reshape(bsz, nb, ATTN_BLOCK, MLA_HEADS, MLA_ROPE).transpose(1, 0, 2, 3, 4)
    key_pos = jnp.arange(seq)

    def attend(blk):
        qn, qr, start = blk
        s = jnp.einsum('bqhd,bkhd->bhqk', qn, k_nope) + jnp.einsum('bqhr,bkr->bhqk', qr, k_r)
        q_pos = start + jnp.arange(ATTN_BLOCK)
        s = jnp.where(key_pos[None, :] <= q_pos[:, None], s, -jnp.inf)
        p = jax.nn.softmax(s, axis=-1)
        return jnp.einsum('bhqk,bkhd->bqhd', p, v)

    out = lax.map(attend, (qn_b, qr_b, jnp.arange(nb) * ATTN_BLOCK))
    return out.transpose(1, 0, 2, 3, 4).reshape(bsz, seq, MLA_WIDTH).astype(c_q.dtype)


def peer_ffn(x, w_q, subkeys, u_tab, v_tab):
    bsz, seq, dm = x.shape
    t = bsz * seq
    xt = x.reshape(t, dm)
    q = (xt @ w_q).astype(F32).reshape(t, PEER_HEADS, 2, PEER_KEY_DIM // 2)
    sub = jnp.einsum('thjd,jkd->thjk', q, subkeys.astype(F32))
    s_top, i_top = lax.top_k(sub, PEER_TOPK)
    cand_s = (s_top[:, :, 0, :, None] + s_top[:, :, 1, None, :]).reshape(t, PEER_HEADS, PEER_TOPK * PEER_TOPK)
    cand_i = (i_top[:, :, 0, :, None] * PEER_NKEYS + i_top[:, :, 1, None, :]).reshape(t, PEER_HEADS, PEER_TOPK * PEER_TOPK)
    best_s, best_j = lax.top_k(cand_s, PEER_TOPK)
    idx = jnp.take_along_axis(cand_i, best_j, axis=-1)
    gate = jax.nn.softmax(best_s, axis=-1)
    nblk = t // PEER_TOKEN_BLOCK
    sel = PEER_HEADS * PEER_TOPK
    idx = idx.reshape(nblk, PEER_TOKEN_BLOCK, sel)
    gate = gate.reshape(nblk, PEER_TOKEN_BLOCK, sel)
    xb = xt.reshape(nblk, PEER_TOKEN_BLOCK, dm)

    def experts(blk):
        xi, ii, gi = blk
        u = jnp.take(u_tab, ii, axis=0).astype(F32)
        hdn = jnp.einsum('tkd,td->tk', u, xi.astype(F32))
        act = gi * jax.nn.gelu(hdn)
        v = jnp.take(v_tab, ii, axis=0).astype(F32)
        return jnp.einsum('tk,tkd->td', act, v)

    out = lax.map(experts, (xb, idx, gate))
    return out.reshape(bsz, seq, dm).astype(x.dtype)


def setup_inputs(seed: int = 0) -> dict:
    key = jax.random.key(seed)
    k = jax.random.split(key, 40)
    L = DEPTH

    def nrm(i, shape, scale):
        return jax.random.normal(k[i], shape, F32) * scale

    def gain(i, shape):
        return 1.0 + 0.02 * jax.random.normal(k[i], shape, F32)

    x = nrm(0, (BATCH, SEQ, D_MODEL), 1.0)
    offs = jax.random.randint(k[1], (BATCH, 1), 0, 1024, dtype=jnp.int32)
    positions = offs + jnp.arange(SEQ, dtype=jnp.int32)[None, :]
    ln_in_g = gain(2, (D_MODEL,))
    ln_in_b = nrm(3, (D_MODEL,), 0.02)
    w_in = nrm(4, (L, D_MODEL, IN_WIDTH), D_MODEL ** -0.5)
    s5_a_re = -0.5 + nrm(5, (L, S5_GROUPS, S5_STATE), 0.01)
    s5_a_im = jnp.broadcast_to(math.pi * jnp.arange(S5_STATE, dtype=F32), (L, S5_GROUPS, S5_STATE))
    s5_log_dt = jax.random.uniform(k[6], (L, S5_GROUPS), F32, math.log(1e-3), math.log(1e-1))
    s5_b_re = nrm(7, (L, S5_GROUPS, S5_STATE, S5_GROUP), (2 * S5_GROUP) ** -0.5)
    s5_b_im = nrm(8, (L, S5_GROUPS, S5_STATE, S5_GROUP), (2 * S5_GROUP) ** -0.5)
    s5_c_re = nrm(9, (L, S5_GROUPS, S5_GROUP, S5_STATE), (2 * S5_STATE) ** -0.5)
    s5_c_im = nrm(10, (L, S5_GROUPS, S5_GROUP, S5_STATE), (2 * S5_STATE) ** -0.5)
    s5_d = nrm(11, (L, S5_WIDTH), 1.0)
    s5_w_glu = nrm(12, (L, S5_WIDTH, S5_WIDTH), S5_WIDTH ** -0.5)
    m2_conv_w = nrm(13, (L, M2_CONV, M2_CONV_DIM), M2_CONV ** -0.5)
    m2_conv_b = nrm(14, (L, M2_CONV_DIM), 0.02)
    dt0 = jnp.exp(jax.random.uniform(k[15], (L, M2_HEADS), F32, math.log(1e-3), math.log(1e-1)))
    m2_dt_bias = dt0 + jnp.log(-jnp.expm1(-dt0))
    m2_a_log = jnp.log(jax.random.uniform(k[16], (L, M2_HEADS), F32, 1.0, 16.0))
    m2_d = gain(17, (L, M2_HEADS))
    m2_norm_w = gain(18, (L, M2_INNER))
    mla_q_norm = gain(19, (L, MLA_Q_RANK))
    mla_w_uq = nrm(20, (L, MLA_Q_RANK, MLA_HEADS * (MLA_NOPE + MLA_ROPE)), MLA_Q_RANK ** -0.5)
    mla_kv_norm = gain(21, (L, MLA_KV_RANK))
    mla_w_ukv = nrm(22, (L, MLA_KV_RANK, MLA_HEADS * (MLA_NOPE + MLA_V)), MLA_KV_RANK ** -0.5)
    w_br_a = nrm(23, (L, S5_WIDTH, D_MODEL), DN_BETA * S5_WIDTH ** -0.5)
    w_br_b = nrm(24, (L, M2_INNER, D_MODEL), DN_BETA * M2_INNER ** -0.5)
    w_br_c = nrm(25, (L, MLA_WIDTH, D_MODEL), DN_BETA * MLA_WIDTH ** -0.5)
    w_out = nrm(26, (L, D_MODEL, D_MODEL), DN_BETA * D_MODEL ** -0.5)
    ln1_g = gain(27, (L, D_MODEL))
    ln1_b = nrm(28, (L, D_MODEL), 0.02)
    peer_w_q = nrm(29, (L, D_MODEL, PEER_HEADS * PEER_KEY_DIM), D_MODEL ** -0.5)
    peer_subkeys = nrm(30, (L, 2, PEER_NKEYS, PEER_KEY_DIM // 2), (PEER_KEY_DIM // 2) ** -0.5)
    peer_u = nrm(31, (L, PEER_EXPERTS, D_MODEL), D_MODEL ** -0.5)
    peer_v = nrm(32, (L, PEER_EXPERTS, D_MODEL), DN_BETA)
    ln2_g = gain(33, (L, D_MODEL))
    ln2_b = nrm(34, (L, D_MODEL), 0.02)
    return {"x": x, "positions": positions, "ln_in_g": ln_in_g, "ln_in_b": ln_in_b, "w_in": w_in,
            "s5_a_re": s5_a_re, "s5_a_im": s5_a_im, "s5_log_dt": s5_log_dt, "s5_b_re": s5_b_re,
            "s5_b_im": s5_b_im, "s5_c_re": s5_c_re, "s5_c_im": s5_c_im, "s5_d": s5_d, "s5_w_glu": s5_w_glu,
            "m2_conv_w": m2_conv_w, "m2_conv_b": m2_conv_b, "m2_dt_bias": m2_dt_bias, "m2_a_log": m2_a_log,
            "m2_d": m2_d, "m2_norm_w": m2_norm_w, "mla_q_norm": mla_q_norm, "mla_w_uq": mla_w_uq,
            "mla_kv_norm": mla_kv_norm, "mla_w_ukv": mla_w_ukv, "w_br_a": w_br_a, "w_br_b": w_br_b,
            "w_br_c": w_br_c, "w_out": w_out, "ln1_g": ln1_g, "ln1_b": ln1_b, "peer_w_q": peer_w_q,
            "peer_subkeys": peer_subkeys, "peer_u": peer_u, "peer_v": peer_v, "ln2_g": ln2_g, "ln2_b": ln2_b}


def reference(x, positions, ln_in_g, ln_in_b, w_in, s5_a_re, s5_a_im, s5_log_dt, s5_b_re, s5_b_im,
              s5_c_re, s5_c_im, s5_d, s5_w_glu, m2_conv_w, m2_conv_b, m2_dt_bias, m2_a_log, m2_d,
              m2_norm_w, mla_q_norm, mla_w_uq, mla_kv_norm, mla_w_ukv, w_br_a, w_br_b, w_br_c, w_out,
              ln1_g, ln1_b, peer_w_q, peer_subkeys, peer_u, peer_v, ln2_g, ln2_b):
    cuts = np.cumsum(IN_SPLITS)[:-1].tolist()
    h = layer_norm(x, ln_in_g, ln_in_b)
    for l in range(DEPTH):
        proj = h @ w_in[l]
        u_s5, z_m2, xbc_m2, dt_m2, c_q, c_kv, k_rope, gates = jnp.split(proj, cuts, axis=-1)
        y_a = s5_mixer(u_s5, s5_a_re[l], s5_a_im[l], s5_log_dt[l], s5_b_re[l], s5_b_im[l],
                       s5_c_re[l], s5_c_im[l], s5_d[l], s5_w_glu[l])
        y_b = mamba2_mixer(z_m2, xbc_m2, dt_m2, m2_conv_w[l], m2_conv_b[l], m2_dt_bias[l],
                           m2_a_log[l], m2_d[l], m2_norm_w[l])
        y_c = mla_mixer(c_q, c_kv, k_rope, positions, mla_q_norm[l], mla_w_uq[l],
                        mla_kv_norm[l], mla_w_ukv[l])
        g_a, g_b, g_c = jnp.split(jax.nn.sigmoid(gates.astype(F32)), N_BRANCHES, axis=-1)
        merged = (g_a * (y_a @ w_br_a[l]).astype(F32) + g_b * (y_b @ w_br_b[l]).astype(F32)
                  + g_c * (y_c @ w_br_c[l]).astype(F32))
        mix = merged.astype(h.dtype) @ w_out[l]
        h = layer_norm(DN_ALPHA * h + mix, ln1_g[l], ln1_b[l])
        ffn = peer_ffn(h, peer_w_q[l], peer_subkeys[l], peer_u[l], peer_v[l])
        h = layer_norm(DN_ALPHA * h + ffn, ln2_g[l], ln2_b[l])
    return h
```

```cpp
#include <hip/hip_runtime.h>
#include <cstdio>
#include <cstdint>
#include <cmath>

namespace {
constexpr int D = 1024, NB = 4, SEQ = 8192, DEPTH = 2;
constexpr int S5W = 384, S5G = 24, S5P = 64;
constexpr int M2I = 512, M2H = 8, M2P = 64, M2N = 128, M2C = 1024;
constexpr int QR = 256, KVR = 128, ROPE = 32, NOPE = 64, VD = 64, AH = 8;
constexpr int INW = 5416;
constexpr int O_U = 0, O_Z = 384, O_XBC = 896, O_DT = 1920, O_CQ = 1928, O_CKV = 2184, O_KR = 2312, O_G = 2344;
constexpr int PH = 8, PK = 128, PT = 16, PE = 16384;
constexpr float ALPHA = 1.41421356237f;
constexpr int MP = SEQ;

__device__ __forceinline__ float gelu_t(float x) { return 0.5f * x * (1.f + tanhf(0.7978845608028654f * (x + 0.044715f * x * x * x))); }
__device__ __forceinline__ float sigm(float x) { return 1.f / (1.f + expf(-x)); }
__device__ __forceinline__ float wsum(float v) { for (int o = 32; o > 0; o >>= 1) v += __shfl_xor(v, o); return v; }

__global__ void __launch_bounds__(256) k_ln(const float* a, const float* add, float alpha, const float* g, const float* b, float* out) {
    __shared__ float red[8];
    const int r = blockIdx.x, t = threadIdx.x;
    float v[4]; float s = 0.f;
#pragma unroll
    for (int i = 0; i < 4; ++i) { const int c = t + 256 * i; float x = alpha * a[(size_t)r * D + c]; if (add) x += add[(size_t)r * D + c]; v[i] = x; s += x; }
    s = wsum(s); if ((t & 63) == 0) red[t >> 6] = s; __syncthreads();
    const float mu = (red[0] + red[1] + red[2] + red[3]) * (1.f / D);
    float q = 0.f;
#pragma unroll
    for (int i = 0; i < 4; ++i) { const float d = v[i] - mu; q += d * d; }
    q = wsum(q); if ((t & 63) == 0) red[4 + (t >> 6)] = q; __syncthreads();
    const float rs = rsqrtf((red[4] + red[5] + red[6] + red[7]) * (1.f / D) + 1e-5f);
#pragma unroll
    for (int i = 0; i < 4; ++i) { const int c = t + 256 * i; out[(size_t)r * D + c] = (v[i] - mu) * rs * g[c] + b[c]; }
}

__global__ void __launch_bounds__(256) k_gemm(const float* A, int lda, const float* B, int ldb, float* C, int ldc, int M, int N, int K) {
    __shared__ float As[16][65], Bs[16][65];
    const int tx = threadIdx.x & 15, ty = threadIdx.x >> 4, m0 = blockIdx.y * 64, n0 = blockIdx.x * 64;
    float acc[4][4];
#pragma unroll
    for (int i = 0; i < 4; ++i)
#pragma unroll
        for (int j = 0; j < 4; ++j) acc[i][j] = 0.f;
    for (int k0 = 0; k0 < K; k0 += 16) {
        for (int i = threadIdx.x; i < 1024; i += 256) { const int r = i >> 4, c = i & 15; As[c][r] = A[(size_t)(m0 + r) * lda + k0 + c]; }
        for (int i = threadIdx.x; i < 1024; i += 256) { const int r = i >> 6, c = i & 63; Bs[r][c] = (n0 + c < N) ? B[(size_t)(k0 + r) * ldb + n0 + c] : 0.f; }
        __syncthreads();
#pragma unroll
        for (int k = 0; k < 16; ++k) {
            float a[4], b[4];
#pragma unroll
            for (int i = 0; i < 4; ++i) { a[i] = As[k][ty + 16 * i]; b[i] = Bs[k][tx + 16 * i]; }
#pragma unroll
            for (int i = 0; i < 4; ++i)
#pragma unroll
                for (int j = 0; j < 4; ++j) acc[i][j] += a[i] * b[j];
        }
        __syncthreads();
    }
#pragma unroll
    for (int i = 0; i < 4; ++i)
#pragma unroll
        for (int j = 0; j < 4; ++j) { const int n = n0 + tx + 16 * j; if (n < N) C[(size_t)(m0 + ty + 16 * i) * ldc + n] = acc[i][j]; }
}

__global__ void __launch_bounds__(64) k_s5(const float* proj, const float* a_re, const float* a_im, const float* log_dt, const float* b_re, const float* b_im,
                                           const float* c_re, const float* c_im, const float* dvec, float* z) {
    const int g = blockIdx.x, p = threadIdx.x;
    const float lr = a_re[g * S5P + p], li = a_im[g * S5P + p], dt = expf(log_dt[g]);
    const float mag = expf(lr * dt), ar = mag * cosf(li * dt), ai = mag * sinf(li * dt);
    const float nr = ar - 1.f, ni = ai, den = lr * lr + li * li;
    const float cr = (nr * lr + ni * li) / den, ci = (ni * lr - nr * li) / den;
    float bbr[16], bbi[16], ccr[16], cci[16];
#pragma unroll
    for (int h = 0; h < 16; ++h) {
        const float br = b_re[(g * S5P + p) * 16 + h], bi = b_im[(g * S5P + p) * 16 + h];
        bbr[h] = cr * br - ci * bi; bbi[h] = cr * bi + ci * br;
        ccr[h] = c_re[(g * 16 + h) * S5P + p]; cci[h] = c_im[(g * 16 + h) * S5P + p];
    }
    float xr = 0.f, xi = 0.f;
    float un[16];
#pragma unroll
    for (int h = 0; h < 16; ++h) un[h] = proj[O_U + g * 16 + h];
    for (int t = 0; t < SEQ; ++t) {
        float u[16];
#pragma unroll
        for (int h = 0; h < 16; ++h) u[h] = un[h];
        if (t + 1 < SEQ) {
#pragma unroll
            for (int h = 0; h < 16; ++h) un[h] = proj[(size_t)(t + 1) * INW + O_U + g * 16 + h];
        }
        float bur = 0.f, bui = 0.f;
#pragma unroll
        for (int h = 0; h < 16; ++h) { const float uu = u[h]; bur += bbr[h] * uu; bui += bbi[h] * uu; }
        const float nxr = ar * xr - ai * xi + bur, nxi = ar * xi + ai * xr + bui; xr = nxr; xi = nxi;
        float mine = 0.f, myu = 0.f;
#pragma unroll
        for (int h = 0; h < 16; ++h) { float y = wsum(xr * ccr[h] - xi * cci[h]); if (p == h) { mine = y; myu = u[h]; } }
        if (p < 16) { const float y = mine + dvec[g * 16 + p] * myu; z[(size_t)t * S5W + g * 16 + p] = gelu_t(y); }
    }
}
__global__ void __launch_bounds__(256) k_glu(const float* z, const float* zw, float* ya, int n) { const int i = blockIdx.x * 256 + threadIdx.x; if (i < n) ya[i] = z[i] * sigm(zw[i]); }

__global__ void __launch_bounds__(256) k_conv(const float* proj, const float* cw, const float* cb, float* xc) {
    const int i = blockIdx.x * 256 + threadIdx.x; const int t = i / M2C, c = i % M2C;
    float s = cb[c];
    for (int k = 0; k < 4; ++k) { const int tt = t - 3 + k; if (tt >= 0) s += cw[k * M2C + c] * proj[(size_t)tt * INW + O_XBC + c]; }
    xc[i] = s * sigm(s);
}
__global__ void __launch_bounds__(128) k_ssd(const float* proj, const float* xc, const float* dt_bias, const float* a_log, const float* dskip, float* y) {
    __shared__ float red[2];
    const int h = blockIdx.x / M2P, p = blockIdx.x % M2P, n = threadIdx.x, gr = h / 4;
    const float A = -expf(a_log[h]), db = dt_bias[h], dk = dskip[h];
    float st = 0.f;
    float n_raw = proj[O_DT + h], n_x = xc[h * M2P + p], n_B = xc[M2I + gr * M2N + n], n_C = xc[M2I + 2 * M2N + gr * M2N + n];
    for (int t = 0; t < SEQ; ++t) {
        const float raw = n_raw + db, x = n_x, Bv = n_B, Cv = n_C;
        if (t + 1 < SEQ) { const size_t t1 = (size_t)(t + 1);
            n_raw = proj[t1 * INW + O_DT + h]; n_x = xc[t1 * M2C + h * M2P + p]; n_B = xc[t1 * M2C + M2I + gr * M2N + n]; n_C = xc[t1 * M2C + M2I + 2 * M2N + gr * M2N + n]; }
        const float dt = raw > 20.f ? raw : log1pf(expf(raw));
        st = expf(A * dt) * st + dt * x * Bv;
        float part = wsum(Cv * st);
        __syncthreads();
        if ((n & 63) == 0) red[n >> 6] = part;
        __syncthreads();
        if (n == 0) y[(size_t)t * M2I + h * M2P + p] = red[0] + red[1] + dk * x;
    }
}
__global__ void __launch_bounds__(512) k_m2norm(const float* proj, const float* y, const float* nw, float* yb) {
    __shared__ float red[8];
    const int t = blockIdx.x, c = threadIdx.x;
    const float zz = proj[(size_t)t * INW + O_Z + c]; const float v = y[(size_t)t * M2I + c] * zz * sigm(zz);
    const float s = wsum(v * v); if ((c & 63) == 0) red[c >> 6] = s; __syncthreads();
    const int g = c >> 8; const float ms = (red[4 * g] + red[4 * g + 1] + red[4 * g + 2] + red[4 * g + 3]) * (1.f / 256.f);
    yb[(size_t)t * M2I + c] = v * rsqrtf(ms + 1e-6f) * nw[c];
}

__global__ void __launch_bounds__(64) k_rms(const float* proj, int off, int W, const float* g, float* out) {
    const int t = blockIdx.x, l = threadIdx.x; float s = 0.f;
    for (int c = l; c < W; c += 64) { const float v = proj[(size_t)t * INW + off + c]; s += v * v; }
    s = wsum(s); const float rs = rsqrtf(s / W + 1e-6f);
    for (int c = l; c < W; c += 64) out[(size_t)t * W + c] = proj[(size_t)t * INW + off + c] * rs * g[c];
}
__global__ void __launch_bounds__(256) k_rope(float* q, const float* proj, const int* pos, float* kr) {
    const int i = blockIdx.x * 256 + threadIdx.x; const int t = i >> 4, f = i & 15;
    const float inv = 1.0f / powf(10000.f, (float)(2 * f) / 32.f); const float ang = (float)pos[t] * inv; const float cs = cosf(ang), sn = sinf(ang);
    const float sc = 0.10206207261596577f;
    for (int h = 0; h < AH; ++h) {
        float* qq = q + (size_t)t * 768 + h * 96;
        const float x1 = qq[64 + f], x2 = qq[80 + f];
        qq[64 + f] = (x1 * cs - x2 * sn) * sc; qq[80 + f] = (x2 * cs + x1 * sn) * sc;
        for (int d = f; d < 64; d += 16) qq[d] *= sc;
    }
    const float k1 = proj[(size_t)t * INW + O_KR + f], k2 = proj[(size_t)t * INW + O_KR + 16 + f];
    kr[t * 32 + f] = k1 * cs - k2 * sn; kr[t * 32 + 16 + f] = k2 * cs + k1 * sn;
}
__global__ void __launch_bounds__(64) k_attn(const float* __restrict__ q, const float* __restrict__ kv, const float* __restrict__ kr, float* __restrict__ yc) {
    const int h = blockIdx.y, qi = blockIdx.x * 64 + threadIdx.x;
    float qv[96], o[64];
#pragma unroll
    for (int d = 0; d < 96; ++d) qv[d] = q[(size_t)qi * 768 + h * 96 + d];
#pragma unroll
    for (int d = 0; d < 64; ++d) o[d] = 0.f;
    float m = -INFINITY, l = 0.f;
    const int kmax = blockIdx.x * 64 + 63;
    for (int k = 0; k <= kmax; ++k) {
        const float* kn = kv + (size_t)k * 1024 + h * 128; const float* krr = kr + (size_t)k * 32;
        float s = 0.f;
#pragma unroll
        for (int d = 0; d < 64; ++d) s += qv[d] * kn[d];
#pragma unroll
        for (int d = 0; d < 32; ++d) s += qv[64 + d] * krr[d];
        if (k <= qi) {
            const float mn = fmaxf(m, s), f = expf(m - mn), pp = expf(s - mn);
            l = l * f + pp; m = mn;
#pragma unroll
            for (int d = 0; d < 64; ++d) o[d] = o[d] * f + pp * kn[64 + d];
        }
    }
    const float il = 1.f / l;
#pragma unroll
    for (int d = 0; d < 64; ++d) yc[(size_t)qi * 512 + h * 64 + d] = o[d] * il;
}

__global__ void __launch_bounds__(256) k_merge(const float* proj, int goff, const float* tmp, float* merged, int first) {
    const int i = blockIdx.x * 256 + threadIdx.x; const int t = i >> 10, c = i & 1023;
    const float v = sigm(proj[(size_t)t * INW + goff + c]) * tmp[i];
    merged[i] = first ? v : merged[i] + v;
}

__global__ void __launch_bounds__(256) k_sub(const float* pq, const float* sk, float* sub) {
    __shared__ float qs[2048];
    const int t = blockIdx.x;
    for (int i = threadIdx.x; i < 2048; i += 256) qs[i] = pq[(size_t)t * 2048 + i];
    __syncthreads();
    for (int o = threadIdx.x; o < 2048; o += 256) {
        const int k = o & 127, hj = o >> 7, j = hj & 1;
        const float* kk = sk + ((size_t)j * PK + k) * 128; const float* qq = qs + hj * 128;
        float s = 0.f; for (int d = 0; d < 128; ++d) s += qq[d] * kk[d];
        sub[(size_t)t * 2048 + o] = s;
    }
}
__global__ void __launch_bounds__(256) k_top1(const float* sub, float* ts, int* ti) {
    const int i = blockIdx.x * 256 + threadIdx.x;
    const float* s = sub + (size_t)i * 128;
    float pv = INFINITY; int pi = -1;
    for (int r = 0; r < PT; ++r) {
        float bv = -INFINITY; int bi = -1;
        for (int k = 0; k < 128; ++k) { const float v = s[k]; const bool valid = (v < pv) || (v == pv && k > pi); if (valid && (bi < 0 || v > bv)) { bv = v; bi = k; } }
        ts[(size_t)i * PT + r] = bv; ti[(size_t)i * PT + r] = bi; pv = bv; pi = bi;
    }
}
__global__ void __launch_bounds__(256) k_top2(const float* ts, const int* ti, float* gate, int* idx) {
    const int i = blockIdx.x * 256 + threadIdx.x;
    const float* s0 = ts + (size_t)(2 * i) * PT; const float* s1 = s0 + PT; const int* i0 = ti + (size_t)(2 * i) * PT; const int* i1 = i0 + PT;
    float a0[16], a1[16];
#pragma unroll
    for (int r = 0; r < 16; ++r) { a0[r] = s0[r]; a1[r] = s1[r]; }
    float pv = INFINITY; int pi = -1; float mx = -INFINITY;
    for (int r = 0; r < PT; ++r) {
        float bv = -INFINITY; int bi = -1;
#pragma unroll
        for (int a = 0; a < 16; ++a)
#pragma unroll
            for (int bb = 0; bb < 16; ++bb) { const int c = a * 16 + bb; const float v = a0[a] + a1[bb]; const bool valid = (v < pv) || (v == pv && c > pi); if (valid && (bi < 0 || v > bv)) { bv = v; bi = c; } }
        gate[(size_t)i * PT + r] = bv; idx[(size_t)i * PT + r] = i0[bi >> 4] * PK + i1[bi & 15]; pv = bv; pi = bi; mx = fmaxf(mx, bv);
    }
    float sum = 0.f;
    for (int r = 0; r < PT; ++r) sum += expf(gate[(size_t)i * PT + r] - mx);
    for (int r = 0; r < PT; ++r) gate[(size_t)i * PT + r] = expf(gate[(size_t)i * PT + r] - mx) / sum;
}
__global__ void __launch_bounds__(256) k_experts(const float* h1, const float* gate, const int* idx, const float* ut, const float* vt, float* ffn) {
    __shared__ float act[128]; __shared__ int ids[128];
    const int t = blockIdx.x, tid = threadIdx.x, lane = tid & 63, w = tid >> 6;
    if (tid < 128) ids[tid] = idx[(size_t)t * 128 + tid];
    __syncthreads();
    float xv[16];
#pragma unroll
    for (int i = 0; i < 16; ++i) xv[i] = h1[(size_t)t * D + lane + 64 * i];
    for (int k = w; k < 128; k += 4) {
        const float* u = ut + (size_t)ids[k] * D; float s = 0.f;
#pragma unroll
        for (int i = 0; i < 16; ++i) s += xv[i] * u[lane + 64 * i];
        s = wsum(s);
        if (lane == 0) act[k] = gate[(size_t)t * 128 + k] * gelu_t(s);
    }
    __syncthreads();
    float o[4] = {0.f, 0.f, 0.f, 0.f};
    for (int k = 0; k < 128; ++k) { const float a = act[k]; const float* v = vt + (size_t)ids[k] * D;
#pragma unroll
        for (int i = 0; i < 4; ++i) o[i] += a * v[tid + 256 * i]; }
#pragma unroll
    for (int i = 0; i < 4; ++i) ffn[(size_t)t * D + tid + 256 * i] = o[i];
}
}

extern "C" void kernel_launch(void* const* d_in, const int* in_sizes, int n_in, void* d_out, int out_size, void* d_ws, size_t ws_size, hipStream_t stream) {
    const float* x = (const float*)d_in[0]; const int* positions = (const int*)d_in[1];
    auto F = [&](int i) { return (const float*)d_in[i]; };
    float* out = (float*)d_out;
    size_t off = 0; auto alloc = [&](size_t n) { float* p = (float*)((char*)d_ws + off); off += ((n * 4 + 255) / 256) * 256; return p; };
    float* proj = alloc((size_t)MP * INW);
    float* ya = alloc((size_t)MP * S5W); float* yb = alloc((size_t)MP * M2I); float* yc = alloc((size_t)MP * 512);
    float* zb = alloc((size_t)MP * S5W); float* zw = alloc((size_t)MP * S5W);
    float* xc = alloc((size_t)MP * M2C); float* ys = alloc((size_t)MP * M2I);
    float* cqn = alloc((size_t)MP * QR); float* ckvn = alloc((size_t)MP * KVR); float* qb = alloc((size_t)MP * 768); float* kvb = alloc((size_t)MP * 1024); float* kr = alloc((size_t)MP * 32);
    float* tmp = alloc((size_t)MP * D); float* merged = alloc((size_t)MP * D);
    float* gate = alloc((size_t)MP * 128); int* idx = (int*)alloc((size_t)MP * 128);
    float* ts = alloc((size_t)MP * 16 * 16); int* ti = (int*)alloc((size_t)MP * 16 * 16);
    float* pq = proj; float* sub = proj + (size_t)MP * 2048; float* ffn = proj + (size_t)MP * 4096;
    if (off > ws_size) { fprintf(stderr, "workspace too small: need %zu have %zu\n", off, ws_size); return; }
    auto gemm = [&](const float* A, int lda, const float* B, int ldb, float* C, int ldc, int M, int N, int K) {
        k_gemm<<<dim3((N + 63) / 64, M / 64), 256, 0, stream>>>(A, lda, B, ldb, C, ldc, M, N, K); };
    for (int b = 0; b < NB; ++b) {
        float* h = out + (size_t)b * MP * D; const int* pos = positions + (size_t)b * SEQ;
        k_ln<<<MP, 256, 0, stream>>>(x + (size_t)b * MP * D, nullptr, 1.f, F(2), F(3), h);
        for (int l = 0; l < DEPTH; ++l) {
            gemm(h, D, F(4) + (size_t)l * D * INW, INW, proj, INW, MP, INW, D);
            k_s5<<<S5G, 64, 0, stream>>>(proj, F(5) + l * S5G * S5P, F(6) + l * S5G * S5P, F(7) + l * S5G, F(8) + (size_t)l * S5G * S5P * 16, F(9) + (size_t)l * S5G * S5P * 16,
                                         F(10) + (size_t)l * S5G * 16 * S5P, F(11) + (size_t)l * S5G * 16 * S5P, F(12) + l * S5W, zb);
            gemm(zb, S5W, F(13) + (size_t)l * S5W * S5W, S5W, zw, S5W, MP, S5W, S5W);
            k_glu<<<MP * S5W / 256, 256, 0, stream>>>(zb, zw, ya, MP * S5W);
            k_conv<<<MP * M2C / 256, 256, 0, stream>>>(proj, F(14) + (size_t)l * 4 * M2C, F(15) + l * M2C, xc);
            k_ssd<<<M2H * M2P, 128, 0, stream>>>(proj, xc, F(16) + l * M2H, F(17) + l * M2H, F(18) + l * M2H, ys);
            k_m2norm<<<MP, 512, 0, stream>>>(proj, ys, F(19) + l * M2I, yb);
            k_rms<<<MP, 64, 0, stream>>>(proj, O_CQ, QR, F(20) + l * QR, cqn);
            k_rms<<<MP, 64, 0, stream>>>(proj, O_CKV, KVR, F(22) + l * KVR, ckvn);
            gemm(cqn, QR, F(21) + (size_t)l * QR * 768, 768, qb, 768, MP, 768, QR);
            gemm(ckvn, KVR, F(23) + (size_t)l * KVR * 1024, 1024, kvb, 1024, MP, 1024, KVR);
            k_rope<<<MP * 16 / 256, 256, 0, stream>>>(qb, proj, pos, kr);
            k_attn<<<dim3(SEQ / 64, AH), 64, 0, stream>>>(qb, kvb, kr, yc);
            gemm(ya, S5W, F(24) + (size_t)l * S5W * D, D, tmp, D, MP, D, S5W);
            k_merge<<<MP * D / 256, 256, 0, stream>>>(proj, O_G, tmp, merged, 1);
            gemm(yb, M2I, F(25) + (size_t)l * M2I * D, D, tmp, D, MP, D, M2I);
            k_merge<<<MP * D / 256, 256, 0, stream>>>(proj, O_G + D, tmp, merged, 0);
            gemm(yc, 512, F(26) + (size_t)l * 512 * D, D, tmp, D, MP, D, 512);
            k_merge<<<MP * D / 256, 256, 0, stream>>>(proj, O_G + 2 * D, tmp, merged, 0);
            gemm(merged, D, F(27) + (size_t)l * D * D, D, tmp, D, MP, D, D);
            k_ln<<<MP, 256, 0, stream>>>(h, tmp, ALPHA, F(28) + l * D, F(29) + l * D, h);
            gemm(h, D, F(30) + (size_t)l * D * 2048, 2048, pq, 2048, MP, 2048, D);
            k_sub<<<MP, 256, 0, stream>>>(pq, F(31) + (size_t)l * 2 * PK * 128, sub);
            k_top1<<<MP * 16 / 256, 256, 0, stream>>>(sub, ts, ti);
            k_top2<<<MP * 8 / 256, 256, 0, stream>>>(ts, ti, gate, idx);
            k_experts<<<MP, 256, 0, stream>>>(h, gate, idx, F(32) + (size_t)l * PE * D, F(33) + (size_t)l * PE * D, ffn);
            k_ln<<<MP, 256, 0, stream>>>(h, ffn, ALPHA, F(34) + l * D, F(35) + l * D, h);
        }
    }
}
```

```cpp
#include <hip/hip_runtime.h>
#include <cstdio>
#include <cstdint>
#include <cmath>
namespace pg8 {
#define PG8_LAS __attribute__((address_space(3)))
typedef unsigned short bf16_t;
typedef short bf16x8 __attribute__((ext_vector_type(8)));
typedef float f32x4 __attribute__((ext_vector_type(4)));
typedef unsigned u32x4 __attribute__((ext_vector_type(4)));
constexpr int BM = 256, BK = 64, HALF = 128, HTB = HALF * BK * 2  , STAGE_BYTES = 8 * HTB, NXCD = 8, WGM = 8;

__host__ __device__ __forceinline__ int lds_byte(int r, int c) { const int st = (r >> 4) * 2 + (c >> 5), rr = r & 15, cc = c & 31, ob = rr * 64 + cc * 2; return st * 1024 + (ob ^ (((ob >> 9) & 1) << 5)); }
__host__ __device__ __forceinline__ void stage_rc(int b, int& R, int& C) { const int st = b / 1024, sb = b % 1024, swz = sb ^ (((sb >> 9) & 1) << 5); R = (st >> 1) * 16 + swz / 64; C = (st & 1) * 32 + (swz % 64) / 2; }
__host__ __device__ __forceinline__ int perm32(int rho) { const int n = rho >> 4, i = rho & 15; return 8 * (i >> 2) + 4 * n + (i & 3); }

struct Unit { int pm, pn; };
struct Gemm { const bf16_t* A; const bf16_t* Bt; int M, N, K; };

struct StaticOrder {
    int nM, nN, nwg, G, c;
    __host__ __device__ void init(int M, int N, int G_, int c_) { nM = M / BM; nN = N / BM; nwg = nM * nN; G = G_; c = c_; }
    __host__ __device__ bool next(int i, Unit& u) const {
        const long L = (long)i * G + c; if (L >= nwg) return false;
        int wgid = (int)L; { const int q = nwg / NXCD, r = nwg % NXCD, xcd = wgid % NXCD, off = wgid / NXCD; wgid = (xcd < r ? xcd * (q + 1) : r * (q + 1) + (xcd - r) * q) + off; }
        const int nig = WGM * nN, gid = wgid / nig, fm = gid * WGM, gsz = (nM - fm) < WGM ? (nM - fm) : WGM;
        u.pm = fm + ((wgid % nig) % gsz); u.pn = (wgid % nig) / gsz; return true;
    }
    __device__ __forceinline__ void a_ready(const Unit&) const {}
    __device__ __forceinline__ void done(const Unit&) const {}
};

__device__ __forceinline__ unsigned cvt_pk_bf16(float lo, float hi) { unsigned r; asm volatile("v_cvt_pk_bf16_f32 %0, %1, %2" : "=v"(r) : "v"(lo), "v"(hi)); return r; }
typedef float f32x2 __attribute__((ext_vector_type(2)));
__device__ __forceinline__ f32x2 gelu_pk(f32x2 v) {
    const f32x2 av = __builtin_elementwise_abs(v), d = av * 0.2316418882f + 1.0f;
    f32x2 t; t.x = __builtin_amdgcn_rcpf(d.x); t.y = __builtin_amdgcn_rcpf(d.y);
    f32x2 q = t * 0.5307027145f + (-0.7265760135f); q = q * t + 0.7107068705f; q = q * t + (-0.142248368f); q = q * t + 0.127414796f; q = q * t;
    const f32x2 s = (v * v) * (-0.72134752044f);
    f32x2 e; e.x = __builtin_amdgcn_exp2f(s.x); e.y = __builtin_amdgcn_exp2f(s.y);
    const f32x2 m = v * (q * e), r = v - m;
    f32x2 o; o.x = v.x < 0.f ? m.x : r.x; o.y = v.y < 0.f ? m.y : r.y; return o;
}

template <int ACT  > struct EpiBf16 {
    static constexpr bool PERM = true, AFTER_DRAIN = false; static_assert(ACT == 0 || ACT == 1, "EpiBf16: ACT is 0 (none) or 1 (gelu_pk)");
    bf16_t* O; int ldc; const float* bias; int split_cols; size_t split_stride; float scale0;
    __device__ __forceinline__ void operator()(const f32x4 (&acc)[2][2][4][2], const Unit& u, int wr, int wc, int fr, int fq) const {
        const int row0 = u.pm * BM + wr * 64 + fr; int colt = u.pn * BM; bf16_t* base = O;
        float sc = 1.f; if (split_cols) { const int t = colt / split_cols; base += (size_t)t * split_stride; colt -= t * split_cols; if (t == 0) sc = scale0; }
        const int col0 = colt + wc * 32 + 8 * fq, bcol0 = u.pn * BM + wc * 32 + 8 * fq;
        f32x4 bv[2][2];
#pragma unroll
        for (int bj = 0; bj < 2; ++bj)
#pragma unroll
            for (int n = 0; n < 2; ++n) bv[bj][n] = bias ? *(const f32x4*)(bias + bcol0 + bj * HALF + 4 * n) : (f32x4){0.f, 0.f, 0.f, 0.f};
#pragma unroll
        for (int ai = 0; ai < 2; ++ai)
#pragma unroll
            for (int m = 0; m < 4; ++m) { bf16_t* rowp = base + (size_t)(row0 + ai * HALF + m * 16) * ldc + col0;
#pragma unroll
                for (int bj = 0; bj < 2; ++bj) { f32x4 v0 = acc[ai][bj][m][0] + bv[bj][0], v1 = acc[ai][bj][m][1] + bv[bj][1];
                    if (ACT == 1) { f32x2 a = gelu_pk((f32x2){v0[0], v0[1]}), b = gelu_pk((f32x2){v0[2], v0[3]}), c = gelu_pk((f32x2){v1[0], v1[1]}), d = gelu_pk((f32x2){v1[2], v1[3]});
                        v0 = (f32x4){a.x, a.y, b.x, b.y}; v1 = (f32x4){c.x, c.y, d.x, d.y}; }
                    v0 = v0 * sc; v1 = v1 * sc; u32x4 w; w.x = cvt_pk_bf16(v0[0], v0[1]); w.y = cvt_pk_bf16(v0[2], v0[3]); w.z = cvt_pk_bf16(v1[0], v1[1]); w.w = cvt_pk_bf16(v1[2], v1[3]);
                    *(u32x4*)(rowp + bj * HALF) = w; } }
    }
};

struct PanelStats {
    unsigned* xbuf;
    unsigned* cnt;
    unsigned* tmo;
    int ntn; float eps;
    unsigned code;
    __device__ __forceinline__ bool run(const f32x4 (&v)[2][2][4][2], const Unit& u, int wr, int wc, int fr, int fq, PG8_LAS unsigned char* lds, int wid, int lane) const {
        typedef float f32x2v __attribute__((ext_vector_type(2)));
        PG8_LAS f32x2v* P = (PG8_LAS f32x2v*)lds;
        PG8_LAS f32x2v* S = (PG8_LAS f32x2v*)(lds + 8192);
        PG8_LAS unsigned* flag = (PG8_LAS unsigned*)(lds + 8192 + 2048);
#pragma unroll
        for (int ai = 0; ai < 2; ++ai)
#pragma unroll
            for (int m = 0; m < 4; ++m) {
                float s = 0.f;
#pragma unroll
                for (int bj = 0; bj < 2; ++bj)
#pragma unroll
                    for (int n = 0; n < 2; ++n) { const f32x4 x = v[ai][bj][m][n]; s += (x[0] + x[1]) + (x[2] + x[3]); }
                s += __shfl_xor(s, 16); s += __shfl_xor(s, 32);
                const float mw = s * (1.0f / 64.0f); float q = 0.f;
#pragma unroll
                for (int bj = 0; bj < 2; ++bj)
#pragma unroll
                    for (int n = 0; n < 2; ++n) { const f32x4 d = v[ai][bj][m][n] - mw; q += (d[0] * d[0] + d[1] * d[1]) + (d[2] * d[2] + d[3] * d[3]); }
                q += __shfl_xor(q, 16); q += __shfl_xor(q, 32);
                if (fq == 0) P[(ai * HALF + wr * 64 + m * 16 + fr) * 4 + wc] = (f32x2v){mw, q};
            }
        asm volatile("s_waitcnt lgkmcnt(0)" ::: "memory"); __builtin_amdgcn_s_barrier(); asm volatile("" ::: "memory");
#if defined(BROKEN_EXCHANGE_NO_WAIT)
#warning BROKEN CONTROL BUILD: the row-statistics exchange does not wait; results are wrong by design
        if (blockIdx.x >= 64) { const long long t0_ = clock64(); while (clock64() - t0_ < 60000) __builtin_amdgcn_s_sleep(8); }
#endif
        const int row = wid * 32 + (lane & 31);
        if (lane < 32) {
            const f32x2v a = P[row * 4 + 0], b = P[row * 4 + 1], c = P[row * 4 + 2], d = P[row * 4 + 3];
            const float mt = (a.x + b.x + c.x + d.x) * 0.25f;
            const float da = a.x - mt, db = b.x - mt, dc = c.x - mt, dd = d.x - mt;
            const float m2 = (a.y + b.y) + (c.y + d.y) + 64.0f * ((da * da + db * db) + (dc * dc + dd * dd));
            unsigned long long* slot = (unsigned long long*)xbuf + ((size_t)(u.pm * BM + row) * 4 + u.pn);
            __hip_atomic_store(slot, ((unsigned long long)__float_as_uint(m2) << 32) | __float_as_uint(mt), __ATOMIC_RELAXED, __HIP_MEMORY_SCOPE_AGENT);
        }
        asm volatile("s_waitcnt vmcnt(0)" ::: "memory");
        if (lane == 0) __hip_atomic_fetch_add(cnt + 64 * u.pm, 1u, __ATOMIC_RELAXED, __HIP_MEMORY_SCOPE_AGENT);
        if (wid == 0) {
            bool dead = false; const unsigned long long t0 = __builtin_amdgcn_s_memrealtime(); const unsigned want = 8u * (unsigned)ntn;
            for (;;) {
#if defined(BROKEN_EXCHANGE_NO_WAIT)
                break;
#endif
                if ((unsigned)__builtin_amdgcn_readfirstlane(__hip_atomic_load(cnt + 64 * u.pm, __ATOMIC_RELAXED, __HIP_MEMORY_SCOPE_AGENT)) >= want) break;
                if (__builtin_amdgcn_s_memrealtime() - t0 > 2000000ull) {
                    if (lane == 0) { unsigned expect = 0u; __hip_atomic_compare_exchange_strong(tmo + 1, &expect, code | (unsigned)(u.pm & 0xff), __ATOMIC_RELAXED, __ATOMIC_RELAXED, __HIP_MEMORY_SCOPE_AGENT);
                                     __hip_atomic_store(tmo, 1u, __ATOMIC_RELAXED, __HIP_MEMORY_SCOPE_AGENT); }
                    dead = true; break; }
                __builtin_amdgcn_s_sleep(2);
            }
            __builtin_amdgcn_fence(__ATOMIC_ACQUIRE, "agent");
            if (lane == 0) flag[0] = dead ? 1u : 0u;
        }
        asm volatile("s_waitcnt vmcnt(0) lgkmcnt(0)" ::: "memory"); __builtin_amdgcn_s_barrier(); asm volatile("" ::: "memory");
        const bool bad = flag[0] != 0u;
        if (lane < 32) {
            const unsigned long long* slot = (const unsigned long long*)xbuf + (size_t)(u.pm * BM + row) * 4; float mt[4], m2[4]; float ms = 0.f;
#pragma unroll
            for (int t = 0; t < 4; ++t) { if (t < ntn) { const unsigned long long w = __hip_atomic_load(slot + t, __ATOMIC_RELAXED, __HIP_MEMORY_SCOPE_AGENT); mt[t] = __uint_as_float((unsigned)w); m2[t] = __uint_as_float((unsigned)(w >> 32)); } else { mt[t] = 0.f; m2[t] = 0.f; } ms += mt[t]; }
            const float mean = ms / (float)ntn; float q = 0.f;
#pragma unroll
            for (int t = 0; t < 4; ++t) if (t < ntn) { const float dm = mt[t] - mean; q += m2[t] + 256.0f * dm * dm; }
            S[row] = (f32x2v){mean, 1.0f / sqrtf(q / (256.0f * (float)ntn) + eps)};
        }
        asm volatile("s_waitcnt lgkmcnt(0)" ::: "memory"); __builtin_amdgcn_s_barrier(); asm volatile("" ::: "memory");
        return bad;
    }
};
struct EpiLnRes {
    static constexpr bool PERM = false, AFTER_DRAIN = true;
    const float* base; float* out; int ldc; const float* bias; PanelStats st; unsigned poison;
    __device__ __forceinline__ void fused(f32x4 (&acc)[2][2][4][2], const Unit& u, int wr, int wc, int fr, int fq, PG8_LAS unsigned char* lds, int wid, int lane) const {
        typedef float f32x2v __attribute__((ext_vector_type(2)));
        const PG8_LAS f32x2v* S = (const PG8_LAS f32x2v*)(lds + 8192);
        const int col0 = u.pn * BM + wc * 32 + 4 * fq;
#pragma unroll
        for (int bj = 0; bj < 2; ++bj)
#pragma unroll
            for (int n = 0; n < 2; ++n) { const f32x4 bv = bias ? *(const f32x4*)(bias + col0 + bj * HALF + n * 16) : (f32x4){0.f, 0.f, 0.f, 0.f};
#pragma unroll
                for (int ai = 0; ai < 2; ++ai)
#pragma unroll
                    for (int m = 0; m < 4; ++m) acc[ai][bj][m][n] += bv; }
        f32x4 pre[4][2][2];
#pragma unroll
        for (int m = 0; m < 4; ++m) { const size_t off = (size_t)(u.pm * BM + wr * 64 + m * 16 + fr) * ldc + col0;
#pragma unroll
            for (int bj = 0; bj < 2; ++bj)
#pragma unroll
                for (int n = 0; n < 2; ++n) pre[m][bj][n] = *(const f32x4*)(base + off + bj * HALF + n * 16); }
        const bool bad = st.run(acc, u, wr, wc, fr, fq, lds, wid, lane) || poison != 0u;
        const float qnan = __builtin_nanf("");
#pragma unroll
        for (int ai = 0; ai < 2; ++ai)
#pragma unroll
            for (int m = 0; m < 4; ++m) { const int r = ai * HALF + wr * 64 + m * 16 + fr; const f32x2v sr = S[r]; const size_t off = (size_t)(u.pm * BM + r) * ldc + col0;
#pragma unroll
                for (int bj = 0; bj < 2; ++bj)
#pragma unroll
                    for (int n = 0; n < 2; ++n) { const f32x4 bs = ai == 0 ? pre[m][bj][n] : *(const f32x4*)(base + off + bj * HALF + n * 16); f32x4 o = bs + (acc[ai][bj][m][n] - sr.x) * sr.y;
                        if (bad) o = (f32x4){qnan, qnan, qnan, qnan}; *(f32x4*)(out + off + bj * HALF + n * 16) = o; }
                if (m & 1) asm volatile("" ::: "memory"); }
    }
};
struct EpiLnResLn {
    static constexpr bool PERM = false, AFTER_DRAIN = true;
    const float* base; float* out; bf16_t* xn; int ldc; const float* bias; PanelStats st1, st2; unsigned poison;
    __device__ __forceinline__ void fused(f32x4 (&acc)[2][2][4][2], const Unit& u, int wr, int wc, int fr, int fq, PG8_LAS unsigned char* lds, int wid, int lane) const {
        typedef float f32x2v __attribute__((ext_vector_type(2))); typedef unsigned u32x2v __attribute__((ext_vector_type(2)));
        const PG8_LAS f32x2v* S = (const PG8_LAS f32x2v*)(lds + 8192);
        const int col0 = u.pn * BM + wc * 32 + 4 * fq;
#pragma unroll
        for (int bj = 0; bj < 2; ++bj)
#pragma unroll
            for (int n = 0; n < 2; ++n) { const f32x4 bv = bias ? *(const f32x4*)(bias + col0 + bj * HALF + n * 16) : (f32x4){0.f, 0.f, 0.f, 0.f};
#pragma unroll
                for (int ai = 0; ai < 2; ++ai)
#pragma unroll
                    for (int m = 0; m < 4; ++m) acc[ai][bj][m][n] += bv; }
        bool bad = st1.run(acc, u, wr, wc, fr, fq, lds, wid, lane) || poison != 0u;
        const float qnan = __builtin_nanf("");
#pragma unroll
        for (int ai = 0; ai < 2; ++ai)
#pragma unroll
            for (int m = 0; m < 4; ++m) { const int r = ai * HALF + wr * 64 + m * 16 + fr; const f32x2v sr = S[r]; const size_t off = (size_t)(u.pm * BM + r) * ldc + col0;
#pragma unroll
                for (int bj = 0; bj < 2; ++bj)
#pragma unroll
                    for (int n = 0; n < 2; ++n) { const f32x4 bs = *(const f32x4*)(base + off + bj * HALF + n * 16); acc[ai][bj][m][n] = bs + (acc[ai][bj][m][n] - sr.x) * sr.y; }
                asm volatile("" : "+v"(acc[ai][0][m][0]), "+v"(acc[ai][0][m][1]), "+v"(acc[ai][1][m][0]), "+v"(acc[ai][1][m][1]));
                if (m & 1) asm volatile("" ::: "memory"); }
        const bool bad1 = bad;
        bad = st2.run(acc, u, wr, wc, fr, fq, lds, wid, lane) || bad;
#pragma unroll
        for (int ai = 0; ai < 2; ++ai)
#pragma unroll
            for (int m = 0; m < 4; ++m) { const int r = ai * HALF + wr * 64 + m * 16 + fr; const f32x2v sr = S[r]; const size_t off = (size_t)(u.pm * BM + r) * ldc + col0;
#pragma unroll
                for (int bj = 0; bj < 2; ++bj)
#pragma unroll
                    for (int n = 0; n < 2; ++n) { const f32x4 x1 = acc[ai][bj][m][n]; *(f32x4*)(out + off + bj * HALF + n * 16) = bad1 ? (f32x4){qnan, qnan, qnan, qnan} : x1;
                        const f32x4 o = (x1 - sr.x) * sr.y; u32x2v w; w.x = cvt_pk_bf16(o[0], o[1]); w.y = cvt_pk_bf16(o[2], o[3]);
                        if (bad) { w.x = 0x7fc07fc0u; w.y = 0x7fc07fc0u; } *(u32x2v*)(xn + off + bj * HALF + n * 16) = w; }
                asm volatile("" ::: "memory"); }
    }
};

template <class Epi, class Sched, bool ALIGN_EPI = false, bool SP2 = false>
__device__ __forceinline__ void gemm_phase(PG8_LAS unsigned char* lds, const Gemm g, const Sched& S, const Epi& E) {
    const int tid = threadIdx.x, wid = __builtin_amdgcn_readfirstlane(tid >> 6), lane = tid & 63, wr = wid >> 2, wc = wid & 3, fr = lane & 15, fq = lane >> 4;
    const int K = g.K, nt = K / BK;
    unsigned voffA[2], voffB[2];
#pragma unroll
    for (int i = 0; i < 2; ++i) { int R, C; stage_rc(tid * 16 + i * 8192, R, C); const int Rb = Epi::PERM ? ((R & ~31) + perm32(R & 31)) : R;
        voffA[i] = (unsigned)(R * K + C) * 2u; voffB[i] = (unsigned)(Rb * K + C) * 2u; }
    const size_t kstep = (size_t)(BK * 2);
    const size_t hstep = (size_t)HALF * K * 2;
    const size_t tstep = 2 * hstep;
    const unsigned ldsw = (unsigned)wid * 1024u;
    const int aoff = lds_byte(wr * 64 + fr, fq * 8), boff = lds_byte(wc * 32 + fr, fq * 8);
#define PG8_SA(b, h) (((b) * 2 + (h)) * HTB)
#define PG8_SB(b, h) ((4 + (b) * 2 + (h)) * HTB)
#define PG8_STAGE(bufoff, gbase, voff) do { _Pragma("unroll") for (int _i = 0; _i < 2; ++_i) \
        __builtin_amdgcn_global_load_lds((const unsigned*)((const char*)(gbase) + (voff)[_i]), (PG8_LAS unsigned*)(lds + (bufoff) + ldsw + _i * 8192), 16, 0, 0); } while (0)
#define PG8_LDA(dst, b, h) do { _Pragma("unroll") for (int m = 0; m < 4; ++m) _Pragma("unroll") for (int k = 0; k < 2; ++k) dst[m][k] = *(const PG8_LAS bf16x8*)(lds + PG8_SA(b, h) + aoff + m * 2048 + k * 1024); } while (0)
#define PG8_LDB(dst, b, h) do { _Pragma("unroll") for (int n = 0; n < 2; ++n) _Pragma("unroll") for (int k = 0; k < 2; ++k) dst[n][k] = *(const PG8_LAS bf16x8*)(lds + PG8_SB(b, h) + boff + n * 2048 + k * 1024); } while (0)
#define PG8_MMA(ai, bj, At, Bt) do { __builtin_amdgcn_s_setprio(1); _Pragma("unroll") for (int m = 0; m < 4; ++m) _Pragma("unroll") for (int n = 0; n < 2; ++n) _Pragma("unroll") for (int k = 0; k < 2; ++k) \
        acc[ai][bj][m][n] = __builtin_amdgcn_mfma_f32_16x16x32_bf16(Bt[n][k], At[m][k], acc[ai][bj][m][n], 0, 0, 0); __builtin_amdgcn_s_setprio(0); } while (0)
#define PG8_WAIT_V(n) asm volatile("s_waitcnt vmcnt(" #n ")" ::: "memory")
#define PG8_WAIT_L(n) asm volatile("s_waitcnt lgkmcnt(" #n ")" ::: "memory")
#define PG8_BAR __builtin_amdgcn_s_barrier()
#define PG8_SCHED __builtin_amdgcn_sched_barrier(0)
    Unit cur, nxt; int ui = 0;
    if (!S.next(0, cur)) return;
    f32x4 acc[2][2][4][2];
#pragma unroll
    for (int a = 0; a < 2; ++a)
#pragma unroll
        for (int b = 0; b < 2; ++b)
#pragma unroll
            for (int m = 0; m < 4; ++m)
#pragma unroll
                for (int n = 0; n < 2; ++n) acc[a][b][m][n] = (f32x4){0.f, 0.f, 0.f, 0.f};
    bf16x8 At[4][2], B0[2][2], B1[2][2];
    const char* cA = (const char*)g.A + (size_t)cur.pm * tstep; const char* cB = (const char*)g.Bt + (size_t)cur.pn * tstep;
    S.a_ready(cur);
    if constexpr (SP2) {
        PG8_STAGE(PG8_SB(0, 0), cB, voffB); PG8_STAGE(PG8_SB(0, 1), cB + hstep, voffB); PG8_STAGE(PG8_SA(0, 0), cA, voffA); PG8_STAGE(PG8_SA(0, 1), cA + hstep, voffA);
        if (wr == 1) PG8_BAR;
        PG8_WAIT_V(2); PG8_BAR;
        PG8_STAGE(PG8_SB(1, 0), cB + kstep, voffB); PG8_STAGE(PG8_SA(1, 0), cA + kstep, voffA); PG8_STAGE(PG8_SB(1, 1), cB + hstep + kstep, voffB);
        PG8_WAIT_V(6); PG8_BAR;
    } else {
        PG8_STAGE(PG8_SB(0, 0), cB, voffB); PG8_STAGE(PG8_SA(0, 0), cA, voffA); PG8_STAGE(PG8_SB(0, 1), cB + hstep, voffB); PG8_STAGE(PG8_SA(0, 1), cA + hstep, voffA);
        if (wr == 1) PG8_BAR;
        PG8_WAIT_V(4); PG8_BAR;
        PG8_STAGE(PG8_SB(1, 0), cB + kstep, voffB); PG8_STAGE(PG8_SA(1, 0), cA + kstep, voffA); PG8_STAGE(PG8_SB(1, 1), cB + hstep + kstep, voffB);
        PG8_WAIT_V(6); PG8_BAR;
    }
    for (;;) {
        const bool has_next = S.next(ui + 1, nxt);
        const char* nA = has_next ? (const char*)g.A + (size_t)nxt.pm * tstep : cA; const char* nB = has_next ? (const char*)g.Bt + (size_t)nxt.pn * tstep : cB;
        for (int t = 0; t < nt; t += 2) {
            const bool last = (t == nt - 2);
            const char* a1 = cA + (size_t)(t + 1) * kstep;
            const char* a2 = last ? nA : cA + (size_t)(t + 2) * kstep; const char* b2 = last ? nB : cB + (size_t)(t + 2) * kstep;
            const char* a3 = a2 + kstep; const char* b3 = b2 + kstep;
            if (last && has_next) S.a_ready(nxt);
            if constexpr (SP2) {
            PG8_LDB(B0, 0, 0); PG8_LDB(B1, 0, 1); PG8_SCHED; PG8_LDA(At, 0, 0); PG8_STAGE(PG8_SA(1, 1), a1 + hstep, voffA);
            PG8_WAIT_V(8); PG8_WAIT_L(0); PG8_BAR; PG8_MMA(0, 0, At, B0); PG8_MMA(0, 1, At, B1); PG8_BAR; PG8_SCHED;
            PG8_LDA(At, 0, 1); PG8_STAGE(PG8_SB(0, 0), b2, voffB); PG8_STAGE(PG8_SB(0, 1), b2 + hstep, voffB); PG8_STAGE(PG8_SA(0, 0), a2, voffA);
            PG8_WAIT_V(8); PG8_WAIT_L(0); PG8_BAR; PG8_MMA(1, 0, At, B0); PG8_MMA(1, 1, At, B1); PG8_BAR; PG8_SCHED;
            PG8_LDB(B0, 1, 0); PG8_LDB(B1, 1, 1); PG8_SCHED; PG8_LDA(At, 1, 0); PG8_STAGE(PG8_SA(0, 1), a2 + hstep, voffA);
            PG8_WAIT_V(8); PG8_WAIT_L(0); PG8_BAR; PG8_MMA(0, 0, At, B0); PG8_MMA(0, 1, At, B1); PG8_BAR; PG8_SCHED;
            PG8_LDA(At, 1, 1); PG8_STAGE(PG8_SB(1, 0), b3, voffB); PG8_STAGE(PG8_SB(1, 1), b3 + hstep, voffB); PG8_STAGE(PG8_SA(1, 0), a3, voffA);
            PG8_WAIT_V(8); PG8_WAIT_L(0); PG8_BAR; PG8_MMA(1, 0, At, B0); PG8_MMA(1, 1, At, B1); PG8_BAR; PG8_SCHED;
            } else {
            PG8_LDB(B0, 0, 0); PG8_SCHED; PG8_LDA(At, 0, 0); PG8_STAGE(PG8_SA(1, 1), a1 + hstep, voffA);
            PG8_WAIT_L(8); PG8_BAR; PG8_WAIT_L(0); PG8_MMA(0, 0, At, B0); PG8_BAR; PG8_SCHED;
            PG8_LDB(B1, 0, 1); PG8_STAGE(PG8_SB(0, 0), b2, voffB);
            PG8_BAR; PG8_WAIT_L(0); PG8_MMA(0, 1, At, B1); PG8_BAR;
            PG8_LDA(At, 0, 1); PG8_STAGE(PG8_SA(0, 0), a2, voffA);
            PG8_BAR; PG8_WAIT_L(0); PG8_MMA(1, 0, At, B0); PG8_BAR; PG8_SCHED;
            PG8_STAGE(PG8_SB(0, 1), b2 + hstep, voffB);
            PG8_WAIT_V(6); PG8_BAR; PG8_MMA(1, 1, At, B1); PG8_BAR;
            PG8_LDB(B0, 1, 0); PG8_SCHED; PG8_LDA(At, 1, 0); PG8_STAGE(PG8_SA(0, 1), a2 + hstep, voffA);
            PG8_WAIT_L(8); PG8_BAR; PG8_WAIT_L(0); PG8_MMA(0, 0, At, B0); PG8_BAR; PG8_SCHED;
            PG8_LDB(B1, 1, 1); PG8_STAGE(PG8_SB(1, 0), b3, voffB);
            PG8_BAR; PG8_WAIT_L(0); PG8_MMA(0, 1, At, B1); PG8_BAR;
            PG8_LDA(At, 1, 1); PG8_STAGE(PG8_SA(1, 0), a3, voffA);
            PG8_BAR; PG8_WAIT_L(0); PG8_MMA(1, 0, At, B0); PG8_BAR; PG8_SCHED;
            PG8_STAGE(PG8_SB(1, 1), b3 + hstep, voffB);
            PG8_WAIT_V(6); PG8_BAR; PG8_MMA(1, 1, At, B1); PG8_BAR;
            }
        }
        if constexpr (ALIGN_EPI) { if (wr == 0) PG8_BAR; }
        if constexpr (!Epi::AFTER_DRAIN) { E(acc, cur, wr, wc, fr, fq); S.done(cur); }
        if (!has_next) break;
#pragma unroll
        for (int a = 0; a < 2; ++a)
#pragma unroll
            for (int b = 0; b < 2; ++b)
#pragma unroll
                for (int m = 0; m < 4; ++m)
#pragma unroll
                    for (int n = 0; n < 2; ++n) acc[a][b][m][n] = (f32x4){0.f, 0.f, 0.f, 0.f};
        cur = nxt; cA = nA; cB = nB; ++ui;
        if constexpr (ALIGN_EPI) { if (wr == 1) PG8_BAR; }
    }
    PG8_WAIT_V(0);
    if constexpr (!ALIGN_EPI) { if (wr == 0) PG8_BAR; }
    PG8_BAR;
    if constexpr (Epi::AFTER_DRAIN) { E.fused(acc, cur, wr, wc, fr, fq, lds, wid, lane); S.done(cur); }
#undef PG8_SA
#undef PG8_SB
#undef PG8_STAGE
#undef PG8_LDA
#undef PG8_LDB
#undef PG8_MMA
#undef PG8_WAIT_V
#undef PG8_WAIT_L
#undef PG8_BAR
#undef PG8_SCHED
}
}
#define GAS __attribute__((address_space(1)))
#define LAS __attribute__((address_space(3)))
typedef unsigned short bf16;
typedef unsigned v4u __attribute__((ext_vector_type(4)));
typedef unsigned v2u __attribute__((ext_vector_type(2)));
typedef float f32x4 __attribute__((ext_vector_type(4)));
typedef float f32x16 __attribute__((ext_vector_type(16)));
typedef short bf16x8 __attribute__((ext_vector_type(8)));
typedef GAS unsigned gu32;
typedef GAS unsigned long long gu64;
#define RLX_AGENT __ATOMIC_RELAXED, __HIP_MEMORY_SCOPE_AGENT
#define LDS_WAIT() asm volatile("s_waitcnt lgkmcnt(0)" ::: "memory")
#define VM_WAIT() asm volatile("s_waitcnt vmcnt(0)" ::: "memory")
__device__ __forceinline__ unsigned f2bf(float f) { unsigned u = __builtin_bit_cast(unsigned, f); return (u + 0x7fffu + ((u >> 16) & 1u)) >> 16; }
__device__ __forceinline__ unsigned pk2(float lo, float hi) { return f2bf(lo) | (f2bf(hi) << 16); }
__device__ __forceinline__ float bf2f(unsigned short v) { return __builtin_bit_cast(float, (unsigned)v << 16); }
__device__ __forceinline__ float bflo(unsigned w) { return __builtin_bit_cast(float, w << 16); }
__device__ __forceinline__ float bfhi(unsigned w) { return __builtin_bit_cast(float, w & 0xffff0000u); }
#define XB_TMO      128
#define XB_XCNT(j)  (256  + 64 * (j))
#define XB_XSUB(j)  (1280 + 64 * (j))
#define XB_XGEN(j)  (2304 + 64 * (j))
#define XB_TOP      3328
#define XB_TOPGEN   3392
#define XCD_BAR_WORDS 3456
#define XB_SPIN_CAP (1u << 18)

__device__ __forceinline__ unsigned xb_ld(unsigned* p)              { return __hip_atomic_load(p, __ATOMIC_RELAXED, __HIP_MEMORY_SCOPE_AGENT); }
__device__ __forceinline__ unsigned xb_add(unsigned* p, unsigned v) { return __hip_atomic_fetch_add(p, v, __ATOMIC_RELAXED, __HIP_MEMORY_SCOPE_AGENT); }
__device__ __forceinline__ unsigned xb_xcc_id() { return (unsigned)__builtin_amdgcn_s_getreg((3 << 11) | 20) & 0xFu; }
#define XB_SPIN(cond, bar) do { unsigned _sp = 0; while (cond) { __builtin_amdgcn_s_sleep(1); \
    if ((++_sp & 255u) == 0u) { if (xb_ld(&(bar)[XB_TMO])) break; if (_sp > XB_SPIN_CAP) { atomicAdd(&(bar)[XB_TMO], 1u); break; } } } } while (0)

struct XcdBarrier {
    unsigned* bar; unsigned x;
    volatile LAS unsigned* st;
};

__device__ __forceinline__ XcdBarrier xcd_barrier_post(unsigned* bar, volatile LAS unsigned* st) {
    XcdBarrier b; b.bar = bar; b.x = xb_xcc_id(); b.st = st;
    if (threadIdx.x == 0) (void)xb_add(&bar[XB_XCNT(b.x)], 1u);
    return b;
}
__device__ __forceinline__ void xcd_barrier_complete(unsigned* bar, unsigned x, unsigned& nloc, unsigned& nx) {
    const unsigned G = gridDim.x * gridDim.y * gridDim.z;
    unsigned sum, cnt, mine, sp = 0u;
    for (;;) {
        sum = 0u; cnt = 0u; mine = 0u;
#pragma unroll
        for (unsigned j = 0; j < 16; ++j) { const unsigned c = xb_ld(&bar[XB_XCNT(j)]); sum += c; cnt += (c > 0u) ? 1u : 0u; mine = (j == x) ? c : mine; }
        if (sum == G) break;
        __builtin_amdgcn_s_sleep(1);
        if ((++sp & 255u) == 0u) { if (xb_ld(&bar[XB_TMO])) break; if (sp > XB_SPIN_CAP) { atomicAdd(&bar[XB_TMO], 1u); break; } }
    }
    nloc = mine > 0u ? mine : 1u; nx = cnt > 0u ? cnt : 1u;
}

__device__ __forceinline__ void xcd_barrier(const XcdBarrier& b) {
    asm volatile("s_waitcnt vmcnt(0)" ::: "memory");
    __syncthreads();
    if (threadIdx.x == 0) {
        unsigned* bar = b.bar;
        __builtin_amdgcn_s_waitcnt(0);
        unsigned nloc = b.st[0], nx = b.st[1];
        if (nloc == 0u) { xcd_barrier_complete(bar, b.x, nloc, nx); b.st[0] = nloc; b.st[1] = nx; }
        const unsigned old = xb_add(&bar[XB_XSUB(b.x)], 1u);
        const unsigned gen = old / nloc;
        if (old + 1u == (gen + 1u) * nloc) {
            __builtin_amdgcn_fence(__ATOMIC_RELEASE, "agent");
            asm volatile("s_waitcnt vmcnt(0)" ::: "memory");
            const unsigned og = xb_add(&bar[XB_TOP], 1u);
            const unsigned tg = og / nx;
            if (og + 1u == (tg + 1u) * nx) xb_add(&bar[XB_TOPGEN], 1u);
            else XB_SPIN(xb_ld(&bar[XB_TOPGEN]) == tg, bar);
            __builtin_amdgcn_fence(__ATOMIC_ACQUIRE, "agent");
            xb_add(&bar[XB_XGEN(b.x)], 1u);
            asm volatile("s_waitcnt vmcnt(0)" ::: "memory");
        } else {
            XB_SPIN(xb_ld(&bar[XB_XGEN(b.x)]) == gen, bar);
            __builtin_amdgcn_fence(__ATOMIC_ACQUIRE, "agent");
            asm volatile("s_waitcnt vmcnt(0)" ::: "memory");
        }
    }
    __syncthreads();
}
constexpr int D = 1024, NB = 4, SEQ = 8192, DEPTH = 2;
constexpr int NBP = 2, M = NBP * SEQ, NPASS = NB / NBP;
constexpr int INW = 5416, PROJW = 2560, GATEW = 3072, WIN_N = PROJW + GATEW;
constexpr int O_U = 0, O_Z = 384, O_XBC = 896, O_DT = 1920, O_CQ = 1928, O_CKV = 2184, O_KR = 2312, O_G = 2344;
constexpr int S5W = 384, S5G = 24, S5P = 64;
constexpr int M2I = 512, M2H = 8, M2P = 64, M2N = 128, M2C = 1024;
constexpr int QR = 256, KVR = 128, AH = 8;
constexpr int PK = 128, PT = 16, PE = 16384;
constexpr float ALPHA = 1.41421356237f;
constexpr int NWAVES = 8, NTHR = 512;

constexpr size_t MiB = 1u << 20;
constexpr size_t WS_CTL = 0, CTL_ZERO_BYTES = 1 * MiB;
constexpr size_t WS_W = 1 * MiB, WL_BYTES = 22 * MiB;
constexpr size_t WO_WIN = 0, WO_WQ = 11 * MiB, WO_WOUT = 15 * MiB, WO_BRA = 17 * MiB, WO_BRB = 17 * MiB + 768 * 1024, WO_BRC = 18 * MiB + 768 * 1024,
                 WO_GLU = 19 * MiB + 768 * 1024, WO_UQ = 20 * MiB + 128 * 1024, WO_KN = 20 * MiB + 512 * 1024, WO_VW = 20 * MiB + 768 * 1024, WO_SK = 21 * MiB;
constexpr size_t WS_WEND = WS_W + DEPTH * WL_BYTES;
constexpr size_t WS_TABU = 45 * MiB, WS_TABV = 77 * MiB;
constexpr size_t WS_HB = 109 * MiB;
constexpr size_t WS_PROJ = 173 * MiB;
constexpr size_t WS_GATES = 253 * MiB;
constexpr size_t WS_YA = 349 * MiB, WS_YB = 361 * MiB, WS_YC = 377 * MiB;
constexpr size_t WS_TMP = 393 * MiB;
constexpr size_t WS_Z = WS_TMP, WS_XT = WS_TMP + 12 * MiB, WS_BN = WS_TMP + 28 * MiB, WS_BT = WS_TMP + 36 * MiB, WS_CN = WS_TMP + 44 * MiB, WS_ST = WS_TMP + 52 * MiB, WS_PREV = WS_TMP + 84 * MiB,
                 WS_CQN = WS_TMP + 100 * MiB, WS_CKVN = WS_TMP + 108 * MiB, WS_ES = WS_TMP + 116 * MiB;
constexpr size_t WS_END = 512 * MiB;
constexpr size_t WS_MERGED = WS_PROJ, WS_TS = WS_PROJ + 32 * MiB, WS_TI = WS_PROJ + 48 * MiB, WS_IDX = WS_PROJ, WS_GW = WS_PROJ + 8 * MiB;
constexpr size_t WS_PQ = WS_GATES;
constexpr size_t OS_Q = 0, OS_KN = 24 * MiB, OS_VT = 40 * MiB, OS_KR = 56 * MiB;
constexpr size_t OS_SDT = 57 * MiB, OS_SAC = 58 * MiB, OS_SW = 59 * MiB, OS_CDEC = 60 * MiB;
constexpr size_t OS_F32 = 0;

struct Params {
    const float* in[36];
    float* out; unsigned char* ws;
};

__device__ __forceinline__ float sigm_f(float x) { return __builtin_amdgcn_rcpf(1.f + __builtin_amdgcn_exp2f(-1.4426950408889634f * x)); }
__device__ __forceinline__ float gelu_t(float x) { const float u = 0.7978845608028654f * (x + 0.044715f * x * x * x); const float e = __builtin_amdgcn_exp2f(2.885390081777927f * u); return x * (1.f - __builtin_amdgcn_rcpf(1.f + e)); }
typedef _Float16 h2_t __attribute__((ext_vector_type(2)));
typedef __bf16 b2_t __attribute__((ext_vector_type(2)));
__device__ __forceinline__ unsigned pkh2(float lo, float hi) { const h2_t h = {(_Float16)lo, (_Float16)hi}; return __builtin_bit_cast(unsigned, h); }
typedef __bf16 b8_t __attribute__((ext_vector_type(8)));
__device__ __forceinline__ float dot8bf(v4u a, v4u b, float c) {
    const b8_t x = __builtin_bit_cast(b8_t, a), y = __builtin_bit_cast(b8_t, b);
    c = __builtin_amdgcn_fdot2_f32_bf16(__builtin_shufflevector(x, x, 0, 1), __builtin_shufflevector(y, y, 0, 1), c, false);
    c = __builtin_amdgcn_fdot2_f32_bf16(__builtin_shufflevector(x, x, 2, 3), __builtin_shufflevector(y, y, 2, 3), c, false);
    c = __builtin_amdgcn_fdot2_f32_bf16(__builtin_shufflevector(x, x, 4, 5), __builtin_shufflevector(y, y, 4, 5), c, false);
    c = __builtin_amdgcn_fdot2_f32_bf16(__builtin_shufflevector(x, x, 6, 7), __builtin_shufflevector(y, y, 6, 7), c, false);
    return c; }
__device__ __forceinline__ unsigned fbits(float f) { return __builtin_bit_cast(unsigned, f); }
__device__ __forceinline__ float bitsf(unsigned u) { return __builtin_bit_cast(float, u); }
__device__ __forceinline__ float hlo(unsigned w) { const h2_t h = __builtin_bit_cast(h2_t, w); return (float)h.x; }
__device__ __forceinline__ float hhi(unsigned w) { const h2_t h = __builtin_bit_cast(h2_t, w); return (float)h.y; }
__device__ __forceinline__ float wsum(float v) {
#pragma unroll
    for (int o = 32; o > 0; o >>= 1) v += __shfl_xor(v, o);
    return v; }

namespace pg8 {
struct EpiProj {
    static constexpr bool PERM = true, AFTER_DRAIN = false;
    bf16_t* proj; bf16_t* gates;
    __device__ __forceinline__ void operator()(const f32x4 (&acc)[2][2][4][2], const Unit& u, int wr, int wc, int fr, int fq) const {
        const int row0 = u.pm * BM + wr * 64 + fr; const bool isg = u.pn >= 10;
        bf16_t* base = isg ? gates : proj; const int ldc = isg ? 3072 : 2560; const int col0 = (isg ? (u.pn - 10) : u.pn) * BM + wc * 32 + 8 * fq;
#pragma unroll
        for (int ai = 0; ai < 2; ++ai)
#pragma unroll
            for (int m = 0; m < 4; ++m) { bf16_t* rowp = base + (size_t)(row0 + ai * HALF + m * 16) * ldc + col0;
#pragma unroll
                for (int bj = 0; bj < 2; ++bj) { f32x4 v0 = acc[ai][bj][m][0], v1 = acc[ai][bj][m][1];
                    if (isg) {
#pragma unroll
                        for (int e = 0; e < 4; ++e) { v0[e] = sigm_f(v0[e]); v1[e] = sigm_f(v1[e]); } }
                    u32x4 w; w.x = cvt_pk_bf16(v0[0], v0[1]); w.y = cvt_pk_bf16(v0[2], v0[3]); w.z = cvt_pk_bf16(v1[0], v1[1]); w.w = cvt_pk_bf16(v1[2], v1[3]);
                    *(u32x4*)(rowp + bj * HALF) = w; } }
    }
};
struct EpiGlu {
    static constexpr bool PERM = true, AFTER_DRAIN = false;
    const bf16_t* z; bf16_t* ya;
    __device__ __forceinline__ void operator()(const f32x4 (&acc)[2][2][4][2], const Unit& u, int wr, int wc, int fr, int fq) const {
        const int row0 = u.pm * BM + wr * 64 + fr; const int col0 = u.pn * BM + wc * 32 + 8 * fq;
#pragma unroll
        for (int ai = 0; ai < 2; ++ai)
#pragma unroll
            for (int m = 0; m < 4; ++m) { const size_t ro = (size_t)(row0 + ai * HALF + m * 16) * 384;
#pragma unroll
                for (int bj = 0; bj < 2; ++bj) { const int c = col0 + bj * HALF; if (c < 384) {
                    const u32x4 zz = *(const u32x4*)(z + ro + c); const f32x4 v0 = acc[ai][bj][m][0], v1 = acc[ai][bj][m][1];
                    float zf[8] = {__builtin_bit_cast(float, zz.x << 16), __builtin_bit_cast(float, zz.x & 0xffff0000u), __builtin_bit_cast(float, zz.y << 16), __builtin_bit_cast(float, zz.y & 0xffff0000u),
                                   __builtin_bit_cast(float, zz.z << 16), __builtin_bit_cast(float, zz.z & 0xffff0000u), __builtin_bit_cast(float, zz.w << 16), __builtin_bit_cast(float, zz.w & 0xffff0000u)};
                    u32x4 w; w.x = cvt_pk_bf16(zf[0] * sigm_f(v0[0]), zf[1] * sigm_f(v0[1])); w.y = cvt_pk_bf16(zf[2] * sigm_f(v0[2]), zf[3] * sigm_f(v0[3]));
                    w.z = cvt_pk_bf16(zf[4] * sigm_f(v1[0]), zf[5] * sigm_f(v1[1])); w.w = cvt_pk_bf16(zf[6] * sigm_f(v1[2]), zf[7] * sigm_f(v1[3]));
                    *(u32x4*)(ya + ro + c) = w; } } }
    }
};
template <int GI> struct EpiMerge {
    static constexpr bool PERM = false, AFTER_DRAIN = false;
    const bf16_t* gates; float* rsum; bf16_t* merged;
    __device__ __forceinline__ void operator()(const f32x4 (&acc)[2][2][4][2], const Unit& u, int wr, int wc, int fr, int fq) const {
        const int row0 = u.pm * BM + wr * 64 + fr; const int col0 = u.pn * BM + wc * 32 + 4 * fq;
#pragma unroll
        for (int ai = 0; ai < 2; ++ai)
#pragma unroll
            for (int m = 0; m < 4; ++m) { const size_t row = (size_t)(row0 + ai * HALF + m * 16);
#pragma unroll
                for (int bj = 0; bj < 2; ++bj)
#pragma unroll
                    for (int n = 0; n < 2; ++n) { const int c = col0 + bj * HALF + 16 * n;
                        const unsigned long long gg = *(const unsigned long long*)(gates + row * 3072 + GI * 1024 + c); const unsigned g0 = (unsigned)gg, g1 = (unsigned)(gg >> 32);
                        f32x4 v = acc[ai][bj][m][n];
                        v[0] *= __builtin_bit_cast(float, g0 << 16); v[1] *= __builtin_bit_cast(float, g0 & 0xffff0000u); v[2] *= __builtin_bit_cast(float, g1 << 16); v[3] *= __builtin_bit_cast(float, g1 & 0xffff0000u);
                        if (GI > 0) v += *(const f32x4*)(rsum + row * 1024 + c);
                        if (GI < 2) *(f32x4*)(rsum + row * 1024 + c) = v;
                        else { const unsigned long long o = (unsigned long long)cvt_pk_bf16(v[0], v[1]) | ((unsigned long long)cvt_pk_bf16(v[2], v[3]) << 32); *(unsigned long long*)(merged + row * 1024 + c) = o; } } }
    }
};
struct EpiF32 {
    static constexpr bool PERM = false, AFTER_DRAIN = false;
    float* O; int ldc;
    __device__ __forceinline__ void operator()(const f32x4 (&acc)[2][2][4][2], const Unit& u, int wr, int wc, int fr, int fq) const {
        const int row0 = u.pm * BM + wr * 64 + fr; const int col0 = u.pn * BM + wc * 32 + 4 * fq;
#pragma unroll
        for (int ai = 0; ai < 2; ++ai)
#pragma unroll
            for (int m = 0; m < 4; ++m) { float* rowp = O + (size_t)(row0 + ai * HALF + m * 16) * ldc + col0;
#pragma unroll
                for (int bj = 0; bj < 2; ++bj)
#pragma unroll
                    for (int n = 0; n < 2; ++n) *(f32x4*)(rowp + bj * HALF + 16 * n) = acc[ai][bj][m][n]; }
    }
};
}

struct Bufs {
    bf16 *HB, *PROJ, *GATES, *YA, *YB, *YC, *Z, *XT, *BN, *BT, *CN, *PREV, *CQN, *CKVN, *Q, *KN, *VT, *KR, *MERGED, *PQ, *TABU, *TABV;
    float *ST, *SDT, *SAC, *SW, *CDEC, *F32, *TS, *GW, *ES; int *TI, *IDX;
};
__host__ __device__ __forceinline__ unsigned char* wl_ptr(const Params& p, int l) { return p.ws + WS_W + (size_t)l * WL_BYTES; }
__host__ __device__ __forceinline__ Bufs make_bufs(const Params& p) {
    Bufs b; unsigned char* ws = p.ws; unsigned char* os = (unsigned char*)p.out + 64 * MiB;
    b.HB = (bf16*)(ws + WS_HB); b.PROJ = (bf16*)(ws + WS_PROJ); b.GATES = (bf16*)(ws + WS_GATES); b.YA = (bf16*)(ws + WS_YA); b.YB = (bf16*)(ws + WS_YB); b.YC = (bf16*)(ws + WS_YC);
    b.Z = (bf16*)(ws + WS_Z); b.XT = (bf16*)(ws + WS_XT); b.BN = (bf16*)(ws + WS_BN); b.BT = (bf16*)(ws + WS_BT); b.CN = (bf16*)(ws + WS_CN); b.ST = (float*)(ws + WS_ST); b.PREV = (bf16*)(ws + WS_PREV);
    b.SDT = (float*)(os + OS_SDT); b.SAC = (float*)(os + OS_SAC); b.SW = (float*)(os + OS_SW); b.CDEC = (float*)(os + OS_CDEC); b.CQN = (bf16*)(ws + WS_CQN); b.CKVN = (bf16*)(ws + WS_CKVN);
    b.Q = (bf16*)(os + OS_Q); b.KN = (bf16*)(os + OS_KN); b.VT = (bf16*)(os + OS_VT); b.KR = (bf16*)(os + OS_KR); b.F32 = (float*)(os + OS_F32);
    b.MERGED = (bf16*)(ws + WS_MERGED); b.PQ = (bf16*)(ws + WS_PQ); b.TABU = (bf16*)(ws + WS_TABU); b.TABV = (bf16*)(ws + WS_TABV);
    b.ES = (float*)(ws + WS_ES); b.TS = (float*)(ws + WS_TS); b.TI = (int*)(ws + WS_TI); b.IDX = (int*)(ws + WS_IDX); b.GW = (float*)(ws + WS_GW);
    return b;
}

__device__ __forceinline__ void tr_item(const float* W, int ldw, int col0, int ncols, bf16* WT, int Kd, int row0, LAS float* scr, int item, int lane) {
    const int nblk = (ncols + 31) / 32, kb = item / nblk, nb = item % nblk, k0 = 64 * kb, n0 = 32 * nb;
    const int nn = n0 + (lane & 31); const bool cv = nn < ncols;
#pragma unroll 8
    for (int i = 0; i < 32; ++i) { const int kk = 2 * i + (lane >> 5); scr[kk * 33 + (lane & 31)] = cv ? W[(size_t)(k0 + kk) * ldw + col0 + nn] : 0.f; }
    LDS_WAIT(); asm volatile("" ::: "memory");
    const int c = lane & 7;
#pragma unroll
    for (int j = 0; j < 4; ++j) { const int n = (lane >> 3) + 8 * j; const LAS float* s = scr + (8 * c) * 33 + n;
        v4u o; o.x = pk2(s[0 * 33], s[1 * 33]); o.y = pk2(s[2 * 33], s[3 * 33]); o.z = pk2(s[4 * 33], s[5 * 33]); o.w = pk2(s[6 * 33], s[7 * 33]);
        if (n0 + n < ncols) *(GAS v4u*)(WT + (size_t)(row0 + n0 + n) * Kd + k0 + 8 * c) = o; }
    LDS_WAIT(); asm volatile("" ::: "memory");
}
constexpr int NSEG = 25;
struct Seg { const float* W; int ldw, Ks, col0, ncols; bf16* WT; int Kd, row0; };
__device__ __forceinline__ Seg get_seg(const Params& p, const Bufs& B, int s) {
    const int l = s / NSEG, k = s % NSEG; unsigned char* wl = wl_ptr(p, l); Seg g;
    switch (k) {
    case 0: g = Seg{p.in[4] + (size_t)l * D * INW, INW, D, 0, O_G, (bf16*)(wl + WO_WIN), D, 0}; break;
    case 1: g = Seg{p.in[4] + (size_t)l * D * INW, INW, D, O_G, 3072, (bf16*)(wl + WO_WIN), D, PROJW}; break;
    case 2: g = Seg{p.in[30] + (size_t)l * D * 2048, 2048, D, 0, 2048, (bf16*)(wl + WO_WQ), D, 0}; break;
    case 3: g = Seg{p.in[27] + (size_t)l * D * D, D, D, 0, D, (bf16*)(wl + WO_WOUT), D, 0}; break;
    case 4: g = Seg{p.in[24] + (size_t)l * S5W * D, D, S5W, 0, D, (bf16*)(wl + WO_BRA), S5W, 0}; break;
    case 5: g = Seg{p.in[25] + (size_t)l * M2I * D, D, M2I, 0, D, (bf16*)(wl + WO_BRB), M2I, 0}; break;
    case 6: g = Seg{p.in[26] + (size_t)l * 512 * D, D, 512, 0, D, (bf16*)(wl + WO_BRC), 512, 0}; break;
    case 7: g = Seg{p.in[13] + (size_t)l * S5W * S5W, S5W, S5W, 0, S5W, (bf16*)(wl + WO_GLU), S5W, 0}; break;
    case 8: g = Seg{p.in[21] + (size_t)l * QR * 768, 768, QR, 0, 768, (bf16*)(wl + WO_UQ), QR, 0}; break;
    default: { const int hh = (k - 9) >> 1, isv = (k - 9) & 1;
        g = Seg{p.in[23] + (size_t)l * KVR * 1024, 1024, KVR, hh * 128 + isv * 64, 64, (bf16*)(wl + (isv ? WO_VW : WO_KN)), 256, hh * 64}; } break;
    }
    return g;
}
__global__ void __launch_bounds__(NTHR, 2) k_prologue(Params p) {
    extern __shared__ __attribute__((aligned(16))) unsigned char lds[];
    const Bufs B = make_bufs(p);
    const int tid = threadIdx.x, lane = tid & 63, wave = tid >> 6;
    LAS float* scr = (LAS float*)((LAS unsigned char*)lds + wave * 8448);
    const int gw = blockIdx.x * NWAVES + wave, NGW = gridDim.x * NWAVES;
    for (int s = 0; s < DEPTH * NSEG; ++s) {
        const Seg g = get_seg(p, B, s); const int nitems = ((g.ncols + 31) / 32) * (g.Ks / 64);
        for (int it = gw; it < nitems; it += NGW) tr_item(g.W, g.ldw, g.col0, g.ncols, g.WT, g.Kd, g.row0, scr, it, lane);
    }
    for (int l = 0; l < DEPTH; ++l) { const float* sk = p.in[31] + (size_t)l * 2 * PK * 128; bf16* dk = (bf16*)(wl_ptr(p, l) + WO_SK);
        for (int i = gw * 64 + lane; i < 2 * PK * 128; i += NGW * 64) dk[i] = (bf16)f2bf(sk[i]); }
    const float* gg = p.in[2]; const float* bb = p.in[3];
    for (int r = gw; r < NB * SEQ; r += NGW) {
        const GAS f32x4* xr = (const GAS f32x4*)(p.in[0] + (size_t)r * D) + lane;
        f32x4 v[4]; float s = 0.f;
#pragma unroll
        for (int j = 0; j < 4; ++j) { v[j] = xr[64 * j]; s += (v[j].x + v[j].y) + (v[j].z + v[j].w); }
        const float mean = wsum(s) * (1.f / D); float s2 = 0.f;
#pragma unroll
        for (int j = 0; j < 4; ++j) { v[j] = v[j] - mean; s2 += (v[j].x * v[j].x + v[j].y * v[j].y) + (v[j].z * v[j].z + v[j].w * v[j].w); }
        const float rstd = 1.f / sqrtf(wsum(s2) * (1.f / D) + 1e-5f);
        GAS unsigned long long* o8 = (GAS unsigned long long*)(B.HB + (size_t)r * D) + lane;
#pragma unroll
        for (int j = 0; j < 4; ++j) { const f32x4 g4 = *(const f32x4*)(gg + 4 * lane + 256 * j), b4 = *(const f32x4*)(bb + 4 * lane + 256 * j);
            o8[64 * j] = (unsigned long long)pk2(v[j].x * rstd * g4.x + b4.x, v[j].y * rstd * g4.y + b4.y) | ((unsigned long long)pk2(v[j].z * rstd * g4.z + b4.z, v[j].w * rstd * g4.w + b4.w) << 32); }
    }
}
__global__ void __launch_bounds__(NTHR, 2) k_tables(Params p, int l) {
    const Bufs B = make_bufs(p);
    const size_t n4 = (size_t)PE * D / 4; const size_t gt = (size_t)blockIdx.x * NTHR + threadIdx.x, NG = (size_t)gridDim.x * NTHR;
    const f32x4* su = (const f32x4*)(p.in[32] + (size_t)l * PE * D); const f32x4* sv = (const f32x4*)(p.in[33] + (size_t)l * PE * D);
    v2u* du = (v2u*)B.TABU; v2u* dv = (v2u*)B.TABV;
    for (size_t i = gt; i < n4; i += NG) { const f32x4 a = su[i], b = sv[i]; du[i] = (v2u){pk2(a.x, a.y), pk2(a.z, a.w)}; dv[i] = (v2u){pkh2(b.x, b.y), pkh2(b.z, b.w)}; }
}

enum { G_PROJ = 0, G_GLU, G_Q, G_KN, G_VT, G_M0, G_M1, G_M2, G_OUT, G_PQ };
template <int KIND> __global__ void __launch_bounds__(NTHR, 2) k_gemm_ph(Params p, int l, int pass) {
    extern __shared__ __attribute__((aligned(16))) unsigned char lds[];
    const Bufs B = make_bufs(p); unsigned char* wl = wl_ptr(p, l);
    PG8_LAS unsigned char* L = (PG8_LAS unsigned char*)lds;
    const bf16* hb = B.HB + (size_t)pass * M * D;
    pg8::StaticOrder S;
    if constexpr (KIND == G_PROJ) { pg8::Gemm g{hb, (const bf16*)(wl + WO_WIN), M, WIN_N, D}; S.init(M, WIN_N, gridDim.x, blockIdx.x); pg8::EpiProj E{B.PROJ, B.GATES};
        pg8::gemm_phase<pg8::EpiProj, pg8::StaticOrder, true, true>(L, g, S, E); }
    if constexpr (KIND == G_GLU) { pg8::Gemm g{B.Z, (const bf16*)(wl + WO_GLU), M, 512, S5W}; S.init(M, 512, gridDim.x, blockIdx.x); pg8::EpiGlu E{B.Z, B.YA};
        pg8::gemm_phase<pg8::EpiGlu, pg8::StaticOrder, true, true>(L, g, S, E); }
    if constexpr (KIND == G_Q) { pg8::Gemm g{B.CQN, (const bf16*)(wl + WO_UQ), M, 768, QR}; S.init(M, 768, gridDim.x, blockIdx.x); pg8::EpiBf16<0> E{B.Q, 768, nullptr, 0, 0, 1.f};
        pg8::gemm_phase<pg8::EpiBf16<0>, pg8::StaticOrder, true, true>(L, g, S, E); }
    if constexpr (KIND == G_KN) { pg8::Gemm g{B.CKVN, (const bf16*)(wl + WO_KN), M, 512, 256}; S.init(M, 512, gridDim.x, blockIdx.x); pg8::EpiBf16<0> E{B.KN, 512, nullptr, 0, 0, 1.f};
        pg8::gemm_phase<pg8::EpiBf16<0>, pg8::StaticOrder, true, true>(L, g, S, E); }
    if constexpr (KIND == G_VT) { pg8::Gemm g{(const bf16*)(wl + WO_VW), B.CKVN, 512, M, 256}; S.init(512, M, gridDim.x, blockIdx.x); pg8::EpiBf16<0> E{B.VT, M, nullptr, 0, 0, 1.f};
        pg8::gemm_phase<pg8::EpiBf16<0>, pg8::StaticOrder, true, true>(L, g, S, E); }
    if constexpr (KIND == G_M0) { pg8::Gemm g{B.YA, (const bf16*)(wl + WO_BRA), M, D, S5W}; S.init(M, D, gridDim.x, blockIdx.x); pg8::EpiMerge<0> E{B.GATES, B.F32, B.MERGED};
        pg8::gemm_phase<pg8::EpiMerge<0>, pg8::StaticOrder, true, true>(L, g, S, E); }
    if constexpr (KIND == G_M1) { pg8::Gemm g{B.YB, (const bf16*)(wl + WO_BRB), M, D, M2I}; S.init(M, D, gridDim.x, blockIdx.x); pg8::EpiMerge<1> E{B.GATES, B.F32, B.MERGED};
        pg8::gemm_phase<pg8::EpiMerge<1>, pg8::StaticOrder, true, true>(L, g, S, E); }
    if constexpr (KIND == G_M2) { pg8::Gemm g{B.YC, (const bf16*)(wl + WO_BRC), M, D, 512}; S.init(M, D, gridDim.x, blockIdx.x); pg8::EpiMerge<2> E{B.GATES, B.F32, B.MERGED};
        pg8::gemm_phase<pg8::EpiMerge<2>, pg8::StaticOrder, true, true>(L, g, S, E); }
    if constexpr (KIND == G_OUT) { pg8::Gemm g{B.MERGED, (const bf16*)(wl + WO_WOUT), M, D, D}; S.init(M, D, gridDim.x, blockIdx.x); pg8::EpiF32 E{B.F32, D};
        pg8::gemm_phase<pg8::EpiF32, pg8::StaticOrder, true, true>(L, g, S, E); }
    if constexpr (KIND == G_PQ) { pg8::Gemm g{hb, (const bf16*)(wl + WO_WQ), M, 2048, D}; S.init(M, 2048, gridDim.x, blockIdx.x); pg8::EpiBf16<0> E{B.PQ, 2048, nullptr, 0, 0, 1.f};
        pg8::gemm_phase<pg8::EpiBf16<0>, pg8::StaticOrder, true, true>(L, g, S, E); }
}

typedef float f32x2 __attribute__((ext_vector_type(2)));
constexpr int S5_CH = 64, S5_NCH = SEQ / S5_CH, S5_UT = S5_CH * S5W * 4, S5_XP = 136, S5_XT = 16 * S5_XP * 2, S5_LDS = S5_UT + NWAVES * S5_XT;
struct S5Lane { float ar, ai, lr, li, dt; };
__device__ __forceinline__ S5Lane s5_lane(const Params& p, int l, int g, int pl, float (&bbr)[16], float (&bbi)[16]) {
    S5Lane L; L.lr = p.in[5][(l * S5G + g) * S5P + pl]; L.li = p.in[6][(l * S5G + g) * S5P + pl]; L.dt = expf(p.in[7][l * S5G + g]);
    const float mag = expf(L.lr * L.dt); L.ar = mag * cosf(L.li * L.dt); L.ai = mag * sinf(L.li * L.dt);
    const float nr = L.ar - 1.f, ni = L.ai, den = L.lr * L.lr + L.li * L.li;
    const float cr = (nr * L.lr + ni * L.li) / den, ci = (ni * L.lr - nr * L.li) / den;
    const f32x4* br4 = (const f32x4*)(p.in[8] + ((size_t)(l * S5G + g) * S5P + pl) * 16); const f32x4* bi4 = (const f32x4*)(p.in[9] + ((size_t)(l * S5G + g) * S5P + pl) * 16);
#pragma unroll
    for (int q = 0; q < 4; ++q) { const f32x4 br = br4[q], bi = bi4[q];
#pragma unroll
        for (int e = 0; e < 4; ++e) { bbr[4 * q + e] = cr * br[e] - ci * bi[e]; bbi[4 * q + e] = cr * bi[e] + ci * br[e]; } }
    return L;
}
__device__ __forceinline__ void s5_load_u(const Bufs& B, int row0, LAS unsigned char* lds) {
    for (int i = threadIdx.x; i < S5_CH * 48; i += NTHR) { const int r = i / 48, ch = i % 48;
        const v4u v = *(const v4u*)(B.PROJ + (size_t)(row0 + r) * PROJW + O_U + ch * 8);
        LAS f32x4* d = (LAS f32x4*)(lds + (r * S5W + ch * 8) * 4);
        d[0] = (f32x4){bflo(v.x), bfhi(v.x), bflo(v.y), bfhi(v.y)}; d[1] = (f32x4){bflo(v.z), bfhi(v.z), bflo(v.w), bfhi(v.w)}; }
}
__device__ __forceinline__ void s5a_phase(const Params& p, const Bufs& B, int l, LAS unsigned char* lds) {
    const int tid = threadIdx.x, lane = tid & 63, w = tid >> 6;
    for (int task = blockIdx.x; task < NBP * S5_NCH; task += gridDim.x) {
        const int sq = task / S5_NCH, c = task % S5_NCH, row0 = sq * SEQ + c * S5_CH;
        s5_load_u(B, row0, lds); __syncthreads();
        for (int gi = 0; gi < 3; ++gi) { const int g = 3 * w + gi; float bbr[16], bbi[16]; const S5Lane L = s5_lane(p, l, g, lane, bbr, bbi);
            float xr = 0.f, xi = 0.f;
            for (int t = 0; t < S5_CH; ++t) { const LAS f32x4* u4 = (const LAS f32x4*)(lds + (t * S5W + g * 16) * 4); float bur = 0.f, bui = 0.f;
#pragma unroll
                for (int q = 0; q < 4; ++q) { const f32x4 u = u4[q];
#pragma unroll
                    for (int e = 0; e < 4; ++e) { bur = fmaf(bbr[4 * q + e], u[e], bur); bui = fmaf(bbi[4 * q + e], u[e], bui); } }
                const float nxr = L.ar * xr - L.ai * xi + bur, nxi = L.ar * xi + L.ai * xr + bui; xr = nxr; xi = nxi; }
            *(f32x2*)(B.ES + ((((size_t)sq * S5_NCH + c) * S5G + g) * S5P + lane) * 2) = (f32x2){xr, xi};
        }
        __syncthreads();
    }
}
__device__ __forceinline__ void s5scan_phase(const Params& p, const Bufs& B, int l, int gtid, int gthreads) {
    for (int ch = gtid; ch < NBP * S5G * S5P; ch += gthreads) {
        const int sq = ch / (S5G * S5P), rem = ch % (S5G * S5P), g = rem >> 6, pl = rem & 63;
        const float lr = p.in[5][(l * S5G + g) * S5P + pl], li = p.in[6][(l * S5G + g) * S5P + pl], dt = expf(p.in[7][l * S5G + g]);
        const float mg = expf(lr * dt * (float)S5_CH), Ar = mg * cosf(li * dt * (float)S5_CH), Ai = mg * sinf(li * dt * (float)S5_CH);
        f32x2* E = (f32x2*)B.ES + (size_t)sq * S5_NCH * S5G * S5P + rem; const size_t cs = (size_t)S5G * S5P;
        float cr = 0.f, ci = 0.f;
        for (int c0 = 0; c0 < S5_NCH; c0 += 16) { f32x2 e[16];
#pragma unroll
            for (int k = 0; k < 16; ++k) e[k] = E[(size_t)(c0 + k) * cs];
#pragma unroll
            for (int k = 0; k < 16; ++k) { E[(size_t)(c0 + k) * cs] = (f32x2){cr, ci}; const float nr = Ar * cr - Ai * ci + e[k].x, ni = Ar * ci + Ai * cr + e[k].y; cr = nr; ci = ni; } }
    }
}
__device__ __forceinline__ void s5b_phase(const Params& p, const Bufs& B, int l, LAS unsigned char* lds) {
    const int tid = threadIdx.x, lane = tid & 63, w = tid >> 6, fr = lane & 15, fq = lane >> 4;
    LAS unsigned char* xt = lds + S5_UT + w * S5_XT;
    for (int task = blockIdx.x; task < NBP * S5_NCH; task += gridDim.x) {
        const int sq = task / S5_NCH, c = task % S5_NCH, row0 = sq * SEQ + c * S5_CH;
        s5_load_u(B, row0, lds); __syncthreads();
        for (int gi = 0; gi < 3; ++gi) { const int g = 3 * w + gi; float bbr[16], bbi[16]; const S5Lane L = s5_lane(p, l, g, lane, bbr, bbi);
            bf16x8 cf[4];
#pragma unroll
            for (int ks = 0; ks < 4; ++ks) { const float* src = (ks < 2 ? p.in[10] : p.in[11]) + ((size_t)(l * S5G + g) * 16 + fr) * S5P + 32 * (ks & 1) + 8 * fq; const float sg = ks < 2 ? 1.f : -1.f;
                const f32x4 a = *(const f32x4*)src, b = *(const f32x4*)(src + 4);
                cf[ks] = __builtin_bit_cast(bf16x8, (v4u){pk2(sg * a[0], sg * a[1]), pk2(sg * a[2], sg * a[3]), pk2(sg * b[0], sg * b[1]), pk2(sg * b[2], sg * b[3])}); }
            const float dsk = p.in[12][l * S5W + g * 16 + fr];
            const f32x2 cin = *(const f32x2*)(B.ES + ((((size_t)sq * S5_NCH + c) * S5G + g) * S5P + lane) * 2);
            float xr = cin.x, xi = cin.y;
            for (int tb = 0; tb < S5_CH; tb += 16) {
#pragma unroll 4
                for (int tt = 0; tt < 16; ++tt) { const int t = tb + tt; const LAS f32x4* u4 = (const LAS f32x4*)(lds + (t * S5W + g * 16) * 4); float bur = 0.f, bui = 0.f;
#pragma unroll
                    for (int q = 0; q < 4; ++q) { const f32x4 u = u4[q];
#pragma unroll
                        for (int e = 0; e < 4; ++e) { bur = fmaf(bbr[4 * q + e], u[e], bur); bui = fmaf(bbi[4 * q + e], u[e], bui); } }
                    const float nxr = L.ar * xr - L.ai * xi + bur, nxi = L.ar * xi + L.ai * xr + bui; xr = nxr; xi = nxi;
                    *(LAS unsigned short*)(xt + (tt * S5_XP + lane) * 2) = (unsigned short)f2bf(xr); *(LAS unsigned short*)(xt + (tt * S5_XP + 64 + lane) * 2) = (unsigned short)f2bf(xi); }
                LDS_WAIT(); asm volatile("" ::: "memory");
                f32x4 acc = {0.f, 0.f, 0.f, 0.f};
#pragma unroll
                for (int ks = 0; ks < 4; ++ks) { const bf16x8 a = *(const LAS bf16x8*)(xt + (fr * S5_XP + 32 * ks + 8 * fq) * 2); acc = __builtin_amdgcn_mfma_f32_16x16x32_bf16(a, cf[ks], acc, 0, 0, 0); }
                LDS_WAIT(); asm volatile("" ::: "memory");
#pragma unroll
                for (int j = 0; j < 4; ++j) { const int t = tb + 4 * fq + j; const float u = *(const LAS float*)(lds + (t * S5W + g * 16 + fr) * 4);
                    B.Z[(size_t)(row0 + t) * S5W + g * 16 + fr] = (bf16)f2bf(gelu_t(acc[j] + dsk * u)); }
            }
        }
        __syncthreads();
    }
}
__global__ void __launch_bounds__(NTHR, 2) k_s5a(Params p, int l) { extern __shared__ __attribute__((aligned(16))) unsigned char lds[]; const Bufs B = make_bufs(p); s5a_phase(p, B, l, (LAS unsigned char*)lds); }
__global__ void __launch_bounds__(NTHR, 2) k_s5scan(Params p, int l) { const Bufs B = make_bufs(p); s5scan_phase(p, B, l, blockIdx.x * NTHR + threadIdx.x, gridDim.x * NTHR); }
__global__ void __launch_bounds__(NTHR, 2) k_s5b(Params p, int l) { extern __shared__ __attribute__((aligned(16))) unsigned char lds[]; const Bufs B = make_bufs(p); s5b_phase(p, B, l, (LAS unsigned char*)lds); }

constexpr int SC = 128, NCK = M / SC;
constexpr int XC_RP = 136, XC_RAW = 131 * XC_RP * 2, XC_T = 128 * XC_RP * 2, XC_LDS = XC_RAW + XC_T;
__device__ __forceinline__ void xc_phase(const Params& p, const Bufs& B, int l, LAS unsigned char* lds) {
    const int tid = threadIdx.x, lane = tid & 63, w = tid >> 6;
    const float* cw = p.in[14] + (size_t)l * 4 * M2C; const float* cb_ = p.in[15] + l * M2C;
    LAS unsigned char* raw = lds; LAS unsigned char* T = lds + XC_RAW;
    for (int task = blockIdx.x; task < NCK * 8; task += gridDim.x) {
        const int ck = task >> 3, cb = task & 7, c = ck & 63, row0 = ck * SC, ch0 = cb * 128;
        for (int i = tid; i < 131 * 16; i += NTHR) { const int r = i >> 4, q = i & 15;
            v4u v = {0u, 0u, 0u, 0u}; if (!(c == 0 && r < 3)) v = *(const v4u*)(B.PROJ + (size_t)(row0 - 3 + r) * PROJW + O_XBC + ch0 + q * 8);
            *(LAS v4u*)(raw + (r * XC_RP + q * 8) * 2) = v; }
        __syncthreads();
        const int cp = tid & 63, lq = tid >> 6; const int chA = ch0 + 2 * cp;
        float wk[4][2]; for (int k = 0; k < 4; ++k) { wk[k][0] = cw[k * M2C + chA]; wk[k][1] = cw[k * M2C + chA + 1]; }
        const float b0 = cb_[chA], b1 = cb_[chA + 1];
        const bool nat = cb >= 4, tr = cb < 6;
        bf16* dnat = cb >= 6 ? B.CN + ((size_t)(ck * 2 + (cb - 6)) * SC) * 128 : B.BN + ((size_t)(ck * 2 + (cb - 4)) * SC) * 128;
        for (int i = 0; i < 16; ++i) { const int ll = lq * 16 + i; float s0 = b0, s1 = b1;
#pragma unroll
            for (int k = 0; k < 4; ++k) { const unsigned x = *(const LAS unsigned*)(raw + ((ll + k) * XC_RP + 2 * cp) * 2); s0 = fmaf(wk[k][0], bflo(x), s0); s1 = fmaf(wk[k][1], bfhi(x), s1); }
            const float y0 = s0 * sigm_f(s0), y1 = s1 * sigm_f(s1);
            if (nat) *(unsigned*)(dnat + (size_t)ll * 128 + 2 * cp) = pk2(y0, y1);
            if (tr) { *(LAS unsigned short*)(T + ((2 * cp) * XC_RP + ll) * 2) = (unsigned short)f2bf(y0); *(LAS unsigned short*)(T + ((2 * cp + 1) * XC_RP + ll) * 2) = (unsigned short)f2bf(y1); } }
        __syncthreads();
        if (tr) { bf16* dT = cb < 4 ? B.XT + ((size_t)(ck * 8 + 2 * cb) * 64) * SC : B.BT + ((size_t)(ck * 2 + (cb - 4)) * 128) * SC;
            for (int i = tid; i < 128 * 16; i += NTHR) { const int cr = i >> 4, q = i & 15; *(v4u*)(dT + (size_t)cr * SC + q * 8) = *(const LAS v4u*)(T + (cr * XC_RP + q * 8) * 2); } }
        __syncthreads();
    }
    for (int ck = blockIdx.x * NWAVES + w; ck < NCK; ck += gridDim.x * NWAVES) {
        const size_t r0 = (size_t)ck * SC + lane, r1 = r0 + 64;
        const v4u d0 = *(const v4u*)(B.PROJ + r0 * PROJW + O_DT), d1 = *(const v4u*)(B.PROJ + r1 * PROJW + O_DT);
        float dtA[8], dtB[8];
        dtA[0] = bflo(d0.x); dtA[1] = bfhi(d0.x); dtA[2] = bflo(d0.y); dtA[3] = bfhi(d0.y); dtA[4] = bflo(d0.z); dtA[5] = bfhi(d0.z); dtA[6] = bflo(d0.w); dtA[7] = bfhi(d0.w);
        dtB[0] = bflo(d1.x); dtB[1] = bfhi(d1.x); dtB[2] = bflo(d1.y); dtB[3] = bfhi(d1.y); dtB[4] = bflo(d1.z); dtB[5] = bfhi(d1.z); dtB[6] = bflo(d1.w); dtB[7] = bfhi(d1.w);
#pragma unroll
        for (int h = 0; h < 8; ++h) {
            const float A = -expf(p.in[17][l * M2H + h]), db = p.in[16][l * M2H + h];
            float ra = dtA[h] + db, rb = dtB[h] + db; ra = ra > 20.f ? ra : log1pf(expf(ra)); rb = rb > 20.f ? rb : log1pf(expf(rb));
            float ca = A * ra, cbv = A * rb;
#pragma unroll
            for (int o = 1; o < 64; o <<= 1) { const float ta = __shfl_up(ca, o), tb = __shfl_up(cbv, o); if (lane >= o) { ca += ta; cbv += tb; } }
            const float tot0 = __shfl(ca, 63); cbv += tot0; const float aend = __shfl(cbv, 63);
            B.SDT[r0 * 8 + h] = ra; B.SDT[r1 * 8 + h] = rb; B.SAC[r0 * 8 + h] = ca; B.SAC[r1 * 8 + h] = cbv;
            B.SW[((size_t)ck * 8 + h) * SC + lane] = expf(aend - ca) * ra; B.SW[((size_t)ck * 8 + h) * SC + 64 + lane] = expf(aend - cbv) * rb;
            if (lane == 0) B.CDEC[ck * 8 + h] = expf(aend);
        }
    }
}
__device__ __forceinline__ void ssd1_phase(const Bufs& B) {
    const int tid = threadIdx.x, lane = tid & 63, w = tid >> 6, fr = lane & 15, fq = lane >> 4, pt = w & 3, nh = w >> 2;
    for (int task = blockIdx.x; task < NCK * 8; task += gridDim.x) {
        const int ck = task >> 3, h = task & 7, gr = h >> 2;
        const bf16* xt = B.XT + ((size_t)(ck * 8 + h) * 64 + 16 * pt + fr) * SC + 8 * fq;
        const float* sw = B.SW + ((size_t)ck * 8 + h) * SC + 8 * fq;
        const bf16* bt = B.BT + ((size_t)(ck * 2 + gr) * 128 + 64 * nh + fr) * SC + 8 * fq;
        f32x4 acc[4];
#pragma unroll
        for (int nt = 0; nt < 4; ++nt) acc[nt] = (f32x4){0.f, 0.f, 0.f, 0.f};
#pragma unroll
        for (int ks = 0; ks < 4; ++ks) {
            const v4u xv = *(const v4u*)(xt + 32 * ks); const f32x4 wa = *(const f32x4*)(sw + 32 * ks), wb = *(const f32x4*)(sw + 32 * ks + 4);
            const bf16x8 af = __builtin_bit_cast(bf16x8, (v4u){pk2(bflo(xv.x) * wa[0], bfhi(xv.x) * wa[1]), pk2(bflo(xv.y) * wa[2], bfhi(xv.y) * wa[3]), pk2(bflo(xv.z) * wb[0], bfhi(xv.z) * wb[1]), pk2(bflo(xv.w) * wb[2], bfhi(xv.w) * wb[3])});
#pragma unroll
            for (int nt = 0; nt < 4; ++nt) { const bf16x8 bfg = *(const bf16x8*)(bt + (size_t)(16 * nt) * SC + 32 * ks); acc[nt] = __builtin_amdgcn_mfma_f32_16x16x32_bf16(af, bfg, acc[nt], 0, 0, 0); }
        }
        float* st = B.ST + ((size_t)(ck * 8 + h) * 64 + 16 * pt + 4 * fq) * 128 + 64 * nh + fr;
#pragma unroll
        for (int nt = 0; nt < 4; ++nt)
#pragma unroll
            for (int j = 0; j < 4; ++j) st[(size_t)j * 128 + 16 * nt] = acc[nt][j];
    }
}
__device__ __forceinline__ void ssd2_phase(const Bufs& B, int gtid, int gthreads) {
    for (int e = gtid; e < NBP * 8 * 64 * 128; e += gthreads) {
        const int sq = e >> 16, rem = e & 65535, h = rem >> 13;
        const float* st = B.ST + (size_t)sq * 64 * 65536 + rem; bf16* pv = B.PREV + (size_t)sq * 64 * 65536 + rem; const float* cd = B.CDEC + (size_t)sq * 64 * 8 + h;
        float carry = 0.f;
        for (int c0 = 0; c0 < 64; c0 += 8) { float v[8], d[8];
#pragma unroll
            for (int k = 0; k < 8; ++k) { v[k] = st[(size_t)(c0 + k) * 65536]; d[k] = cd[(c0 + k) * 8]; }
#pragma unroll
            for (int k = 0; k < 8; ++k) { pv[(size_t)(c0 + k) * 65536] = (bf16)f2bf(carry); carry = carry * d[k] + v[k]; } }
    }
}
constexpr int S3_CBP = 136, S3_CB = 128 * S3_CBP * 2, S3_AD = 4 * 128 * 2 * 4, S3_SS = 128 * 4 * 4, S3_LDS = S3_CB + S3_AD + S3_SS;
__device__ __forceinline__ void ssd3_phase(const Params& p, const Bufs& B, int l, LAS unsigned char* lds) {
    const int tid = threadIdx.x, lane = tid & 63, w = tid >> 6, fr = lane & 15, fq = lane >> 4, hh = w >> 1, lh = w & 1;
    LAS unsigned char* cbl = lds; LAS float* ad = (LAS float*)(lds + S3_CB); LAS float* ss = (LAS float*)(lds + S3_CB + S3_AD);
    for (int task = blockIdx.x; task < NCK * 2; task += gridDim.x) {
        const int ck = task >> 1, gr = task & 1, h = 4 * gr + hh; const size_t row0 = (size_t)ck * SC;
        const bf16* cn = B.CN + (size_t)(ck * 2 + gr) * SC * 128; const bf16* bn = B.BN + (size_t)(ck * 2 + gr) * SC * 128;
        for (int i = tid; i < 4 * 128; i += NTHR) { const int h4 = i >> 7, ll = i & 127; ad[i * 2] = B.SAC[(row0 + ll) * 8 + 4 * gr + h4]; ad[i * 2 + 1] = B.SDT[(row0 + ll) * 8 + 4 * gr + h4]; }
        {
            bf16x8 af[4];
#pragma unroll
            for (int ks = 0; ks < 4; ++ks) af[ks] = *(const bf16x8*)(cn + (size_t)(16 * w + fr) * 128 + 32 * ks + 8 * fq);
#pragma unroll
            for (int nt = 0; nt < 8; ++nt) { f32x4 acc = {0.f, 0.f, 0.f, 0.f};
#pragma unroll
                for (int ks = 0; ks < 4; ++ks) { const bf16x8 bfg = *(const bf16x8*)(bn + (size_t)(16 * nt + fr) * 128 + 32 * ks + 8 * fq); acc = __builtin_amdgcn_mfma_f32_16x16x32_bf16(af[ks], bfg, acc, 0, 0, 0); }
#pragma unroll
                for (int j = 0; j < 4; ++j) *(LAS unsigned short*)(cbl + ((16 * w + 4 * fq + j) * S3_CBP + 16 * nt + fr) * 2) = (unsigned short)f2bf(acc[j]); }
        }
        __syncthreads();
        f32x4 acc[4][4];
#pragma unroll
        for (int mt = 0; mt < 4; ++mt)
#pragma unroll
            for (int nt = 0; nt < 4; ++nt) acc[mt][nt] = (f32x4){0.f, 0.f, 0.f, 0.f};
        const int l0 = 64 * lh;
        { const bf16* pv = B.PREV + (size_t)(ck * 8 + h) * 64 * 128;
#pragma unroll 1
          for (int ks = 0; ks < 4; ++ks) { bf16x8 bfg[4], af[4];
#pragma unroll
            for (int nt = 0; nt < 4; ++nt) bfg[nt] = *(const bf16x8*)(pv + (size_t)(16 * nt + fr) * 128 + 32 * ks + 8 * fq);
#pragma unroll
            for (int mt = 0; mt < 4; ++mt) af[mt] = *(const bf16x8*)(cn + (size_t)(l0 + 16 * mt + fr) * 128 + 32 * ks + 8 * fq);
#pragma unroll
            for (int mt = 0; mt < 4; ++mt)
#pragma unroll
                for (int nt = 0; nt < 4; ++nt) acc[mt][nt] = __builtin_amdgcn_mfma_f32_16x16x32_bf16(af[mt], bfg[nt], acc[mt][nt], 0, 0, 0); } }
#pragma unroll
        for (int mt = 0; mt < 4; ++mt)
#pragma unroll
            for (int j = 0; j < 4; ++j) { const float ea = __expf(ad[(hh * 128 + l0 + 16 * mt + 4 * fq + j) * 2]);
#pragma unroll
                for (int nt = 0; nt < 4; ++nt) acc[mt][nt][j] *= ea; }
        { const bf16* xt = B.XT + (size_t)(ck * 8 + h) * 64 * SC; const float Dh = p.in[18][l * M2H + h];
#pragma unroll 1
          for (int ks = 0; ks < 4; ++ks) {
            if (32 * ks <= l0 + 63) {
                bf16x8 bfg[4];
#pragma unroll
                for (int nt = 0; nt < 4; ++nt) bfg[nt] = *(const bf16x8*)(xt + (size_t)(16 * nt + fr) * SC + 32 * ks + 8 * fq);
                float as_[8], ds_[8];
#pragma unroll
                for (int j = 0; j < 8; ++j) { as_[j] = ad[(hh * 128 + 32 * ks + 8 * fq + j) * 2]; ds_[j] = ad[(hh * 128 + 32 * ks + 8 * fq + j) * 2 + 1]; }
#pragma unroll
                for (int mt = 0; mt < 4; ++mt) { const int lrow = l0 + 16 * mt + fr;
                    if (32 * ks <= l0 + 16 * mt + 15) {
                        const float al = ad[(hh * 128 + lrow) * 2];
                        const v4u cv = *(const LAS v4u*)(cbl + (lrow * S3_CBP + 32 * ks + 8 * fq) * 2);
                        float cf[8] = {bflo(cv.x), bfhi(cv.x), bflo(cv.y), bfhi(cv.y), bflo(cv.z), bfhi(cv.z), bflo(cv.w), bfhi(cv.w)};
#pragma unroll
                        for (int j = 0; j < 8; ++j) { const int sidx = 32 * ks + 8 * fq + j; float v = cf[j] * __expf(fminf(al - as_[j], 0.f)) * ds_[j]; v = sidx <= lrow ? v : 0.f; cf[j] = v + (sidx == lrow ? Dh : 0.f); }
                        const bf16x8 af = __builtin_bit_cast(bf16x8, (v4u){pk2(cf[0], cf[1]), pk2(cf[2], cf[3]), pk2(cf[4], cf[5]), pk2(cf[6], cf[7])});
#pragma unroll
                        for (int nt = 0; nt < 4; ++nt) acc[mt][nt] = __builtin_amdgcn_mfma_f32_16x16x32_bf16(af, bfg[nt], acc[mt][nt], 0, 0, 0);
                    } }
            } } }
        const float* nw = p.in[19] + l * M2I + gr * 256 + hh * 64;
#pragma unroll
        for (int mt = 0; mt < 4; ++mt)
#pragma unroll
            for (int j = 0; j < 4; ++j) { const int lrow = l0 + 16 * mt + 4 * fq + j; const bf16* zr = B.PROJ + (row0 + lrow) * PROJW + O_Z + gr * 256 + hh * 64; float q = 0.f;
#pragma unroll
                for (int nt = 0; nt < 4; ++nt) { const float zz = bf2f(zr[16 * nt + fr]); const float v = acc[mt][nt][j] * zz * sigm_f(zz); acc[mt][nt][j] = v; q += v * v; }
                q += __shfl_xor(q, 1); q += __shfl_xor(q, 2); q += __shfl_xor(q, 4); q += __shfl_xor(q, 8);
                if (fr == 0) ss[lrow * 4 + hh] = q; }
        __syncthreads();
#pragma unroll
        for (int mt = 0; mt < 4; ++mt)
#pragma unroll
            for (int j = 0; j < 4; ++j) { const int lrow = l0 + 16 * mt + 4 * fq + j; const f32x4 s4 = *(const LAS f32x4*)(ss + lrow * 4);
                const float rs = rsqrtf((s4[0] + s4[1] + s4[2] + s4[3]) * (1.f / 256.f) + 1e-6f); bf16* yr = B.YB + (row0 + lrow) * M2I + gr * 256 + hh * 64;
#pragma unroll
                for (int nt = 0; nt < 4; ++nt) yr[16 * nt + fr] = (bf16)f2bf(acc[mt][nt][j] * rs * nw[16 * nt + fr]); }
        __syncthreads();
    }
}
__global__ void __launch_bounds__(NTHR, 2) k_xc(Params p, int l) { extern __shared__ __attribute__((aligned(16))) unsigned char lds[]; const Bufs B = make_bufs(p); xc_phase(p, B, l, (LAS unsigned char*)lds); }
__global__ void __launch_bounds__(NTHR, 2) k_ssd1(Params p) { const Bufs B = make_bufs(p); ssd1_phase(B); }
__global__ void __launch_bounds__(NTHR, 2) k_ssd2(Params p) { const Bufs B = make_bufs(p); ssd2_phase(B, blockIdx.x * NTHR + threadIdx.x, gridDim.x * NTHR); }
__global__ void __launch_bounds__(NTHR, 2) k_ssd3(Params p, int l) { extern __shared__ __attribute__((aligned(16))) unsigned char lds[]; const Bufs B = make_bufs(p); ssd3_phase(p, B, l, (LAS unsigned char*)lds); }

__global__ void __launch_bounds__(64) n_s5(Params p, int l) {
    const Bufs B = make_bufs(p);
    const int g = blockIdx.x, sq = blockIdx.y, pp = threadIdx.x;
    const float* a_re = p.in[5] + l * S5G * S5P; const float* a_im = p.in[6] + l * S5G * S5P; const float* log_dt = p.in[7] + l * S5G;
    const float* b_re = p.in[8] + (size_t)l * S5G * S5P * 16; const float* b_im = p.in[9] + (size_t)l * S5G * S5P * 16;
    const float* c_re = p.in[10] + (size_t)l * S5G * 16 * S5P; const float* c_im = p.in[11] + (size_t)l * S5G * 16 * S5P; const float* dvec = p.in[12] + l * S5W;
    const float lr = a_re[g * S5P + pp], li = a_im[g * S5P + pp], dt = expf(log_dt[g]);
    const float mag = expf(lr * dt), ar = mag * cosf(li * dt), ai = mag * sinf(li * dt);
    const float nr = ar - 1.f, ni = ai, den = lr * lr + li * li;
    const float cr = (nr * lr + ni * li) / den, ci = (ni * lr - nr * li) / den;
    float bbr[16], bbi[16], ccr[16], cci[16];
#pragma unroll
    for (int h = 0; h < 16; ++h) {
        const float br = b_re[(g * S5P + pp) * 16 + h], bi = b_im[(g * S5P + pp) * 16 + h];
        bbr[h] = cr * br - ci * bi; bbi[h] = cr * bi + ci * br;
        ccr[h] = c_re[(g * 16 + h) * S5P + pp]; cci[h] = c_im[(g * 16 + h) * S5P + pp];
    }
    const bf16* U = B.PROJ + (size_t)sq * SEQ * PROJW + O_U + g * 16;
    float xr = 0.f, xi = 0.f; float un[16];
#pragma unroll
    for (int h = 0; h < 16; ++h) un[h] = bf2f(U[h]);
    for (int t = 0; t < SEQ; ++t) {
        float u[16];
#pragma unroll
        for (int h = 0; h < 16; ++h) u[h] = un[h];
        if (t + 1 < SEQ) {
#pragma unroll
            for (int h = 0; h < 16; ++h) un[h] = bf2f(U[(size_t)(t + 1) * PROJW + h]); }
        float bur = 0.f, bui = 0.f;
#pragma unroll
        for (int h = 0; h < 16; ++h) { bur += bbr[h] * u[h]; bui += bbi[h] * u[h]; }
        const float nxr = ar * xr - ai * xi + bur, nxi = ar * xi + ai * xr + bui; xr = nxr; xi = nxi;
        float mine = 0.f, myu = 0.f;
#pragma unroll
        for (int h = 0; h < 16; ++h) { const float y = wsum(xr * ccr[h] - xi * cci[h]); if (pp == h) { mine = y; myu = u[h]; } }
        if (pp < 16) B.Z[(size_t)(sq * SEQ + t) * S5W + g * 16 + pp] = (bf16)f2bf(gelu_t(mine + dvec[g * 16 + pp] * myu));
    }
}
__global__ void __launch_bounds__(64) n_rms(Params p, int off, int W, const float* g, bf16* out, int ldo) {
    const Bufs B = make_bufs(p);
    const int t = blockIdx.x, ln = threadIdx.x; float s = 0.f;
    for (int c = ln; c < W; c += 64) { const float v = bf2f(B.PROJ[(size_t)t * PROJW + off + c]); s += v * v; }
    s = wsum(s); const float rs = rsqrtf(s / W + 1e-6f);
    for (int c = ln; c < ldo; c += 64) out[(size_t)t * ldo + c] = c < W ? (bf16)f2bf(bf2f(B.PROJ[(size_t)t * PROJW + off + c]) * rs * g[c]) : (bf16)0;
}
__device__ __forceinline__ void rope_phase(const Params& p, const Bufs& B, int pass, int gtid, int gthreads) {
    const int* pos = (const int*)p.in[1] + (size_t)pass * M;
    for (int i = gtid; i < M * 16; i += gthreads) {
        const int t = i >> 4, f = i & 15;
        const float inv = 1.0f / powf(10000.f, (float)(2 * f) / 32.f); const float ang = (float)pos[t] * inv; const float cs = cosf(ang), sn = sinf(ang);
        const float sc = 0.10206207261596577f * 1.4426950408889634f;
        for (int h = 0; h < AH; ++h) {
            bf16* qq = B.Q + (size_t)t * 768 + h * 96;
            const float x1 = bf2f(qq[64 + f]), x2 = bf2f(qq[80 + f]);
            qq[64 + f] = (bf16)f2bf((x1 * cs - x2 * sn) * sc); qq[80 + f] = (bf16)f2bf((x2 * cs + x1 * sn) * sc);
            for (int d = f; d < 64; d += 16) qq[d] = (bf16)f2bf(bf2f(qq[d]) * sc);
        }
        const float k1 = bf2f(B.PROJ[(size_t)t * PROJW + O_KR + f]), k2 = bf2f(B.PROJ[(size_t)t * PROJW + O_KR + 16 + f]);
        B.KR[t * 32 + f] = (bf16)f2bf(k1 * cs - k2 * sn); B.KR[t * 32 + 16 + f] = (bf16)f2bf(k2 * cs + k1 * sn);
    }
}
__global__ void __launch_bounds__(NTHR, 2) k_rope(Params p, int pass) { const Bufs B = make_bufs(p); rope_phase(p, B, pass, blockIdx.x * NTHR + threadIdx.x, gridDim.x * NTHR); }

constexpr int AT_KP = 104, AT_VP = 68, AT_KB = 64 * AT_KP * 2, AT_VB = 64 * AT_VP * 2, AT_LDS = 2 * AT_KB + 2 * AT_VB;
__device__ __forceinline__ int crow16(int r, int hi) { return (r & 3) + 8 * (r >> 2) + 4 * hi; }
__device__ __forceinline__ void attn_unit(const Bufs& B, int b, int h, int qb, LAS unsigned char* lds) {
    const int tid = threadIdx.x, lane = tid & 63, w = tid >> 6, q31 = lane & 31, hi = lane >> 5;
    const size_t rb = (size_t)b * SEQ; const int q0 = qb * 256, qrow = q0 + 32 * w + q31;
    bf16x8 qr[6];
#pragma unroll
    for (int ks = 0; ks < 6; ++ks) qr[ks] = *(const bf16x8*)(B.Q + (rb + qrow) * 768 + h * 96 + 16 * ks + 8 * hi);
    f32x16 o0 = {}, o1 = {}; float mrun = -INFINITY, lrun = 0.f;
    const int NT = (q0 + 256) / 64;
    const int kr_ = tid >> 3, kc = tid & 7;
    const int rr_ = (tid & 255) >> 2, rc = tid & 3;
    const bf16* kn_src = B.KN + (rb + kr_) * 512 + h * 64 + kc * 8;
    const bf16* kr_src = B.KR + (rb + rr_) * 32 + rc * 8;
    const bf16* vt_src = B.VT + (size_t)(h * 64 + kr_) * M + rb + kc * 8;
    v4u gk, gr, gv;
    gk = *(const v4u*)(kn_src); if (tid < 256) gr = *(const v4u*)(kr_src); gv = *(const v4u*)(vt_src);
    {
        LAS unsigned char* kb = lds; LAS unsigned char* vb = lds + 2 * AT_KB;
        *(LAS v4u*)(kb + kr_ * (AT_KP * 2) + kc * 16) = gk; if (tid < 256) *(LAS v4u*)(kb + rr_ * (AT_KP * 2) + 128 + rc * 16) = gr;
        *(LAS v2u*)(vb + kr_ * (AT_VP * 2) + kc * 16) = (v2u){gv.x, gv.y}; *(LAS v2u*)(vb + kr_ * (AT_VP * 2) + kc * 16 + 8) = (v2u){gv.z, gv.w};
    }
    __syncthreads();
    for (int t = 0; t < NT; ++t) {
        const int k0 = 64 * t, buf = t & 1;
        if (t + 1 < NT) { gk = *(const v4u*)(kn_src + (size_t)(k0 + 64) * 512); if (tid < 256) gr = *(const v4u*)(kr_src + (size_t)(k0 + 64) * 32); gv = *(const v4u*)(vt_src + k0 + 64); }
        if (k0 <= q0 + 32 * w + 31) {
            const LAS unsigned char* kb = lds + buf * AT_KB; const LAS unsigned char* vb = lds + 2 * AT_KB + buf * AT_VB;
            f32x16 s0 = {}, s1 = {};
#pragma unroll
            for (int ks = 0; ks < 6; ++ks) {
                const bf16x8 a0 = *(const LAS bf16x8*)(kb + q31 * (AT_KP * 2) + ks * 32 + hi * 16);
                const bf16x8 a1 = *(const LAS bf16x8*)(kb + (32 + q31) * (AT_KP * 2) + ks * 32 + hi * 16);
                s0 = __builtin_amdgcn_mfma_f32_32x32x16_bf16(a0, qr[ks], s0, 0, 0, 0);
                s1 = __builtin_amdgcn_mfma_f32_32x32x16_bf16(a1, qr[ks], s1, 0, 0, 0);
            }
            if (k0 + 63 > q0 + 32 * w) {
#pragma unroll
                for (int r = 0; r < 16; ++r) { const int kv = k0 + crow16(r, hi); if (kv > qrow) s0[r] = -INFINITY; if (kv + 32 > qrow) s1[r] = -INFINITY; }
            }
            float mx = fmaxf(s0[0], s1[0]);
#pragma unroll
            for (int r = 1; r < 16; ++r) mx = fmaxf(mx, fmaxf(s0[r], s1[r]));
            mx = fmaxf(mx, __shfl_xor(mx, 32));
            const float mnew = fmaxf(mrun, mx), alpha = __builtin_amdgcn_exp2f(mrun - mnew); mrun = mnew;
            float ps = 0.f;
#pragma unroll
            for (int r = 0; r < 16; ++r) { s0[r] = __builtin_amdgcn_exp2f(s0[r] - mnew); s1[r] = __builtin_amdgcn_exp2f(s1[r] - mnew); ps += s0[r] + s1[r]; }
            lrun = lrun * alpha + ps;
#pragma unroll
            for (int r = 0; r < 16; ++r) { o0[r] *= alpha; o1[r] *= alpha; }
#pragma unroll
            for (int st = 0; st < 4; ++st) {
                v4u pw;
                if (st == 0) pw = (v4u){pk2(s0[0], s0[1]), pk2(s0[2], s0[3]), pk2(s0[4], s0[5]), pk2(s0[6], s0[7])};
                if (st == 1) pw = (v4u){pk2(s0[8], s0[9]), pk2(s0[10], s0[11]), pk2(s0[12], s0[13]), pk2(s0[14], s0[15])};
                if (st == 2) pw = (v4u){pk2(s1[0], s1[1]), pk2(s1[2], s1[3]), pk2(s1[4], s1[5]), pk2(s1[6], s1[7])};
                if (st == 3) pw = (v4u){pk2(s1[8], s1[9]), pk2(s1[10], s1[11]), pk2(s1[12], s1[13]), pk2(s1[14], s1[15])};
                const bf16x8 pb = __builtin_bit_cast(bf16x8, pw);
                const LAS unsigned char* v0p = vb + q31 * (AT_VP * 2) + (16 * st + 4 * hi) * 2;
                const v2u va = *(const LAS v2u*)(v0p), vb2 = *(const LAS v2u*)(v0p + 16);
                const v2u vc = *(const LAS v2u*)(v0p + 32 * (AT_VP * 2)), vd = *(const LAS v2u*)(v0p + 32 * (AT_VP * 2) + 16);
                o0 = __builtin_amdgcn_mfma_f32_32x32x16_bf16(__builtin_bit_cast(bf16x8, (v4u){va.x, va.y, vb2.x, vb2.y}), pb, o0, 0, 0, 0);
                o1 = __builtin_amdgcn_mfma_f32_32x32x16_bf16(__builtin_bit_cast(bf16x8, (v4u){vc.x, vc.y, vd.x, vd.y}), pb, o1, 0, 0, 0);
            }
        }
        if (t + 1 < NT) {
            LAS unsigned char* kb = lds + (buf ^ 1) * AT_KB; LAS unsigned char* vb = lds + 2 * AT_KB + (buf ^ 1) * AT_VB;
            *(LAS v4u*)(kb + kr_ * (AT_KP * 2) + kc * 16) = gk; if (tid < 256) *(LAS v4u*)(kb + rr_ * (AT_KP * 2) + 128 + rc * 16) = gr;
            *(LAS v2u*)(vb + kr_ * (AT_VP * 2) + kc * 16) = (v2u){gv.x, gv.y}; *(LAS v2u*)(vb + kr_ * (AT_VP * 2) + kc * 16 + 8) = (v2u){gv.z, gv.w};
        }
        __syncthreads();
    }
    lrun += __shfl_xor(lrun, 32);
    const float il = 1.f / lrun;
    bf16* orow = B.YC + (rb + qrow) * 512 + h * 64;
#pragma unroll
    for (int g4 = 0; g4 < 4; ++g4) {
        const v2u a = {pk2(o0[4 * g4] * il, o0[4 * g4 + 1] * il), pk2(o0[4 * g4 + 2] * il, o0[4 * g4 + 3] * il)};
        const v2u c = {pk2(o1[4 * g4] * il, o1[4 * g4 + 1] * il), pk2(o1[4 * g4 + 2] * il, o1[4 * g4 + 3] * il)};
        *(v2u*)(orow + 8 * g4 + 4 * hi) = a; *(v2u*)(orow + 32 + 8 * g4 + 4 * hi) = c;
    }
}
__device__ __forceinline__ void attn_phase(const Bufs& B, LAS unsigned char* lds) {
    const int c = blockIdx.x;
    for (int u = c; u < 2 * 256; u += gridDim.x) {
        const int cc = u & 255, second = u >> 8; const int bh = cc >> 4, s = cc & 15;
        attn_unit(B, bh >> 3, bh & 7, second ? 31 - s : s, lds);
    }
}
__global__ void __launch_bounds__(NTHR, 2) k_attn(Params p) {
    extern __shared__ __attribute__((aligned(16))) unsigned char lds[];
    const Bufs B = make_bufs(p); attn_phase(B, (LAS unsigned char*)lds);
}

__global__ void __launch_bounds__(256) n_ln(Params p, int pass, const float* g, const float* b, int final_) {
    __shared__ float red[8];
    const Bufs B = make_bufs(p);
    const int r = blockIdx.x, t = threadIdx.x; bf16* hrow = B.HB + ((size_t)pass * M + r) * D; const float* add = B.F32 + (size_t)r * D;
    float v[4]; float s = 0.f;
#pragma unroll
    for (int i = 0; i < 4; ++i) { const int c = t + 256 * i; const float x = ALPHA * bf2f(hrow[c]) + add[c]; v[i] = x; s += x; }
    s = wsum(s); if ((t & 63) == 0) red[t >> 6] = s; __syncthreads();
    const float mu = (red[0] + red[1] + red[2] + red[3]) * (1.f / D);
    float q = 0.f;
#pragma unroll
    for (int i = 0; i < 4; ++i) { const float d = v[i] - mu; q += d * d; }
    q = wsum(q); if ((t & 63) == 0) red[4 + (t >> 6)] = q; __syncthreads();
    const float rs = rsqrtf((red[4] + red[5] + red[6] + red[7]) * (1.f / D) + 1e-5f);
#pragma unroll
    for (int i = 0; i < 4; ++i) { const int c = t + 256 * i; const float y = (v[i] - mu) * rs * g[c] + b[c]; hrow[c] = (bf16)f2bf(y); if (final_) p.out[((size_t)pass * M + r) * D + c] = y; }
}
template <int N, int K, int J> struct BitonicDesc {
    static __device__ __forceinline__ void run(float (&v)[N]) {
#pragma unroll
        for (int i = 0; i < N; ++i) { const int l = i ^ J; if (l > i) { const bool desc = ((i & K) == 0) || (K == N); const float a = v[i], b = v[l]; const float mx = __builtin_fmaxf(a, b), mn = __builtin_fminf(a, b); v[i] = desc ? mx : mn; v[l] = desc ? mn : mx; } }
        if constexpr (J > 1) BitonicDesc<N, K, J / 2>::run(v); else if constexpr (K < N) BitonicDesc<N, 2 * K, K>::run(v);
    }
};
__device__ __forceinline__ void sort16_desc(float (&v)[16]) { BitonicDesc<16, 2, 1>::run(v); }
__device__ __forceinline__ void merge16_desc(float (&a)[16], const float (&b)[16]) {
#pragma unroll
    for (int i = 0; i < 16; ++i) a[i] = __builtin_fmaxf(a[i], b[15 - i]);
    BitonicDesc<16, 16, 8>::run(a);
}
__device__ __forceinline__ void xmerge16_desc(float (&a)[16]) {
    float o[16];
#pragma unroll
    for (int i = 0; i < 16; ++i) o[i] = __shfl_xor(a[i], 32);
    merge16_desc(a, o);
}
constexpr int SK_P = 136, SEL_LDS = 2 * PK * SK_P * 2;
__device__ __forceinline__ void sel_phase(const Params& p, const Bufs& B, int l, LAS unsigned char* lds) {
    const int tid = threadIdx.x, lane = tid & 63, w = tid >> 6, n = lane & 31, hi = lane >> 5;
    const bf16* sk = (const bf16*)(wl_ptr(p, l) + WO_SK);
    for (int i = tid; i < 2 * PK * 16; i += NTHR) { const int row = i >> 4, ch = i & 15; *(LAS v4u*)(lds + row * (SK_P * 2) + ch * 16) = *(const v4u*)(sk + row * 128 + ch * 8); }
    __syncthreads();
    for (int task = blockIdx.x * NWAVES + w; task < M * 8 / 32; task += gridDim.x * NWAVES) {
        const int pair = task * 32 + n, t = pair >> 3, h = pair & 7;
        const bf16* qrow = B.PQ + (size_t)t * 2048 + h * 256;
        float a0[16], a1[16];
#pragma unroll
        for (int j = 0; j < 2; ++j) {
            bf16x8 qf[8];
#pragma unroll
            for (int ks = 0; ks < 8; ++ks) qf[ks] = *(const bf16x8*)(qrow + j * 128 + 16 * ks + 8 * hi);
            float run[16];
#pragma unroll
            for (int kb = 0; kb < 4; ++kb) { f32x16 acc = {};
#pragma unroll
                for (int ks = 0; ks < 8; ++ks) { const bf16x8 A = *(const LAS bf16x8*)(lds + ((j * PK + kb * 32 + n) * SK_P + 16 * ks + 8 * hi) * 2); acc = __builtin_amdgcn_mfma_f32_32x32x16_bf16(A, qf[ks], acc, 0, 0, 0); }
                float v[16];
#pragma unroll
                for (int r = 0; r < 16; ++r) v[r] = bitsf((fbits(acc[r]) & ~127u) | (unsigned)(kb * 32 + (r & 3) + 8 * (r >> 2) + 4 * hi));
                sort16_desc(v);
                if (kb == 0) {
#pragma unroll
                    for (int i = 0; i < 16; ++i) run[i] = v[i]; }
                else merge16_desc(run, v);
                asm volatile("" ::: "memory");
            }
            xmerge16_desc(run);
#pragma unroll
            for (int i = 0; i < 16; ++i) { if (j == 0) a0[i] = run[i]; else a1[i] = run[i]; }
        }
        unsigned k0[16], k1[16];
#pragma unroll
        for (int i = 0; i < 16; ++i) { k0[i] = (fbits(a0[i]) & 127u) << 7; k1[i] = fbits(a1[i]) & 127u; }
        float cc[32];
#pragma unroll
        for (int s_ = 0; s_ < 32; ++s_) cc[s_] = -INFINITY;
        {
            int cnt = 0;
#pragma unroll
            for (int i = 0; i < 16; ++i)
#pragma unroll
                for (int j = 0; j < 16; ++j) if ((i + 1) * (j + 1) <= 16) {
                    const float vv = bitsf((fbits(a0[i] + a1[j]) & ~0x3FFFu) | k0[i] | k1[j]);
                    if ((cnt & 1) == 0) { cc[cnt >> 1] = hi ? cc[cnt >> 1] : vv; } else { cc[cnt >> 1] = hi ? vv : cc[cnt >> 1]; }
                    ++cnt; }
        }
        float c0[16], c1[16];
#pragma unroll
        for (int i = 0; i < 16; ++i) { c0[i] = cc[i]; c1[i] = cc[16 + i]; }
        sort16_desc(c0); sort16_desc(c1); merge16_desc(c0, c1); xmerge16_desc(c0);
        const float m0 = bitsf(fbits(c0[0]) & ~0x3FFFu);
        float e[16]; float sum = 0.f;
#pragma unroll
        for (int i = 0; i < 16; ++i) { e[i] = __builtin_amdgcn_exp2f((bitsf(fbits(c0[i]) & ~0x3FFFu) - m0) * 1.4426950408889634f); sum += e[i]; }
        const float inv = 1.f / sum;
        v4u ia, ib; f32x4 ga, gb; const unsigned hm = 0u - (unsigned)hi;
#define SELH(a, b) ((fbits((a)) & ~hm) | (fbits((b)) & hm))
#pragma unroll
        for (int q = 0; q < 4; ++q) { ia[q] = SELH(c0[q], c0[8 + q]) & 0x3FFFu; ib[q] = SELH(c0[4 + q], c0[12 + q]) & 0x3FFFu;
            ga[q] = bitsf(SELH(e[q], e[8 + q])) * inv; gb[q] = bitsf(SELH(e[4 + q], e[12 + q])) * inv; }
#undef SELH
        const size_t ob = (size_t)t * 128 + h * 16 + 8 * hi;
        *(v4u*)(B.IDX + ob) = ia; *(v4u*)(B.IDX + ob + 4) = ib; *(f32x4*)(B.GW + ob) = ga; *(f32x4*)(B.GW + ob + 4) = gb;
    }
}
__global__ void __launch_bounds__(NTHR, 2) k_sel(Params p, int l) {
    extern __shared__ __attribute__((aligned(16))) unsigned char lds[];
    const Bufs B = make_bufs(p); sel_phase(p, B, l, (LAS unsigned char*)lds);
}

__device__ __forceinline__ void exp_phase(const Params& p, const Bufs& B, int l, int pass, int final_) {
    const int tid = threadIdx.x, lane = tid & 63, w = tid >> 6;
    const float* g2 = p.in[34] + l * D; const float* b2 = p.in[35] + l * D;
    const unsigned short* TU = B.TABU; const unsigned short* TV = B.TABV;
    for (int t = blockIdx.x * NWAVES + w; t < M; t += gridDim.x * NWAVES) {
        bf16* hrow = B.HB + ((size_t)pass * M + t) * D;
        const v4u x0 = *(const v4u*)(hrow + 8 * lane), x1 = *(const v4u*)(hrow + 512 + 8 * lane);
        const int id0 = B.IDX[(size_t)t * 128 + lane], id1 = B.IDX[(size_t)t * 128 + 64 + lane];
        const float gw0 = B.GW[(size_t)t * 128 + lane], gw1 = B.GW[(size_t)t * 128 + 64 + lane];
        float o[16];
#pragma unroll
        for (int i = 0; i < 16; ++i) o[i] = 0.f;
        for (int g = 0; g < 32; ++g) {
            v4u U[4][2], V[4][2];
            const int idsel = g < 16 ? id0 : id1; const float gwsel = g < 16 ? gw0 : gw1;
#pragma unroll
            for (int e = 0; e < 4; ++e) { const int idk = __builtin_amdgcn_readlane(idsel, (4 * g + e) & 63);
                const unsigned short* ur = TU + (size_t)idk * D; const unsigned short* vr = TV + (size_t)idk * D;
                U[e][0] = *(const v4u*)(ur + 8 * lane); U[e][1] = *(const v4u*)(ur + 512 + 8 * lane);
                V[e][0] = *(const v4u*)(vr + 8 * lane); V[e][1] = *(const v4u*)(vr + 512 + 8 * lane); }
            float s[4];
#pragma unroll
            for (int e = 0; e < 4; ++e) s[e] = dot8bf(U[e][1], x1, dot8bf(U[e][0], x0, 0.f));
            const bool hi = lane >= 32, b4 = (lane >> 4) & 1;
            const float r0 = (hi ? s[2] : s[0]) + __shfl_xor(hi ? s[0] : s[2], 32);
            const float r1 = (hi ? s[3] : s[1]) + __shfl_xor(hi ? s[1] : s[3], 32);
            float qv = (b4 ? r1 : r0) + __shfl_xor(b4 ? r0 : r1, 16);
            qv += __shfl_xor(qv, 8); qv += __shfl_xor(qv, 4); qv += __shfl_xor(qv, 2); qv += __shfl_xor(qv, 1);
            const float gk = __shfl(gwsel, (4 * g + (lane >> 4)) & 63);
            const float act = gk * gelu_t(qv);
#pragma unroll
            for (int e = 0; e < 4; ++e) { const float a = __builtin_bit_cast(float, __builtin_amdgcn_readlane(__builtin_bit_cast(int, act), 16 * e));
#pragma unroll
                for (int q = 0; q < 4; ++q) { const unsigned wa = V[e][0][q], wb = V[e][1][q];
                    o[2 * q] = fmaf(a, hlo(wa), o[2 * q]); o[2 * q + 1] = fmaf(a, hhi(wa), o[2 * q + 1]); o[8 + 2 * q] = fmaf(a, hlo(wb), o[8 + 2 * q]); o[8 + 2 * q + 1] = fmaf(a, hhi(wb), o[8 + 2 * q + 1]); } }
        }
        float y[16]; float sm = 0.f;
#pragma unroll
        for (int q = 0; q < 4; ++q) { y[2 * q] = ALPHA * bflo(x0[q]) + o[2 * q]; y[2 * q + 1] = ALPHA * bfhi(x0[q]) + o[2 * q + 1]; y[8 + 2 * q] = ALPHA * bflo(x1[q]) + o[8 + 2 * q]; y[8 + 2 * q + 1] = ALPHA * bfhi(x1[q]) + o[8 + 2 * q + 1]; }
#pragma unroll
        for (int i = 0; i < 16; ++i) sm += y[i];
        const float mu = wsum(sm) * (1.f / D); float sq = 0.f;
#pragma unroll
        for (int i = 0; i < 16; ++i) { y[i] -= mu; sq += y[i] * y[i]; }
        const float rs = rsqrtf(wsum(sq) * (1.f / D) + 1e-5f);
#pragma unroll
        for (int hf = 0; hf < 2; ++hf) { const int c0 = hf * 512 + 8 * lane;
            const f32x4 ga = *(const f32x4*)(g2 + c0), gb = *(const f32x4*)(g2 + c0 + 4), ba = *(const f32x4*)(b2 + c0), bb = *(const f32x4*)(b2 + c0 + 4);
            f32x4 ya, yb;
#pragma unroll
            for (int q = 0; q < 4; ++q) { ya[q] = y[hf * 8 + q] * rs * ga[q] + ba[q]; yb[q] = y[hf * 8 + 4 + q] * rs * gb[q] + bb[q]; }
            *(v4u*)(hrow + c0) = (v4u){pk2(ya[0], ya[1]), pk2(ya[2], ya[3]), pk2(yb[0], yb[1]), pk2(yb[2], yb[3])};
            if (final_) { float* orow = p.out + ((size_t)pass * M + t) * D + c0; *(f32x4*)orow = ya; *(f32x4*)(orow + 4) = yb; } }
    }
}
__global__ void __launch_bounds__(NTHR, 2) k_exp(Params p, int l, int pass, int final_) { const Bufs B = make_bufs(p); exp_phase(p, B, l, pass, final_); }

__global__ void __launch_bounds__(256) n_subtop(Params p, int l) {
    __shared__ float qs[2048]; __shared__ float sub[2048];
    const Bufs B = make_bufs(p); const float* sk = p.in[31] + (size_t)l * 2 * PK * 128;
    const int t = blockIdx.x;
    for (int i = threadIdx.x; i < 2048; i += 256) qs[i] = bf2f(B.PQ[(size_t)t * 2048 + i]);
    __syncthreads();
    for (int o = threadIdx.x; o < 2048; o += 256) { const int k = o & 127, hj = o >> 7, j = hj & 1;
        const float* kk = sk + ((size_t)j * PK + k) * 128; const float* qq = qs + hj * 128; float s = 0.f;
        for (int d = 0; d < 128; ++d) s += qq[d] * kk[d];
        sub[o] = s; }
    __syncthreads();
    if (threadIdx.x < 16) { const float* s = sub + threadIdx.x * 128; const size_t ob = ((size_t)t * 16 + threadIdx.x) * PT;
        float pv = INFINITY; int pi = -1;
        for (int r = 0; r < PT; ++r) { float bv = -INFINITY; int bi = -1;
            for (int k = 0; k < 128; ++k) { const float v = s[k]; const bool valid = (v < pv) || (v == pv && k > pi); if (valid && (bi < 0 || v > bv)) { bv = v; bi = k; } }
            B.TS[ob + r] = bv; B.TI[ob + r] = bi; pv = bv; pi = bi; } }
}
__global__ void __launch_bounds__(256) n_top2(Params p) {
    const Bufs B = make_bufs(p);
    const int i = blockIdx.x * 256 + threadIdx.x;
    const float* s0 = B.TS + (size_t)(2 * i) * PT; const float* s1 = s0 + PT; const int* i0 = B.TI + (size_t)(2 * i) * PT; const int* i1 = i0 + PT;
    float a0[16], a1[16];
#pragma unroll
    for (int r = 0; r < 16; ++r) { a0[r] = s0[r]; a1[r] = s1[r]; }
    float pv = INFINITY; int pi = -1; float mx = -INFINITY;
    for (int r = 0; r < PT; ++r) {
        float bv = -INFINITY; int bi = -1;
#pragma unroll
        for (int a = 0; a < 16; ++a)
#pragma unroll
            for (int bb = 0; bb < 16; ++bb) { const int c = a * 16 + bb; const float v = a0[a] + a1[bb]; const bool valid = (v < pv) || (v == pv && c > pi); if (valid && (bi < 0 || v > bv)) { bv = v; bi = c; } }
        B.GW[(size_t)i * PT + r] = bv; B.IDX[(size_t)i * PT + r] = i0[bi >> 4] * PK + i1[bi & 15]; pv = bv; pi = bi; mx = fmaxf(mx, bv);
    }
    float sum = 0.f;
    for (int r = 0; r < PT; ++r) sum += expf(B.GW[(size_t)i * PT + r] - mx);
    for (int r = 0; r < PT; ++r) B.GW[(size_t)i * PT + r] = expf(B.GW[(size_t)i * PT + r] - mx) / sum;
}

template <int KIND> static void launch_gemm(const Params& p, int l, int pass, int grid, hipStream_t stream) {
    static bool attr = false;
    if (!attr) { (void)hipFuncSetAttribute((const void*)k_gemm_ph<KIND>, hipFuncAttributeMaxDynamicSharedMemorySize, 131072); attr = true; }
    hipLaunchKernelGGL(k_gemm_ph<KIND>, dim3(grid), dim3(NTHR), 131072, stream, p, l, pass);
}
extern "C" void kernel_launch(void* const* d_in, const int* in_sizes, int n_in, void* d_out, int out_size, void* d_ws, size_t ws_size, hipStream_t stream) {
    if (n_in != 36 || ws_size < WS_END || out_size != NB * SEQ * D) { fprintf(stderr, "kernel_launch: unexpected sizes (n_in %d, ws %zu, out %d)\n", n_in, ws_size, out_size); return; }
    Params p{};
    for (int i = 0; i < 36; ++i) p.in[i] = (const float*)d_in[i];
    p.out = (float*)d_out; p.ws = (unsigned char*)d_ws;
    const int grid = 256;
    static bool attr0 = false;
    if (!attr0) { (void)hipFuncSetAttribute((const void*)k_xc, hipFuncAttributeMaxDynamicSharedMemorySize, XC_LDS); (void)hipFuncSetAttribute((const void*)k_s5a, hipFuncAttributeMaxDynamicSharedMemorySize, S5_LDS); (void)hipFuncSetAttribute((const void*)k_s5b, hipFuncAttributeMaxDynamicSharedMemorySize, S5_LDS); (void)hipFuncSetAttribute((const void*)k_sel, hipFuncAttributeMaxDynamicSharedMemorySize, SEL_LDS); (void)hipFuncSetAttribute((const void*)k_prologue, hipFuncAttributeMaxDynamicSharedMemorySize, 8448 * 8); attr0 = true; }
    (void)hipMemsetAsync((char*)d_ws + WS_W, 0, WS_WEND - WS_W, stream);
    hipLaunchKernelGGL(k_prologue, dim3(grid), dim3(NTHR), 8448 * 8, stream, p);
    auto F = [&](int i) { return (const float*)d_in[i]; };
    const Bufs B = make_bufs(p);
    for (int l = 0; l < DEPTH; ++l) {
        hipLaunchKernelGGL(k_tables, dim3(grid), dim3(NTHR), 0, stream, p, l);
        for (int pass = 0; pass < NPASS; ++pass) {
            launch_gemm<G_PROJ>(p, l, pass, grid, stream);
            hipLaunchKernelGGL(k_s5a, dim3(grid), dim3(NTHR), S5_LDS, stream, p, l);
            hipLaunchKernelGGL(k_s5scan, dim3(grid), dim3(NTHR), 0, stream, p, l);
            hipLaunchKernelGGL(k_s5b, dim3(grid), dim3(NTHR), S5_LDS, stream, p, l);
            launch_gemm<G_GLU>(p, l, pass, grid, stream);
            hipLaunchKernelGGL(k_xc, dim3(grid), dim3(NTHR), XC_LDS, stream, p, l);
            hipLaunchKernelGGL(k_ssd1, dim3(grid), dim3(NTHR), 0, stream, p);
            hipLaunchKernelGGL(k_ssd2, dim3(grid), dim3(NTHR), 0, stream, p);
            hipLaunchKernelGGL(k_ssd3, dim3(grid), dim3(NTHR), S3_LDS, stream, p, l);
            hipLaunchKernelGGL(n_rms, dim3(M), dim3(64), 0, stream, p, O_CQ, QR, F(20) + l * QR, B.CQN, 256);
            hipLaunchKernelGGL(n_rms, dim3(M), dim3(64), 0, stream, p, O_CKV, KVR, F(22) + l * KVR, B.CKVN, 256);
            launch_gemm<G_Q>(p, l, pass, grid, stream);
            launch_gemm<G_KN>(p, l, pass, grid, stream);
            launch_gemm<G_VT>(p, l, pass, grid, stream);
            hipLaunchKernelGGL(k_rope, dim3(grid), dim3(NTHR), 0, stream, p, pass);
            hipLaunchKernelGGL(k_attn, dim3(grid), dim3(NTHR), AT_LDS, stream, p);
            launch_gemm<G_M0>(p, l, pass, grid, stream);
            launch_gemm<G_M1>(p, l, pass, grid, stream);
            launch_gemm<G_M2>(p, l, pass, grid, stream);
            launch_gemm<G_OUT>(p, l, pass, grid, stream);
            hipLaunchKernelGGL(n_ln, dim3(M), dim3(256), 0, stream, p, pass, F(28) + l * D, F(29) + l * D, 0);
            launch_gemm<G_PQ>(p, l, pass, grid, stream);
#ifdef NAIVE_SEL
            hipLaunchKernelGGL(n_subtop, dim3(M), dim3(256), 0, stream, p, l);
            hipLaunchKernelGGL(n_top2, dim3(M * 8 / 256), dim3(256), 0, stream, p);
#else
            hipLaunchKernelGGL(k_sel, dim3(grid), dim3(NTHR), SEL_LDS, stream, p, l);
#endif
            hipLaunchKernelGGL(k_exp, dim3(grid), dim3(NTHR), 0, stream, p, l, pass, l == DEPTH - 1 ? 1 : 0);
        }
    }
}
```

```cpp
#include <hip/hip_runtime.h>
#include <cstdio>
#include <cstdint>
#include <cmath>
__device__ __forceinline__ int otid() { int t = threadIdx.x; asm volatile("" : "+v"(t)); __builtin_assume(t >= 0 && t < 512); return t; }
struct KIn { __device__ __forceinline__ const float* operator[](int i) const { int o_ = i * 8; asm volatile("" : "+v"(o_)); o_ = __builtin_amdgcn_readfirstlane(o_);
    const __attribute__((address_space(4))) char* base = (const __attribute__((address_space(4))) char*)__builtin_amdgcn_kernarg_segment_ptr();
    return (const float*)*(const __attribute__((address_space(1))) float* const __attribute__((address_space(4)))*)(base + o_); } };
__device__ __forceinline__ KIn kin() { return KIn{}; }
namespace pg8 {
#define PG8_LAS __attribute__((address_space(3)))
typedef unsigned short bf16_t;
typedef short bf16x8 __attribute__((ext_vector_type(8)));
typedef float f32x4 __attribute__((ext_vector_type(4)));
typedef unsigned u32x4 __attribute__((ext_vector_type(4)));
constexpr int BM = 256, BK = 64, HALF = 128, HTB = HALF * BK * 2  , STAGE_BYTES = 8 * HTB, NXCD = 8, WGM = 8;

__host__ __device__ __forceinline__ int lds_byte(int r, int c) { const int st = (r >> 4) * 2 + (c >> 5), rr = r & 15, cc = c & 31, ob = rr * 64 + cc * 2; return st * 1024 + (ob ^ (((ob >> 9) & 1) << 5)); }
__host__ __device__ __forceinline__ void stage_rc(int b, int& R, int& C) { const int st = b / 1024, sb = b % 1024, swz = sb ^ (((sb >> 9) & 1) << 5); R = (st >> 1) * 16 + swz / 64; C = (st & 1) * 32 + (swz % 64) / 2; }
__host__ __device__ __forceinline__ int perm32(int rho) { const int n = rho >> 4, i = rho & 15; return 8 * (i >> 2) + 4 * n + (i & 3); }

struct Unit { int pm, pn; };
struct Gemm { const bf16_t* A; const bf16_t* Bt; int M, N, K; };

struct StaticOrder {
    int nM, nN, nwg, G, c;
    __host__ __device__ void init(int M, int N, int G_, int c_) { nM = M / BM; nN = N / BM; nwg = nM * nN; G = G_; c = c_; }
    __host__ __device__ bool next(int i, Unit& u) const {
        const long L = (long)i * G + c; if (L >= nwg) return false;
        int wgid = (int)L; { const int q = nwg / NXCD, r = nwg % NXCD, xcd = wgid % NXCD, off = wgid / NXCD; wgid = (xcd < r ? xcd * (q + 1) : r * (q + 1) + (xcd - r) * q) + off; }
        const int nig = WGM * nN, gid = wgid / nig, fm = gid * WGM, gsz = (nM - fm) < WGM ? (nM - fm) : WGM;
        u.pm = fm + ((wgid % nig) % gsz); u.pn = (wgid % nig) / gsz; return true;
    }
    __device__ __forceinline__ void a_ready(const Unit&) const {}
    __device__ __forceinline__ void done(const Unit&) const {}
};

__device__ __forceinline__ unsigned cvt_pk_bf16(float lo, float hi) { unsigned r; asm volatile("v_cvt_pk_bf16_f32 %0, %1, %2" : "=v"(r) : "v"(lo), "v"(hi)); return r; }
typedef float f32x2 __attribute__((ext_vector_type(2)));
__device__ __forceinline__ f32x2 gelu_pk(f32x2 v) {
    const f32x2 av = __builtin_elementwise_abs(v), d = av * 0.2316418882f + 1.0f;
    f32x2 t; t.x = __builtin_amdgcn_rcpf(d.x); t.y = __builtin_amdgcn_rcpf(d.y);
    f32x2 q = t * 0.5307027145f + (-0.7265760135f); q = q * t + 0.7107068705f; q = q * t + (-0.142248368f); q = q * t + 0.127414796f; q = q * t;
    const f32x2 s = (v * v) * (-0.72134752044f);
    f32x2 e; e.x = __builtin_amdgcn_exp2f(s.x); e.y = __builtin_amdgcn_exp2f(s.y);
    const f32x2 m = v * (q * e), r = v - m;
    f32x2 o; o.x = v.x < 0.f ? m.x : r.x; o.y = v.y < 0.f ? m.y : r.y; return o;
}

template <int ACT  > struct EpiBf16 {
    static constexpr bool PERM = true, AFTER_DRAIN = false, MIDK = false; static_assert(ACT == 0 || ACT == 1, "EpiBf16: ACT is 0 (none) or 1 (gelu_pk)");
    bf16_t* O; int ldc; const float* bias; int split_cols; size_t split_stride; float scale0;
    __device__ __forceinline__ void operator()(const f32x4 (&acc)[2][2][4][2], const Unit& u, int wr, int wc, int fr_, int fq_) const {
        const int lane_ = otid() & 63, fr = lane_ & 15, fq = lane_ >> 4;
        const int row0 = u.pm * BM + wr * 64 + fr; int colt = u.pn * BM; bf16_t* base = O;
        float sc = 1.f; if (split_cols) { const int t = colt / split_cols; base += (size_t)t * split_stride; colt -= t * split_cols; if (t == 0) sc = scale0; }
        const int col0 = colt + wc * 32 + 8 * fq, bcol0 = u.pn * BM + wc * 32 + 8 * fq;
        f32x4 bv[2][2];
#pragma unroll
        for (int bj = 0; bj < 2; ++bj)
#pragma unroll
            for (int n = 0; n < 2; ++n) bv[bj][n] = bias ? *(const f32x4*)(bias + bcol0 + bj * HALF + 4 * n) : (f32x4){0.f, 0.f, 0.f, 0.f};
#pragma unroll
        for (int ai = 0; ai < 2; ++ai)
#pragma unroll
            for (int m = 0; m < 4; ++m) { bf16_t* rowp = base + (size_t)(row0 + ai * HALF + m * 16) * ldc + col0;
#pragma unroll
                for (int bj = 0; bj < 2; ++bj) { f32x4 v0 = acc[ai][bj][m][0] + bv[bj][0], v1 = acc[ai][bj][m][1] + bv[bj][1];
                    if (ACT == 1) { f32x2 a = gelu_pk((f32x2){v0[0], v0[1]}), b = gelu_pk((f32x2){v0[2], v0[3]}), c = gelu_pk((f32x2){v1[0], v1[1]}), d = gelu_pk((f32x2){v1[2], v1[3]});
                        v0 = (f32x4){a.x, a.y, b.x, b.y}; v1 = (f32x4){c.x, c.y, d.x, d.y}; }
                    v0 = v0 * sc; v1 = v1 * sc; u32x4 w; w.x = cvt_pk_bf16(v0[0], v0[1]); w.y = cvt_pk_bf16(v0[2], v0[3]); w.z = cvt_pk_bf16(v1[0], v1[1]); w.w = cvt_pk_bf16(v1[2], v1[3]);
                    *(u32x4*)(rowp + bj * HALF) = w; } }
    }
};

struct PanelStats {
    unsigned* xbuf;
    unsigned* cnt;
    unsigned* tmo;
    int ntn; float eps;
    unsigned code;
    __device__ __forceinline__ bool run(const f32x4 (&v)[2][2][4][2], const Unit& u, int wr, int wc, int fr, int fq, PG8_LAS unsigned char* lds, int wid, int lane) const {
        typedef float f32x2v __attribute__((ext_vector_type(2)));
        PG8_LAS f32x2v* P = (PG8_LAS f32x2v*)lds;
        PG8_LAS f32x2v* S = (PG8_LAS f32x2v*)(lds + 8192);
        PG8_LAS unsigned* flag = (PG8_LAS unsigned*)(lds + 8192 + 2048);
#pragma unroll
        for (int ai = 0; ai < 2; ++ai)
#pragma unroll
            for (int m = 0; m < 4; ++m) {
                float s = 0.f;
#pragma unroll
                for (int bj = 0; bj < 2; ++bj)
#pragma unroll
                    for (int n = 0; n < 2; ++n) { const f32x4 x = v[ai][bj][m][n]; s += (x[0] + x[1]) + (x[2] + x[3]); }
                s += __shfl_xor(s, 16); s += __shfl_xor(s, 32);
                const float mw = s * (1.0f / 64.0f); float q = 0.f;
#pragma unroll
                for (int bj = 0; bj < 2; ++bj)
#pragma unroll
                    for (int n = 0; n < 2; ++n) { const f32x4 d = v[ai][bj][m][n] - mw; q += (d[0] * d[0] + d[1] * d[1]) + (d[2] * d[2] + d[3] * d[3]); }
                q += __shfl_xor(q, 16); q += __shfl_xor(q, 32);
                if (fq == 0) P[(ai * HALF + wr * 64 + m * 16 + fr) * 4 + wc] = (f32x2v){mw, q};
            }
        asm volatile("s_waitcnt lgkmcnt(0)" ::: "memory"); __builtin_amdgcn_s_barrier(); asm volatile("" ::: "memory");
#if defined(BROKEN_EXCHANGE_NO_WAIT)
#warning BROKEN CONTROL BUILD: the row-statistics exchange does not wait; results are wrong by design
        if (blockIdx.x >= 64) { const long long t0_ = clock64(); while (clock64() - t0_ < 60000) __builtin_amdgcn_s_sleep(8); }
#endif
        const int row = wid * 32 + (lane & 31);
        if (lane < 32) {
            const f32x2v a = P[row * 4 + 0], b = P[row * 4 + 1], c = P[row * 4 + 2], d = P[row * 4 + 3];
            const float mt = (a.x + b.x + c.x + d.x) * 0.25f;
            const float da = a.x - mt, db = b.x - mt, dc = c.x - mt, dd = d.x - mt;
            const float m2 = (a.y + b.y) + (c.y + d.y) + 64.0f * ((da * da + db * db) + (dc * dc + dd * dd));
            unsigned long long* slot = (unsigned long long*)xbuf + ((size_t)(u.pm * BM + row) * 4 + u.pn);
            __hip_atomic_store(slot, ((unsigned long long)__float_as_uint(m2) << 32) | __float_as_uint(mt), __ATOMIC_RELAXED, __HIP_MEMORY_SCOPE_AGENT);
        }
        asm volatile("s_waitcnt vmcnt(0)" ::: "memory");
        if (lane == 0) __hip_atomic_fetch_add(cnt + 64 * u.pm, 1u, __ATOMIC_RELAXED, __HIP_MEMORY_SCOPE_AGENT);
        if (wid == 0) {
            bool dead = false; const unsigned long long t0 = __builtin_amdgcn_s_memrealtime(); const unsigned want = 8u * (unsigned)ntn;
            for (;;) {
#if defined(BROKEN_EXCHANGE_NO_WAIT)
                break;
#endif
                if ((unsigned)__builtin_amdgcn_readfirstlane(__hip_atomic_load(cnt + 64 * u.pm, __ATOMIC_RELAXED, __HIP_MEMORY_SCOPE_AGENT)) >= want) break;
                if (__builtin_amdgcn_s_memrealtime() - t0 > 2000000ull) {
                    if (lane == 0) { unsigned expect = 0u; __hip_atomic_compare_exchange_strong(tmo + 1, &expect, code | (unsigned)(u.pm & 0xff), __ATOMIC_RELAXED, __ATOMIC_RELAXED, __HIP_MEMORY_SCOPE_AGENT);
                                     __hip_atomic_store(tmo, 1u, __ATOMIC_RELAXED, __HIP_MEMORY_SCOPE_AGENT); }
                    dead = true; break; }
                __builtin_amdgcn_s_sleep(2);
            }
            __builtin_amdgcn_fence(__ATOMIC_ACQUIRE, "agent");
            if (lane == 0) flag[0] = dead ? 1u : 0u;
        }
        asm volatile("s_waitcnt vmcnt(0) lgkmcnt(0)" ::: "memory"); __builtin_amdgcn_s_barrier(); asm volatile("" ::: "memory");
        const bool bad = flag[0] != 0u;
        if (lane < 32) {
            const unsigned long long* slot = (const unsigned long long*)xbuf + (size_t)(u.pm * BM + row) * 4; float mt[4], m2[4]; float ms = 0.f;
#pragma unroll
            for (int t = 0; t < 4; ++t) { if (t < ntn) { const unsigned long long w = __hip_atomic_load(slot + t, __ATOMIC_RELAXED, __HIP_MEMORY_SCOPE_AGENT); mt[t] = __uint_as_float((unsigned)w); m2[t] = __uint_as_float((unsigned)(w >> 32)); } else { mt[t] = 0.f; m2[t] = 0.f; } ms += mt[t]; }
            const float mean = ms / (float)ntn; float q = 0.f;
#pragma unroll
            for (int t = 0; t < 4; ++t) if (t < ntn) { const float dm = mt[t] - mean; q += m2[t] + 256.0f * dm * dm; }
            S[row] = (f32x2v){mean, 1.0f / sqrtf(q / (256.0f * (float)ntn) + eps)};
        }
        asm volatile("s_waitcnt lgkmcnt(0)" ::: "memory"); __builtin_amdgcn_s_barrier(); asm volatile("" ::: "memory");
        return bad;
    }
};
struct EpiLnRes {
    static constexpr bool PERM = false, AFTER_DRAIN = true;
    const float* base; float* out; int ldc; const float* bias; PanelStats st; unsigned poison;
    __device__ __forceinline__ void fused(f32x4 (&acc)[2][2][4][2], const Unit& u, int wr, int wc, int fr, int fq, PG8_LAS unsigned char* lds, int wid, int lane) const {
        typedef float f32x2v __attribute__((ext_vector_type(2)));
        const PG8_LAS f32x2v* S = (const PG8_LAS f32x2v*)(lds + 8192);
        const int col0 = u.pn * BM + wc * 32 + 4 * fq;
#pragma unroll
        for (int bj = 0; bj < 2; ++bj)
#pragma unroll
            for (int n = 0; n < 2; ++n) { const f32x4 bv = bias ? *(const f32x4*)(bias + col0 + bj * HALF + n * 16) : (f32x4){0.f, 0.f, 0.f, 0.f};
#pragma unroll
                for (int ai = 0; ai < 2; ++ai)
#pragma unroll
                    for (int m = 0; m < 4; ++m) acc[ai][bj][m][n] += bv; }
        f32x4 pre[4][2][2];
#pragma unroll
        for (int m = 0; m < 4; ++m) { const size_t off = (size_t)(u.pm * BM + wr * 64 + m * 16 + fr) * ldc + col0;
#pragma unroll
            for (int bj = 0; bj < 2; ++bj)
#pragma unroll
                for (int n = 0; n < 2; ++n) pre[m][bj][n] = *(const f32x4*)(base + off + bj * HALF + n * 16); }
        const bool bad = st.run(acc, u, wr, wc, fr, fq, lds, wid, lane) || poison != 0u;
        const float qnan = __builtin_nanf("");
#pragma unroll
        for (int ai = 0; ai < 2; ++ai)
#pragma unroll
            for (int m = 0; m < 4; ++m) { const int r = ai * HALF + wr * 64 + m * 16 + fr; const f32x2v sr = S[r]; const size_t off = (size_t)(u.pm * BM + r) * ldc + col0;
#pragma unroll
                for (int bj = 0; bj < 2; ++bj)
#pragma unroll
                    for (int n = 0; n < 2; ++n) { const f32x4 bs = ai == 0 ? pre[m][bj][n] : *(const f32x4*)(base + off + bj * HALF + n * 16); f32x4 o = bs + (acc[ai][bj][m][n] - sr.x) * sr.y;
                        if (bad) o = (f32x4){qnan, qnan, qnan, qnan}; *(f32x4*)(out + off + bj * HALF + n * 16) = o; }
                if (m & 1) asm volatile("" ::: "memory"); }
    }
};
struct EpiLnResLn {
    static constexpr bool PERM = false, AFTER_DRAIN = true;
    const float* base; float* out; bf16_t* xn; int ldc; const float* bias; PanelStats st1, st2; unsigned poison;
    __device__ __forceinline__ void fused(f32x4 (&acc)[2][2][4][2], const Unit& u, int wr, int wc, int fr, int fq, PG8_LAS unsigned char* lds, int wid, int lane) const {
        typedef float f32x2v __attribute__((ext_vector_type(2))); typedef unsigned u32x2v __attribute__((ext_vector_type(2)));
        const PG8_LAS f32x2v* S = (const PG8_LAS f32x2v*)(lds + 8192);
        const int col0 = u.pn * BM + wc * 32 + 4 * fq;
#pragma unroll
        for (int bj = 0; bj < 2; ++bj)
#pragma unroll
            for (int n = 0; n < 2; ++n) { const f32x4 bv = bias ? *(const f32x4*)(bias + col0 + bj * HALF + n * 16) : (f32x4){0.f, 0.f, 0.f, 0.f};
#pragma unroll
                for (int ai = 0; ai < 2; ++ai)
#pragma unroll
                    for (int m = 0; m < 4; ++m) acc[ai][bj][m][n] += bv; }
        bool bad = st1.run(acc, u, wr, wc, fr, fq, lds, wid, lane) || poison != 0u;
        const float qnan = __builtin_nanf("");
#pragma unroll
        for (int ai = 0; ai < 2; ++ai)
#pragma unroll
            for (int m = 0; m < 4; ++m) { const int r = ai * HALF + wr * 64 + m * 16 + fr; const f32x2v sr = S[r]; const size_t off = (size_t)(u.pm * BM + r) * ldc + col0;
#pragma unroll
                for (int bj = 0; bj < 2; ++bj)
#pragma unroll
                    for (int n = 0; n < 2; ++n) { const f32x4 bs = *(const f32x4*)(base + off + bj * HALF + n * 16); acc[ai][bj][m][n] = bs + (acc[ai][bj][m][n] - sr.x) * sr.y; }
                asm volatile("" : "+v"(acc[ai][0][m][0]), "+v"(acc[ai][0][m][1]), "+v"(acc[ai][1][m][0]), "+v"(acc[ai][1][m][1]));
                if (m & 1) asm volatile("" ::: "memory"); }
        const bool bad1 = bad;
        bad = st2.run(acc, u, wr, wc, fr, fq, lds, wid, lane) || bad;
#pragma unroll
        for (int ai = 0; ai < 2; ++ai)
#pragma unroll
            for (int m = 0; m < 4; ++m) { const int r = ai * HALF + wr * 64 + m * 16 + fr; const f32x2v sr = S[r]; const size_t off = (size_t)(u.pm * BM + r) * ldc + col0;
#pragma unroll
                for (int bj = 0; bj < 2; ++bj)
#pragma unroll
                    for (int n = 0; n < 2; ++n) { const f32x4 x1 = acc[ai][bj][m][n]; *(f32x4*)(out + off + bj * HALF + n * 16) = bad1 ? (f32x4){qnan, qnan, qnan, qnan} : x1;
                        const f32x4 o = (x1 - sr.x) * sr.y; u32x2v w; w.x = cvt_pk_bf16(o[0], o[1]); w.y = cvt_pk_bf16(o[2], o[3]);
                        if (bad) { w.x = 0x7fc07fc0u; w.y = 0x7fc07fc0u; } *(u32x2v*)(xn + off + bj * HALF + n * 16) = w; }
                asm volatile("" ::: "memory"); }
    }
};

template <class Epi, class Sched, bool ALIGN_EPI = false, bool SP2 = false>
__device__ __forceinline__ void gemm_phase(PG8_LAS unsigned char* lds, const Gemm g, const Sched& S, const Epi& E) {
    const int tid = otid(), wid = __builtin_amdgcn_readfirstlane(tid >> 6), lane = tid & 63, wr = wid >> 2, wc = wid & 3, fr = lane & 15, fq = lane >> 4;
    const int K = g.K, nt = K / BK;
    unsigned voffA[2], voffB[2];
#pragma unroll
    for (int i = 0; i < 2; ++i) { int R, C; stage_rc(tid * 16 + i * 8192, R, C); const int Rb = Epi::PERM ? ((R & ~31) + perm32(R & 31)) : R;
        voffA[i] = (unsigned)(R * K + C) * 2u; voffB[i] = (unsigned)(Rb * K + C) * 2u; }
    const size_t kstep = (size_t)(BK * 2);
    const size_t hstep = (size_t)HALF * K * 2;
    const size_t tstep = 2 * hstep;
    const unsigned ldsw = (unsigned)wid * 1024u;
    const int aoff = lds_byte(wr * 64 + fr, fq * 8), boff = lds_byte(wc * 32 + fr, fq * 8);
#define PG8_SA(b, h) (((b) * 2 + (h)) * HTB)
#define PG8_SB(b, h) ((4 + (b) * 2 + (h)) * HTB)
#define PG8_STAGE(bufoff, gbase, voff) do { _Pragma("unroll") for (int _i = 0; _i < 2; ++_i) \
        __builtin_amdgcn_global_load_lds((const unsigned*)((const char*)(gbase) + (voff)[_i]), (PG8_LAS unsigned*)(lds + (bufoff) + ldsw + _i * 8192), 16, 0, 0); } while (0)
#define PG8_LDA(dst, b, h) do { _Pragma("unroll") for (int m = 0; m < 4; ++m) _Pragma("unroll") for (int k = 0; k < 2; ++k) dst[m][k] = *(const PG8_LAS bf16x8*)(lds + PG8_SA(b, h) + aoff + m * 2048 + k * 1024); } while (0)
#define PG8_LDB(dst, b, h) do { _Pragma("unroll") for (int n = 0; n < 2; ++n) _Pragma("unroll") for (int k = 0; k < 2; ++k) dst[n][k] = *(const PG8_LAS bf16x8*)(lds + PG8_SB(b, h) + boff + n * 2048 + k * 1024); } while (0)
#define PG8_MMA(ai, bj, At, Bt) do { __builtin_amdgcn_s_setprio(1); _Pragma("unroll") for (int m = 0; m < 4; ++m) _Pragma("unroll") for (int n = 0; n < 2; ++n) _Pragma("unroll") for (int k = 0; k < 2; ++k) \
        acc[ai][bj][m][n] = __builtin_amdgcn_mfma_f32_16x16x32_bf16(Bt[n][k], At[m][k], acc[ai][bj][m][n], 0, 0, 0); __builtin_amdgcn_s_setprio(0); } while (0)
#define PG8_WAIT_V(n) asm volatile("s_waitcnt vmcnt(" #n ")" ::: "memory")
#define PG8_WAIT_L(n) asm volatile("s_waitcnt lgkmcnt(" #n ")" ::: "memory")
#define PG8_BAR __builtin_amdgcn_s_barrier()
#define PG8_SCHED __builtin_amdgcn_sched_barrier(0)
    Unit cur, nxt; int ui = 0;
    if (!S.next(0, cur)) return;
    f32x4 acc[2][2][4][2];
#pragma unroll
    for (int a = 0; a < 2; ++a)
#pragma unroll
        for (int b = 0; b < 2; ++b)
#pragma unroll
            for (int m = 0; m < 4; ++m)
#pragma unroll
                for (int n = 0; n < 2; ++n) acc[a][b][m][n] = (f32x4){0.f, 0.f, 0.f, 0.f};
    bf16x8 At[4][2], B0[2][2], B1[2][2];
    const char* cA = (const char*)g.A + (size_t)cur.pm * tstep; const char* cB = (const char*)g.Bt + (size_t)cur.pn * tstep;
    S.a_ready(cur);
    if constexpr (SP2) {
        PG8_STAGE(PG8_SB(0, 0), cB, voffB); PG8_STAGE(PG8_SB(0, 1), cB + hstep, voffB); PG8_STAGE(PG8_SA(0, 0), cA, voffA); PG8_STAGE(PG8_SA(0, 1), cA + hstep, voffA);
        if (wr == 1) PG8_BAR;
        PG8_WAIT_V(2); PG8_BAR;
        PG8_STAGE(PG8_SB(1, 0), cB + kstep, voffB); PG8_STAGE(PG8_SA(1, 0), cA + kstep, voffA); PG8_STAGE(PG8_SB(1, 1), cB + hstep + kstep, voffB);
        PG8_WAIT_V(6); PG8_BAR;
    } else {
        PG8_STAGE(PG8_SB(0, 0), cB, voffB); PG8_STAGE(PG8_SA(0, 0), cA, voffA); PG8_STAGE(PG8_SB(0, 1), cB + hstep, voffB); PG8_STAGE(PG8_SA(0, 1), cA + hstep, voffA);
        if (wr == 1) PG8_BAR;
        PG8_WAIT_V(4); PG8_BAR;
        PG8_STAGE(PG8_SB(1, 0), cB + kstep, voffB); PG8_STAGE(PG8_SA(1, 0), cA + kstep, voffA); PG8_STAGE(PG8_SB(1, 1), cB + hstep + kstep, voffB);
        PG8_WAIT_V(6); PG8_BAR;
    }
    for (;;) {
        const bool has_next = S.next(ui + 1, nxt);
        const char* nA = has_next ? (const char*)g.A + (size_t)nxt.pm * tstep : cA; const char* nB = has_next ? (const char*)g.Bt + (size_t)nxt.pn * tstep : cB;
        for (int t = 0; t < nt; t += 2) {
            const bool last = (t == nt - 2);
            const char* a1 = cA + (size_t)(t + 1) * kstep;
            const char* a2 = last ? nA : cA + (size_t)(t + 2) * kstep; const char* b2 = last ? nB : cB + (size_t)(t + 2) * kstep;
            const char* a3 = a2 + kstep; const char* b3 = b2 + kstep;
            if (last && has_next) S.a_ready(nxt);
            if constexpr (SP2) {
            PG8_LDB(B0, 0, 0); PG8_LDB(B1, 0, 1); PG8_SCHED; PG8_LDA(At, 0, 0); PG8_STAGE(PG8_SA(1, 1), a1 + hstep, voffA);
            PG8_WAIT_V(8); PG8_WAIT_L(0); PG8_BAR; PG8_MMA(0, 0, At, B0); PG8_MMA(0, 1, At, B1); PG8_BAR; PG8_SCHED;
            PG8_LDA(At, 0, 1); PG8_STAGE(PG8_SB(0, 0), b2, voffB); PG8_STAGE(PG8_SB(0, 1), b2 + hstep, voffB); PG8_STAGE(PG8_SA(0, 0), a2, voffA);
            PG8_WAIT_V(8); PG8_WAIT_L(0); PG8_BAR; PG8_MMA(1, 0, At, B0); PG8_MMA(1, 1, At, B1); PG8_BAR; PG8_SCHED;
            PG8_LDB(B0, 1, 0); PG8_LDB(B1, 1, 1); PG8_SCHED; PG8_LDA(At, 1, 0); PG8_STAGE(PG8_SA(0, 1), a2 + hstep, voffA);
            PG8_WAIT_V(8); PG8_WAIT_L(0); PG8_BAR; PG8_MMA(0, 0, At, B0); PG8_MMA(0, 1, At, B1); PG8_BAR; PG8_SCHED;
            PG8_LDA(At, 1, 1); PG8_STAGE(PG8_SB(1, 0), b3, voffB); PG8_STAGE(PG8_SB(1, 1), b3 + hstep, voffB); PG8_STAGE(PG8_SA(1, 0), a3, voffA);
            PG8_WAIT_V(8); PG8_WAIT_L(0); PG8_BAR; PG8_MMA(1, 0, At, B0); PG8_MMA(1, 1, At, B1); PG8_BAR; PG8_SCHED;
            } else {
            PG8_LDB(B0, 0, 0); PG8_SCHED; PG8_LDA(At, 0, 0); PG8_STAGE(PG8_SA(1, 1), a1 + hstep, voffA);
            PG8_WAIT_L(8); PG8_BAR; PG8_WAIT_L(0); PG8_MMA(0, 0, At, B0); PG8_BAR; PG8_SCHED;
            PG8_LDB(B1, 0, 1); PG8_STAGE(PG8_SB(0, 0), b2, voffB);
            PG8_BAR; PG8_WAIT_L(0); PG8_MMA(0, 1, At, B1); PG8_BAR;
            PG8_LDA(At, 0, 1); PG8_STAGE(PG8_SA(0, 0), a2, voffA);
            PG8_BAR; PG8_WAIT_L(0); PG8_MMA(1, 0, At, B0); PG8_BAR; PG8_SCHED;
            PG8_STAGE(PG8_SB(0, 1), b2 + hstep, voffB);
            PG8_WAIT_V(6); PG8_BAR; PG8_MMA(1, 1, At, B1); PG8_BAR;
            PG8_LDB(B0, 1, 0); PG8_SCHED; PG8_LDA(At, 1, 0); PG8_STAGE(PG8_SA(0, 1), a2 + hstep, voffA);
            PG8_WAIT_L(8); PG8_BAR; PG8_WAIT_L(0); PG8_MMA(0, 0, At, B0); PG8_BAR; PG8_SCHED;
            PG8_LDB(B1, 1, 1); PG8_STAGE(PG8_SB(1, 0), b3, voffB);
            PG8_BAR; PG8_WAIT_L(0); PG8_MMA(0, 1, At, B1); PG8_BAR;
            PG8_LDA(At, 1, 1); PG8_STAGE(PG8_SA(1, 0), a3, voffA);
            PG8_BAR; PG8_WAIT_L(0); PG8_MMA(1, 0, At, B0); PG8_BAR; PG8_SCHED;
            PG8_STAGE(PG8_SB(1, 1), b3 + hstep, voffB);
            PG8_WAIT_V(6); PG8_BAR; PG8_MMA(1, 1, At, B1); PG8_BAR;
            }
            if constexpr (Epi::MIDK) { if (E.is_boundary(t + 2)) E.mid(acc, cur, t + 2, wr, wc); }
        }
        if constexpr (ALIGN_EPI) { if (wr == 0) PG8_BAR; }
        if constexpr (!Epi::AFTER_DRAIN) { E(acc, cur, wr, wc, fr, fq); S.done(cur); }
        if (!has_next) break;
#pragma unroll
        for (int a = 0; a < 2; ++a)
#pragma unroll
            for (int b = 0; b < 2; ++b)
#pragma unroll
                for (int m = 0; m < 4; ++m)
#pragma unroll
                    for (int n = 0; n < 2; ++n) acc[a][b][m][n] = (f32x4){0.f, 0.f, 0.f, 0.f};
        cur = nxt; cA = nA; cB = nB; ++ui;
        if constexpr (ALIGN_EPI) { if (wr == 1) PG8_BAR; }
    }
    PG8_WAIT_V(0);
    if constexpr (!ALIGN_EPI) { if (wr == 0) PG8_BAR; }
    PG8_BAR;
    if constexpr (Epi::AFTER_DRAIN) { E.fused(acc, cur, wr, wc, fr, fq, lds, wid, lane); S.done(cur); }
#undef PG8_SA
#undef PG8_SB
#undef PG8_STAGE
#undef PG8_LDA
#undef PG8_LDB
#undef PG8_MMA
#undef PG8_WAIT_V
#undef PG8_WAIT_L
#undef PG8_BAR
#undef PG8_SCHED
}
}
#define GAS __attribute__((address_space(1)))
#define LAS __attribute__((address_space(3)))
typedef unsigned short bf16;
typedef unsigned v4u __attribute__((ext_vector_type(4)));
typedef unsigned v2u __attribute__((ext_vector_type(2)));
typedef float f32x4 __attribute__((ext_vector_type(4)));
typedef float f32x16 __attribute__((ext_vector_type(16)));
typedef short bf16x8 __attribute__((ext_vector_type(8)));
typedef GAS unsigned gu32;
typedef GAS unsigned long long gu64;
#define RLX_AGENT __ATOMIC_RELAXED, __HIP_MEMORY_SCOPE_AGENT
#define LDS_WAIT() asm volatile("s_waitcnt lgkmcnt(0)" ::: "memory")
#define VM_WAIT() asm volatile("s_waitcnt vmcnt(0)" ::: "memory")
typedef float f32x2_cv __attribute__((ext_vector_type(2))); typedef __bf16 bf16x2_cv __attribute__((ext_vector_type(2)));
__device__ __forceinline__ unsigned pk2(float lo, float hi) { const f32x2_cv v = {lo, hi}; const bf16x2_cv b = __builtin_convertvector(v, bf16x2_cv); return __builtin_bit_cast(unsigned, b); }
__device__ __forceinline__ unsigned f2bf(float f) { return pk2(f, 0.f) & 0xffffu; }
__device__ __forceinline__ float bf2f(unsigned short v) { return __builtin_bit_cast(float, (unsigned)v << 16); }
__device__ __forceinline__ float bflo(unsigned w) { return __builtin_bit_cast(float, w << 16); }
__device__ __forceinline__ float bfhi(unsigned w) { return __builtin_bit_cast(float, w & 0xffff0000u); }
__device__ __forceinline__ float sx(float v, int m) { const int a = ((otid() & 63) ^ m) << 2; return __builtin_bit_cast(float, __builtin_amdgcn_ds_bpermute(a, __builtin_bit_cast(int, v))); }
__device__ __forceinline__ float sl(float v, int srcl) { int a = srcl << 2; return __builtin_bit_cast(float, __builtin_amdgcn_ds_bpermute(a, __builtin_bit_cast(int, v))); }
__device__ __forceinline__ float sup(float v, int o) { const int l = otid() & 63; const int a = (l >= o ? l - o : l) << 2; return __builtin_bit_cast(float, __builtin_amdgcn_ds_bpermute(a, __builtin_bit_cast(int, v))); }
#define XB_TMO      128
#define XB_XCNT(j)  (256  + 64 * (j))
#define XB_XSUB(j)  (1280 + 64 * (j))
#define XB_XGEN(j)  (2304 + 64 * (j))
#define XB_TOP      3328
#define XB_TOPGEN   3392
#define XCD_BAR_WORDS 3456
#define XB_SPIN_CAP (1u << 18)

__device__ __forceinline__ unsigned xb_ld(unsigned* p)              { return __hip_atomic_load(p, __ATOMIC_RELAXED, __HIP_MEMORY_SCOPE_AGENT); }
__device__ __forceinline__ unsigned xb_add(unsigned* p, unsigned v) { return __hip_atomic_fetch_add(p, v, __ATOMIC_RELAXED, __HIP_MEMORY_SCOPE_AGENT); }
__device__ __forceinline__ unsigned xb_xcc_id() { return (unsigned)__builtin_amdgcn_s_getreg((3 << 11) | 20) & 0xFu; }
#define XB_SPIN(cond, bar) do { unsigned _sp = 0; while (cond) { __builtin_amdgcn_s_sleep(1); \
    if ((++_sp & 255u) == 0u) { if (xb_ld(&(bar)[XB_TMO])) break; if (_sp > XB_SPIN_CAP) { atomicAdd(&(bar)[XB_TMO], 1u); break; } } } } while (0)

struct XcdBarrier {
    unsigned* bar; unsigned x;
    volatile LAS unsigned* st;
};

__device__ __forceinline__ XcdBarrier xcd_barrier_post(unsigned* bar, volatile LAS unsigned* st) {
    XcdBarrier b; b.bar = bar; b.x = xb_xcc_id(); b.st = st;
    if (threadIdx.x == 0) (void)xb_add(&bar[XB_XCNT(b.x)], 1u);
    return b;
}
__device__ __forceinline__ void xcd_barrier_complete(unsigned* bar, unsigned x, unsigned& nloc, unsigned& nx) {
    const unsigned G = gridDim.x * gridDim.y * gridDim.z;
    unsigned sum, cnt, mine, sp = 0u;
    for (;;) {
        sum = 0u; cnt = 0u; mine = 0u;
#pragma unroll
        for (unsigned j = 0; j < 16; ++j) { const unsigned c = xb_ld(&bar[XB_XCNT(j)]); sum += c; cnt += (c > 0u) ? 1u : 0u; mine = (j == x) ? c : mine; }
        if (sum == G) break;
        __builtin_amdgcn_s_sleep(1);
        if ((++sp & 255u) == 0u) { if (xb_ld(&bar[XB_TMO])) break; if (sp > XB_SPIN_CAP) { atomicAdd(&bar[XB_TMO], 1u); break; } }
    }
    nloc = mine > 0u ? mine : 1u; nx = cnt > 0u ? cnt : 1u;
}

__device__ __forceinline__ void xcd_barrier(const XcdBarrier& b) {
    asm volatile("s_waitcnt vmcnt(0)" ::: "memory");
    __syncthreads();
    if (threadIdx.x == 0) {
        unsigned* bar = b.bar;
        __builtin_amdgcn_s_waitcnt(0);
        unsigned nloc = b.st[0], nx = b.st[1];
        if (nloc == 0u) { xcd_barrier_complete(bar, b.x, nloc, nx); b.st[0] = nloc; b.st[1] = nx; }
        const unsigned old = xb_add(&bar[XB_XSUB(b.x)], 1u);
        const unsigned gen = old / nloc;
        if (old + 1u == (gen + 1u) * nloc) {
            __builtin_amdgcn_fence(__ATOMIC_RELEASE, "agent");
            asm volatile("s_waitcnt vmcnt(0)" ::: "memory");
            const unsigned og = xb_add(&bar[XB_TOP], 1u);
            const unsigned tg = og / nx;
            if (og + 1u == (tg + 1u) * nx) xb_add(&bar[XB_TOPGEN], 1u);
            else XB_SPIN(xb_ld(&bar[XB_TOPGEN]) == tg, bar);
            __builtin_amdgcn_fence(__ATOMIC_ACQUIRE, "agent");
            xb_add(&bar[XB_XGEN(b.x)], 1u);
            asm volatile("s_waitcnt vmcnt(0)" ::: "memory");
        } else {
            XB_SPIN(xb_ld(&bar[XB_XGEN(b.x)]) == gen, bar);
            __builtin_amdgcn_fence(__ATOMIC_ACQUIRE, "agent");
            asm volatile("s_waitcnt vmcnt(0)" ::: "memory");
        }
    }
    __syncthreads();
}
constexpr int D = 1024, NB = 4, SEQ = 8192, DEPTH = 2;
constexpr int NBP = 2, M = NBP * SEQ, NPASS = NB / NBP;
constexpr int INW = 5416, PROJW = 2560, GATEW = 3072, WIN_N = PROJW + GATEW;
constexpr int O_U = 0, O_Z = 384, O_XBC = 896, O_DT = 1920, O_CQ = 1928, O_CKV = 2184, O_KR = 2312, O_G = 2344;
constexpr int S5W = 384, S5G = 24, S5P = 64;
constexpr int M2I = 512, M2H = 8, M2P = 64, M2N = 128, M2C = 1024;
constexpr int QR = 256, KVR = 128, AH = 8;
constexpr int PK = 128, PT = 16, PE = 16384;
constexpr float ALPHA = 1.41421356237f;
constexpr int NWAVES = 8, NTHR = 512;

constexpr size_t MiB = 1u << 20;
constexpr size_t WS_CTL = 0, CTL_ZERO_BYTES = 1 * MiB;
constexpr size_t WS_W = 1 * MiB, WL_BYTES = 22 * MiB;
constexpr size_t WO_WIN = 0, WO_WQ = 11 * MiB, WO_WOUT = 15 * MiB, WO_BRA = 17 * MiB, WO_BRB = 17 * MiB + 768 * 1024, WO_BRC = 18 * MiB + 768 * 1024,
                 WO_GLU = 19 * MiB + 768 * 1024, WO_UQ = 20 * MiB + 128 * 1024, WO_KN = 20 * MiB + 512 * 1024, WO_VW = 20 * MiB + 768 * 1024, WO_SK = 21 * MiB,
                 WO_S5BF = 21 * MiB + 64 * 1024, WO_S5CF = 21 * MiB + 256 * 1024, WO_S5AB = 21 * MiB + 352 * 1024;
constexpr size_t WS_WEND = WS_W + DEPTH * WL_BYTES;
constexpr size_t WS_TABU = 45 * MiB, WS_TABV = 77 * MiB;
constexpr size_t WS_SU = 256 * 1024, WS_SV = 384 * 1024;
constexpr size_t WS_HB = 109 * MiB;
constexpr size_t WS_PROJ = 173 * MiB;
constexpr size_t WS_GATES = 253 * MiB;
constexpr int YCW = 1408, YC_A = 0, YC_B = 384, YC_C = 896;
constexpr size_t WS_YA = 349 * MiB;
constexpr size_t WS_TMP = 393 * MiB;
constexpr size_t WS_Z = WS_TMP, WS_XT = WS_TMP + 12 * MiB, WS_BN = WS_TMP + 28 * MiB, WS_BT = WS_TMP + 36 * MiB, WS_CN = WS_TMP + 44 * MiB, WS_ST = WS_TMP + 52 * MiB, WS_PREV = WS_TMP + 84 * MiB,
                 WS_CQN = WS_TMP + 100 * MiB, WS_CKVN = WS_TMP + 108 * MiB, WS_ES = WS_TMP + 116 * MiB;
constexpr size_t WS_END = 512 * MiB;
constexpr size_t WS_MERGED = WS_PROJ, WS_TS = WS_PROJ + 32 * MiB, WS_TI = WS_PROJ + 48 * MiB, WS_IDX = WS_PROJ, WS_GW = WS_PROJ + 8 * MiB;
constexpr size_t WS_PQ = WS_GATES;
constexpr int VT_P = M + 64;
constexpr size_t OS_Q = 0, OS_KN = 24 * MiB, OS_VT = 40 * MiB, OS_KR = 57 * MiB;
constexpr size_t OS_SDT = 58 * MiB, OS_SAC = 59 * MiB, OS_SW = 60 * MiB, OS_CDEC = 61 * MiB;
constexpr size_t OS_F32 = 0;

struct Params {
    const float* in[36];
    float* out; unsigned char* ws;
};

__device__ __forceinline__ float fexp(float x) { return __builtin_amdgcn_exp2f(x * 1.4426950408889634f); }
__device__ __forceinline__ float flog(float x) { return __builtin_amdgcn_logf(x) * 0.6931471805599453f; }
__device__ __forceinline__ void fsincos(float ang, float& sn, float& cs) { const float rev = __builtin_amdgcn_fractf(ang * 0.15915494309189535f); sn = __builtin_amdgcn_sinf(rev); cs = __builtin_amdgcn_cosf(rev); }
__device__ __forceinline__ f32x4 zero4() { f32x4 z = {0.f, 0.f, 0.f, 0.f}; asm volatile("" : "+v"(z)); return z; }
__device__ __forceinline__ float sigm_f(float x) { return __builtin_amdgcn_rcpf(1.f + __builtin_amdgcn_exp2f(-1.4426950408889634f * x)); }
__device__ __forceinline__ float gelu_t(float x) { const float u = 0.7978845608028654f * (x + 0.044715f * x * x * x); const float e = __builtin_amdgcn_exp2f(2.885390081777927f * u); return x * (1.f - __builtin_amdgcn_rcpf(1.f + e)); }
typedef _Float16 h2_t __attribute__((ext_vector_type(2)));
typedef __bf16 b2_t __attribute__((ext_vector_type(2)));
__device__ __forceinline__ unsigned pkh2(float lo, float hi) { const h2_t h = {(_Float16)lo, (_Float16)hi}; return __builtin_bit_cast(unsigned, h); }
typedef __bf16 b8_t __attribute__((ext_vector_type(8)));
__device__ __forceinline__ float dot8bf(v4u a, v4u b, float c) {
    const b8_t x = __builtin_bit_cast(b8_t, a), y = __builtin_bit_cast(b8_t, b);
    c = __builtin_amdgcn_fdot2_f32_bf16(__builtin_shufflevector(x, x, 0, 1), __builtin_shufflevector(y, y, 0, 1), c, false);
    c = __builtin_amdgcn_fdot2_f32_bf16(__builtin_shufflevector(x, x, 2, 3), __builtin_shufflevector(y, y, 2, 3), c, false);
    c = __builtin_amdgcn_fdot2_f32_bf16(__builtin_shufflevector(x, x, 4, 5), __builtin_shufflevector(y, y, 4, 5), c, false);
    c = __builtin_amdgcn_fdot2_f32_bf16(__builtin_shufflevector(x, x, 6, 7), __builtin_shufflevector(y, y, 6, 7), c, false);
    return c; }
__device__ __forceinline__ unsigned fbits(float f) { return __builtin_bit_cast(unsigned, f); }
__device__ __forceinline__ float bitsf(unsigned u) { return __builtin_bit_cast(float, u); }
__device__ __forceinline__ float hlo(unsigned w) { const h2_t h = __builtin_bit_cast(h2_t, w); return (float)h.x; }
__device__ __forceinline__ float hhi(unsigned w) { const h2_t h = __builtin_bit_cast(h2_t, w); return (float)h.y; }
__device__ __forceinline__ float wsum(float v) {
#pragma unroll
    for (int o = 32; o > 0; o >>= 1) v += sx(v, o);
    return v; }

namespace pg8 {
struct EpiProj {
    static constexpr bool PERM = true, AFTER_DRAIN = false, MIDK = false;
    bf16_t* proj; bf16_t* gates;
    __device__ __forceinline__ void operator()(const f32x4 (&acc)[2][2][4][2], const Unit& u, int wr, int wc, int fr_, int fq_) const {
        const int tid_ = otid(), lane_ = tid_ & 63, fr = lane_ & 15, fq = lane_ >> 4;
        const int row0 = u.pm * BM + wr * 64 + fr; const bool isg = u.pn >= 10;
        const int col0 = u.pn * BM + wc * 32 + 8 * fq;
        u32x4* gt = (u32x4*)gates + ((size_t)(u.pm * 12 + (u.pn - 10)) * 16) * 512 + tid_;
#pragma unroll
        for (int ai = 0; ai < 2; ++ai)
#pragma unroll
            for (int m = 0; m < 4; ++m) { bf16_t* rowp = proj + (size_t)(row0 + ai * HALF + m * 16) * 2560 + col0;
#pragma unroll
                for (int bj = 0; bj < 2; ++bj) { f32x4 v0 = acc[ai][bj][m][0], v1 = acc[ai][bj][m][1];
                    if (isg) {
#pragma unroll
                        for (int e = 0; e < 4; ++e) { v0[e] = sigm_f(v0[e]); v1[e] = sigm_f(v1[e]); } }
                    u32x4 w; w.x = cvt_pk_bf16(v0[0], v0[1]); w.y = cvt_pk_bf16(v0[2], v0[3]); w.z = cvt_pk_bf16(v1[0], v1[1]); w.w = cvt_pk_bf16(v1[2], v1[3]);
                    if (isg) gt[((ai * 4 + m) * 2 + bj) * 512] = w; else *(u32x4*)(rowp + bj * HALF) = w; } }
    }
};
struct EpiGlu {
    static constexpr bool PERM = true, AFTER_DRAIN = false, MIDK = false;
    const bf16_t* z; bf16_t* ya;
    __device__ __forceinline__ void operator()(const f32x4 (&acc)[2][2][4][2], const Unit& u, int wr, int wc, int fr_, int fq_) const {
        const int lane_ = otid() & 63, fr = lane_ & 15, fq = lane_ >> 4;
        const int row0 = u.pm * BM + wr * 64 + fr; const int col0 = u.pn * BM + wc * 32 + 8 * fq;
#pragma unroll
        for (int ai = 0; ai < 2; ++ai)
#pragma unroll
            for (int m = 0; m < 4; ++m) { const size_t ro = (size_t)(row0 + ai * HALF + m * 16) * 384, ry = (size_t)(row0 + ai * HALF + m * 16) * 1408;
#pragma unroll
                for (int bj = 0; bj < 2; ++bj) { const int c = col0 + bj * HALF; if (c < 384) {
                    const u32x4 zz = *(const u32x4*)(z + ro + c); const f32x4 v0 = acc[ai][bj][m][0], v1 = acc[ai][bj][m][1];
                    float zf[8] = {__builtin_bit_cast(float, zz.x << 16), __builtin_bit_cast(float, zz.x & 0xffff0000u), __builtin_bit_cast(float, zz.y << 16), __builtin_bit_cast(float, zz.y & 0xffff0000u),
                                   __builtin_bit_cast(float, zz.z << 16), __builtin_bit_cast(float, zz.z & 0xffff0000u), __builtin_bit_cast(float, zz.w << 16), __builtin_bit_cast(float, zz.w & 0xffff0000u)};
                    u32x4 w; w.x = cvt_pk_bf16(zf[0] * sigm_f(v0[0]), zf[1] * sigm_f(v0[1])); w.y = cvt_pk_bf16(zf[2] * sigm_f(v0[2]), zf[3] * sigm_f(v0[3]));
                    w.z = cvt_pk_bf16(zf[4] * sigm_f(v1[0]), zf[5] * sigm_f(v1[1])); w.w = cvt_pk_bf16(zf[6] * sigm_f(v1[2]), zf[7] * sigm_f(v1[3]));
                    *(u32x4*)(ya + ry + c) = w; } }
                asm volatile("" ::: "memory"); }
    }
};
struct EpiMergeCat {
    static constexpr bool PERM = true, AFTER_DRAIN = false, MIDK = true;
    const bf16_t* gates; bf16_t* merged;
    __device__ __forceinline__ bool is_boundary(int kt) const { return kt == 6 || kt == 14; }
    __device__ __forceinline__ const u32x4* gtile(const Unit& u, int gi, int tid_) const { return (const u32x4*)gates + ((size_t)(u.pm * 12 + gi * 4 + u.pn) * 16) * 512 + tid_; }
    static __device__ __forceinline__ float glo(unsigned w) { return fmaxf(__builtin_bit_cast(float, w << 16), 1e-20f); }
    static __device__ __forceinline__ float ghi(unsigned w) { return fmaxf(__builtin_bit_cast(float, w & 0xffff0000u), 1e-20f); }
    __device__ __forceinline__ void mid(f32x4 (&acc)[2][2][4][2], const Unit& u, int kt, int wr, int wc) const {
        const int tid_ = otid(); const int gi = kt == 6 ? 0 : 1;
        const u32x4* gx = gtile(u, gi, tid_); const u32x4* gy = gtile(u, gi + 1, tid_);
#pragma unroll
        for (int ai = 0; ai < 2; ++ai)
#pragma unroll
            for (int m = 0; m < 4; ++m) {
#pragma unroll
                for (int bj = 0; bj < 2; ++bj) { const int slot = ((ai * 4 + m) * 2 + bj) * 512; const u32x4 x = gx[slot], y = gy[slot];
                    f32x4 v0 = acc[ai][bj][m][0], v1 = acc[ai][bj][m][1];
                    v0[0] *= glo(x.x) * __builtin_amdgcn_rcpf(glo(y.x)); v0[1] *= ghi(x.x) * __builtin_amdgcn_rcpf(ghi(y.x)); v0[2] *= glo(x.y) * __builtin_amdgcn_rcpf(glo(y.y)); v0[3] *= ghi(x.y) * __builtin_amdgcn_rcpf(ghi(y.y));
                    v1[0] *= glo(x.z) * __builtin_amdgcn_rcpf(glo(y.z)); v1[1] *= ghi(x.z) * __builtin_amdgcn_rcpf(ghi(y.z)); v1[2] *= glo(x.w) * __builtin_amdgcn_rcpf(glo(y.w)); v1[3] *= ghi(x.w) * __builtin_amdgcn_rcpf(ghi(y.w));
                    acc[ai][bj][m][0] = v0; acc[ai][bj][m][1] = v1; }
                asm volatile("" ::: "memory"); }
    }
    __device__ __forceinline__ void operator()(const f32x4 (&acc)[2][2][4][2], const Unit& u, int wr, int wc, int fr_, int fq_) const {
        const int tid_ = otid(), lane_ = tid_ & 63, fr = lane_ & 15, fq = lane_ >> 4;
        const int row0 = u.pm * BM + wr * 64 + fr; const int col0 = u.pn * BM + wc * 32 + 8 * fq;
        const u32x4* gc = gtile(u, 2, tid_);
#pragma unroll
        for (int ai = 0; ai < 2; ++ai)
#pragma unroll
            for (int m = 0; m < 4; ++m) { bf16_t* rowp = merged + (size_t)(row0 + ai * HALF + m * 16) * 1024 + col0;
#pragma unroll
                for (int bj = 0; bj < 2; ++bj) { const u32x4 g = gc[((ai * 4 + m) * 2 + bj) * 512]; const f32x4 v0 = acc[ai][bj][m][0], v1 = acc[ai][bj][m][1];
                    u32x4 w; w.x = cvt_pk_bf16(v0[0] * glo(g.x), v0[1] * ghi(g.x)); w.y = cvt_pk_bf16(v0[2] * glo(g.y), v0[3] * ghi(g.y)); w.z = cvt_pk_bf16(v1[0] * glo(g.z), v1[1] * ghi(g.z)); w.w = cvt_pk_bf16(v1[2] * glo(g.w), v1[3] * ghi(g.w));
                    *(u32x4*)(rowp + bj * HALF) = w; }
                asm volatile("" ::: "memory"); }
    }
};
struct EpiF32 {
    static constexpr bool PERM = false, AFTER_DRAIN = false, MIDK = false;
    float* O; int ldc;
    __device__ __forceinline__ void operator()(const f32x4 (&acc)[2][2][4][2], const Unit& u, int wr, int wc, int fr_, int fq_) const {
        const int lane_ = otid() & 63, fr = lane_ & 15, fq = lane_ >> 4;
        const int row0 = u.pm * BM + wr * 64 + fr; const int col0 = u.pn * BM + wc * 32 + 4 * fq;
#pragma unroll
        for (int ai = 0; ai < 2; ++ai)
#pragma unroll
            for (int m = 0; m < 4; ++m) { float* rowp = O + (size_t)(row0 + ai * HALF + m * 16) * ldc + col0;
#pragma unroll
                for (int bj = 0; bj < 2; ++bj)
#pragma unroll
                    for (int n = 0; n < 2; ++n) *(f32x4*)(rowp + bj * HALF + 16 * n) = acc[ai][bj][m][n]; }
    }
};
}

struct Bufs {
    unsigned char* ws; unsigned char* os;
    __device__ __forceinline__ bf16* HB() const { unsigned o_ = (unsigned)WS_HB; asm volatile("" : "+v"(o_)); return (bf16*)(ws + (unsigned)__builtin_amdgcn_readfirstlane((int)o_)); }
    __device__ __forceinline__ bf16* PROJ() const { unsigned o_ = (unsigned)WS_PROJ; asm volatile("" : "+v"(o_)); return (bf16*)(ws + (unsigned)__builtin_amdgcn_readfirstlane((int)o_)); }
    __device__ __forceinline__ bf16* GATES() const { unsigned o_ = (unsigned)WS_GATES; asm volatile("" : "+v"(o_)); return (bf16*)(ws + (unsigned)__builtin_amdgcn_readfirstlane((int)o_)); }
    __device__ __forceinline__ bf16* YA() const { unsigned o_ = (unsigned)WS_YA; asm volatile("" : "+v"(o_)); return (bf16*)(ws + (unsigned)__builtin_amdgcn_readfirstlane((int)o_)); }
    __device__ __forceinline__ bf16* Z() const { unsigned o_ = (unsigned)WS_Z; asm volatile("" : "+v"(o_)); return (bf16*)(ws + (unsigned)__builtin_amdgcn_readfirstlane((int)o_)); }
    __device__ __forceinline__ bf16* XT() const { unsigned o_ = (unsigned)WS_XT; asm volatile("" : "+v"(o_)); return (bf16*)(ws + (unsigned)__builtin_amdgcn_readfirstlane((int)o_)); }
    __device__ __forceinline__ bf16* BN() const { unsigned o_ = (unsigned)WS_BN; asm volatile("" : "+v"(o_)); return (bf16*)(ws + (unsigned)__builtin_amdgcn_readfirstlane((int)o_)); }
    __device__ __forceinline__ bf16* BT() const { unsigned o_ = (unsigned)WS_BT; asm volatile("" : "+v"(o_)); return (bf16*)(ws + (unsigned)__builtin_amdgcn_readfirstlane((int)o_)); }
    __device__ __forceinline__ bf16* CN() const { unsigned o_ = (unsigned)WS_CN; asm volatile("" : "+v"(o_)); return (bf16*)(ws + (unsigned)__builtin_amdgcn_readfirstlane((int)o_)); }
    __device__ __forceinline__ bf16* PREV() const { unsigned o_ = (unsigned)WS_PREV; asm volatile("" : "+v"(o_)); return (bf16*)(ws + (unsigned)__builtin_amdgcn_readfirstlane((int)o_)); }
    __device__ __forceinline__ bf16* CQN() const { unsigned o_ = (unsigned)WS_CQN; asm volatile("" : "+v"(o_)); return (bf16*)(ws + (unsigned)__builtin_amdgcn_readfirstlane((int)o_)); }
    __device__ __forceinline__ bf16* CKVN() const { unsigned o_ = (unsigned)WS_CKVN; asm volatile("" : "+v"(o_)); return (bf16*)(ws + (unsigned)__builtin_amdgcn_readfirstlane((int)o_)); }
    __device__ __forceinline__ bf16* MERGED() const { unsigned o_ = (unsigned)WS_MERGED; asm volatile("" : "+v"(o_)); return (bf16*)(ws + (unsigned)__builtin_amdgcn_readfirstlane((int)o_)); }
    __device__ __forceinline__ bf16* PQ() const { unsigned o_ = (unsigned)WS_PQ; asm volatile("" : "+v"(o_)); return (bf16*)(ws + (unsigned)__builtin_amdgcn_readfirstlane((int)o_)); }
    __device__ __forceinline__ bf16* Q() const { unsigned o_ = (unsigned)OS_Q; asm volatile("" : "+v"(o_)); return (bf16*)(os + (unsigned)__builtin_amdgcn_readfirstlane((int)o_)); }
    __device__ __forceinline__ bf16* KN() const { unsigned o_ = (unsigned)OS_KN; asm volatile("" : "+v"(o_)); return (bf16*)(os + (unsigned)__builtin_amdgcn_readfirstlane((int)o_)); }
    __device__ __forceinline__ bf16* VT() const { unsigned o_ = (unsigned)OS_VT; asm volatile("" : "+v"(o_)); return (bf16*)(os + (unsigned)__builtin_amdgcn_readfirstlane((int)o_)); }
    __device__ __forceinline__ bf16* KR() const { unsigned o_ = (unsigned)OS_KR; asm volatile("" : "+v"(o_)); return (bf16*)(os + (unsigned)__builtin_amdgcn_readfirstlane((int)o_)); }
    __device__ __forceinline__ unsigned char* TABU() const { unsigned o_ = (unsigned)WS_TABU; asm volatile("" : "+v"(o_)); return ws + (unsigned)__builtin_amdgcn_readfirstlane((int)o_); }
    __device__ __forceinline__ unsigned char* TABV() const { unsigned o_ = (unsigned)WS_TABV; asm volatile("" : "+v"(o_)); return ws + (unsigned)__builtin_amdgcn_readfirstlane((int)o_); }
    __device__ __forceinline__ float* SU() const { unsigned o_ = (unsigned)WS_SU; asm volatile("" : "+v"(o_)); return (float*)(ws + (unsigned)__builtin_amdgcn_readfirstlane((int)o_)); }
    __device__ __forceinline__ float* SV() const { unsigned o_ = (unsigned)WS_SV; asm volatile("" : "+v"(o_)); return (float*)(ws + (unsigned)__builtin_amdgcn_readfirstlane((int)o_)); }
    __device__ __forceinline__ float* ST() const { unsigned o_ = (unsigned)WS_ST; asm volatile("" : "+v"(o_)); return (float*)(ws + (unsigned)__builtin_amdgcn_readfirstlane((int)o_)); }
    __device__ __forceinline__ float* TS() const { unsigned o_ = (unsigned)WS_TS; asm volatile("" : "+v"(o_)); return (float*)(ws + (unsigned)__builtin_amdgcn_readfirstlane((int)o_)); }
    __device__ __forceinline__ float* GW() const { unsigned o_ = (unsigned)WS_GW; asm volatile("" : "+v"(o_)); return (float*)(ws + (unsigned)__builtin_amdgcn_readfirstlane((int)o_)); }
    __device__ __forceinline__ float* ES() const { unsigned o_ = (unsigned)WS_ES; asm volatile("" : "+v"(o_)); return (float*)(ws + (unsigned)__builtin_amdgcn_readfirstlane((int)o_)); }
    __device__ __forceinline__ float* SDT() const { unsigned o_ = (unsigned)OS_SDT; asm volatile("" : "+v"(o_)); return (float*)(os + (unsigned)__builtin_amdgcn_readfirstlane((int)o_)); }
    __device__ __forceinline__ float* SAC() const { unsigned o_ = (unsigned)OS_SAC; asm volatile("" : "+v"(o_)); return (float*)(os + (unsigned)__builtin_amdgcn_readfirstlane((int)o_)); }
    __device__ __forceinline__ float* SW() const { unsigned o_ = (unsigned)OS_SW; asm volatile("" : "+v"(o_)); return (float*)(os + (unsigned)__builtin_amdgcn_readfirstlane((int)o_)); }
    __device__ __forceinline__ float* CDEC() const { unsigned o_ = (unsigned)OS_CDEC; asm volatile("" : "+v"(o_)); return (float*)(os + (unsigned)__builtin_amdgcn_readfirstlane((int)o_)); }
    __device__ __forceinline__ float* F32() const { unsigned o_ = (unsigned)OS_F32; asm volatile("" : "+v"(o_)); return (float*)(os + (unsigned)__builtin_amdgcn_readfirstlane((int)o_)); }
    __device__ __forceinline__ int* TI() const { unsigned o_ = (unsigned)WS_TI; asm volatile("" : "+v"(o_)); return (int*)(ws + (unsigned)__builtin_amdgcn_readfirstlane((int)o_)); }
    __device__ __forceinline__ int* IDX() const { unsigned o_ = (unsigned)WS_IDX; asm volatile("" : "+v"(o_)); return (int*)(ws + (unsigned)__builtin_amdgcn_readfirstlane((int)o_)); }
};
__device__ __forceinline__ Bufs make_bufs(const Params& p) { Bufs b; b.ws = p.ws; b.os = (unsigned char*)p.out + 64 * MiB; return b; }
__device__ __forceinline__ unsigned char* wl_ptr(const Params& p, int l) { unsigned o_ = (unsigned)(WS_W + (size_t)l * WL_BYTES); asm volatile("" : "+v"(o_)); return p.ws + (unsigned)__builtin_amdgcn_readfirstlane((int)o_); }

__device__ __forceinline__ void tr_item(const float* W, int ldw, int col0, int ncols, bf16* WT, int Kd, int row0, int koff, LAS float* scr, int item, int lane) {
    const int nblk = (ncols + 63) / 64, kb = item / nblk, nb = item % nblk, k0 = 64 * kb, n0 = 64 * nb;
    const int nn = n0 + lane; const bool cv = nn < ncols; const float* src = W + (size_t)k0 * ldw + col0 + nn;
#pragma unroll 16
    for (int i = 0; i < 64; ++i) scr[i * 65 + lane] = cv ? src[(size_t)i * ldw] : 0.f;
    LDS_WAIT(); asm volatile("" ::: "memory");
    const int c = lane & 7;
#pragma unroll
    for (int j = 0; j < 8; ++j) { const int n = (lane >> 3) + 8 * j; const LAS float* sp = scr + (8 * c) * 65 + n;
        v4u o; o.x = pk2(sp[0 * 65], sp[1 * 65]); o.y = pk2(sp[2 * 65], sp[3 * 65]); o.z = pk2(sp[4 * 65], sp[5 * 65]); o.w = pk2(sp[6 * 65], sp[7 * 65]);
        if (n0 + n < ncols) *(GAS v4u*)(WT + (size_t)(row0 + n0 + n) * Kd + koff + k0 + 8 * c) = o; }
    LDS_WAIT(); asm volatile("" ::: "memory");
}
constexpr int NSEG = 25;
struct Seg { const float* W; int ldw, Ks, col0, ncols; bf16* WT; int Kd, row0, koff; };
__device__ __forceinline__ Seg get_seg(const Params& p, const Bufs& B, int s) {
    const int l = s / NSEG, k = s % NSEG; unsigned char* wl = wl_ptr(p, l); Seg g;
    switch (k) {
    case 0: g = Seg{kin()[4] + (size_t)l * D * INW, INW, D, 0, O_G, (bf16*)(wl + WO_WIN), D, 0, 0}; break;
    case 1: g = Seg{kin()[4] + (size_t)l * D * INW, INW, D, O_G, 3072, (bf16*)(wl + WO_WIN), D, PROJW, 0}; break;
    case 2: g = Seg{kin()[30] + (size_t)l * D * 2048, 2048, D, 0, 2048, (bf16*)(wl + WO_WQ), D, 0, 0}; break;
    case 3: g = Seg{kin()[27] + (size_t)l * D * D, D, D, 0, D, (bf16*)(wl + WO_WOUT), D, 0, 0}; break;
    case 4: g = Seg{kin()[24] + (size_t)l * S5W * D, D, S5W, 0, D, (bf16*)(wl + WO_BRA), YCW, 0, YC_A}; break;
    case 5: g = Seg{kin()[25] + (size_t)l * M2I * D, D, M2I, 0, D, (bf16*)(wl + WO_BRA), YCW, 0, YC_B}; break;
    case 6: g = Seg{kin()[26] + (size_t)l * 512 * D, D, 512, 0, D, (bf16*)(wl + WO_BRA), YCW, 0, YC_C}; break;
    case 7: g = Seg{kin()[13] + (size_t)l * S5W * S5W, S5W, S5W, 0, S5W, (bf16*)(wl + WO_GLU), S5W, 0, 0}; break;
    case 8: g = Seg{kin()[21] + (size_t)l * QR * 768, 768, QR, 0, 768, (bf16*)(wl + WO_UQ), QR, 0, 0}; break;
    default: { const int hh = (k - 9) >> 1, isv = (k - 9) & 1;
        g = Seg{kin()[23] + (size_t)l * KVR * 1024, 1024, KVR, hh * 128 + isv * 64, 64, (bf16*)(wl + (isv ? WO_VW : WO_KN)), 256, hh * 64, 0}; } break;
    }
    return g;
}
__device__ __forceinline__ void prologue_phase(const Params& p, const Bufs& B, LAS unsigned char* lds) {
    const int tid = otid(), lane = tid & 63, wave = tid >> 6;
    LAS float* scr = (LAS float*)(lds + wave * 16640);
    const int gw = blockIdx.x * NWAVES + wave, NGW = gridDim.x * NWAVES;
    {
        int total = 0;
        for (int sg = 0; sg < DEPTH * NSEG; ++sg) { const Seg g = get_seg(p, B, sg); total += ((g.ncols + 63) / 64) * (g.Ks / 64); }
        for (int it = gw; it < total; it += NGW) {
            int sg = 0, base = 0; Seg g = get_seg(p, B, 0); int n = ((g.ncols + 63) / 64) * (g.Ks / 64);
            while (it >= base + n) { base += n; ++sg; g = get_seg(p, B, sg); n = ((g.ncols + 63) / 64) * (g.Ks / 64); }
            tr_item(g.W, g.ldw, g.col0, g.ncols, g.WT, g.Kd, g.row0, g.koff, scr, it - base, lane);
        }
    }
    for (int l = 0; l < DEPTH; ++l) { unsigned char* wl = wl_ptr(p, l); const v4u z4 = {0u, 0u, 0u, 0u};
        v4u* a = (v4u*)(wl + WO_WIN + (size_t)O_G * D * 2); for (int i = gw * 64 + lane; i < (PROJW - O_G) * D * 2 / 16; i += NGW * 64) a[i] = z4;
        v4u* b = (v4u*)(wl + WO_GLU + (size_t)S5W * S5W * 2); for (int i = gw * 64 + lane; i < (512 - S5W) * S5W * 2 / 16; i += NGW * 64) b[i] = z4;
        for (int i = gw * 64 + lane; i < 2 * 512 * 16; i += NGW * 64) { const int m = i >> 13, r = (i >> 4) & 511, c = i & 15; *(v4u*)(wl + (m ? WO_VW : WO_KN) + (size_t)r * 512 + 256 + c * 16) = z4; } }
    for (int l = 0; l < DEPTH; ++l) { const float* sk = kin()[31] + (size_t)l * 2 * PK * 128; bf16* dk = (bf16*)(wl_ptr(p, l) + WO_SK);
        for (int i = gw * 64 + lane; i < 2 * PK * 128; i += NGW * 64) dk[i] = (bf16)f2bf(sk[i]); }
    const float* gg = kin()[2]; const float* bb = kin()[3];
    for (int r = gw; r < NB * SEQ; r += NGW) {
        const GAS f32x4* xr = (const GAS f32x4*)(kin()[0] + (size_t)r * D) + lane;
        f32x4 v[4]; float s = 0.f;
#pragma unroll
        for (int j = 0; j < 4; ++j) { v[j] = xr[64 * j]; s += (v[j].x + v[j].y) + (v[j].z + v[j].w); }
        const float mean = wsum(s) * (1.f / D); float s2 = 0.f;
#pragma unroll
        for (int j = 0; j < 4; ++j) { v[j] = v[j] - mean; s2 += (v[j].x * v[j].x + v[j].y * v[j].y) + (v[j].z * v[j].z + v[j].w * v[j].w); }
        const float rstd = __builtin_amdgcn_rsqf(wsum(s2) * (1.f / D) + 1e-5f);
        GAS unsigned long long* o8 = (GAS unsigned long long*)(B.HB() + (size_t)r * D) + lane;
#pragma unroll
        for (int j = 0; j < 4; ++j) { const f32x4 g4 = *(const f32x4*)(gg + 4 * lane + 256 * j), b4 = *(const f32x4*)(bb + 4 * lane + 256 * j);
            o8[64 * j] = (unsigned long long)pk2(v[j].x * rstd * g4.x + b4.x, v[j].y * rstd * g4.y + b4.y) | ((unsigned long long)pk2(v[j].z * rstd * g4.z + b4.z, v[j].w * rstd * g4.w + b4.w) << 32); }
    }
}
__device__ __forceinline__ void tables_phase(const Params& p, const Bufs& B) {
    const int lane = otid() & 63, w = otid() >> 6;
    for (int r = blockIdx.x * NWAVES + w; r < 2 * DEPTH * PE; r += gridDim.x * NWAVES) {
        const int isv = r >= DEPTH * PE, rr = isv ? r - DEPTH * PE : r;
        const f32x4* src = (const f32x4*)(kin()[isv ? 33 : 32] + (size_t)rr * D) + lane;
        f32x4 v[4]; float am = 0.f;
#pragma unroll
        for (int q = 0; q < 4; ++q) { v[q] = src[64 * q]; am = fmaxf(am, fmaxf(fmaxf(fabsf(v[q][0]), fabsf(v[q][1])), fmaxf(fabsf(v[q][2]), fabsf(v[q][3])))); }
#pragma unroll
        for (int o = 32; o > 0; o >>= 1) am = fmaxf(am, sx(am, o));
        const float sc = am > 0.f ? am * (1.f / 127.f) : 1.f, inv = 1.f / sc; const int off = isv ? 128 : 0;
        unsigned* dst = (unsigned*)((isv ? B.TABV() : B.TABU()) + (size_t)rr * D) + lane;
#pragma unroll
        for (int q = 0; q < 4; ++q) { unsigned wv = 0u;
#pragma unroll
            for (int e = 0; e < 4; ++e) wv |= ((unsigned)((int)rintf(v[q][e] * inv) + off) & 0xffu) << (8 * e);
            dst[64 * q] = wv; }
        if (lane == 0) (isv ? B.SV() : B.SU())[rr] = sc;
    }
}

enum { G_PROJ = 0, G_GLU, G_Q, G_KN, G_VT, G_M0, G_M1, G_M2, G_OUT, G_PQ };
template <int KIND> __device__ __forceinline__ void gemm_ph(const Params& p, const Bufs& B, int l, int pass, int cid, LAS unsigned char* lds) {
    unsigned char* wl = wl_ptr(p, l);
    PG8_LAS unsigned char* L = (PG8_LAS unsigned char*)lds;
    const bf16* hb = B.HB() + (size_t)pass * M * D;
    pg8::StaticOrder S;
    if constexpr (KIND == G_PROJ) { pg8::Gemm g{hb, (const bf16*)(wl + WO_WIN), M, WIN_N, D}; S.init(M, WIN_N, gridDim.x, cid); pg8::EpiProj E{B.PROJ(), B.GATES()};
        pg8::gemm_phase<pg8::EpiProj, pg8::StaticOrder, true, true>(L, g, S, E); }
    if constexpr (KIND == G_GLU) { pg8::Gemm g{B.Z(), (const bf16*)(wl + WO_GLU), M, 512, S5W}; S.init(M, 512, gridDim.x, cid); pg8::EpiGlu E{B.Z(), B.YA()};
        pg8::gemm_phase<pg8::EpiGlu, pg8::StaticOrder, true, true>(L, g, S, E); }
    if constexpr (KIND == G_Q) { pg8::Gemm g{B.CQN(), (const bf16*)(wl + WO_UQ), M, 768, QR}; S.init(M, 768, gridDim.x, cid); pg8::EpiBf16<0> E{B.Q(), 768, nullptr, 0, 0, 1.f};
        pg8::gemm_phase<pg8::EpiBf16<0>, pg8::StaticOrder, true, true>(L, g, S, E); }
    if constexpr (KIND == G_KN) { pg8::Gemm g{B.CKVN(), (const bf16*)(wl + WO_KN), M, 512, 256}; S.init(M, 512, gridDim.x, cid); pg8::EpiBf16<0> E{B.KN(), 512, nullptr, 0, 0, 1.f};
        pg8::gemm_phase<pg8::EpiBf16<0>, pg8::StaticOrder, true, true>(L, g, S, E); }
    if constexpr (KIND == G_VT) { pg8::Gemm g{(const bf16*)(wl + WO_VW), B.CKVN(), 512, M, 256}; S.init(512, M, gridDim.x, cid); pg8::EpiBf16<0> E{B.VT(), VT_P, nullptr, 0, 0, 1.f};
        pg8::gemm_phase<pg8::EpiBf16<0>, pg8::StaticOrder, true, true>(L, g, S, E); }
    if constexpr (KIND == G_M0) { pg8::Gemm g{B.YA(), (const bf16*)(wl + WO_BRA), M, D, YCW}; S.init(M, D, gridDim.x, cid); pg8::EpiMergeCat E{B.GATES(), B.MERGED()};
        pg8::gemm_phase<pg8::EpiMergeCat, pg8::StaticOrder, true, true>(L, g, S, E); }
    if constexpr (KIND == G_OUT) { pg8::Gemm g{B.MERGED(), (const bf16*)(wl + WO_WOUT), M, D, D}; S.init(M, D, gridDim.x, cid); pg8::EpiF32 E{B.F32(), D};
        pg8::gemm_phase<pg8::EpiF32, pg8::StaticOrder, true, true>(L, g, S, E); }
    if constexpr (KIND == G_PQ) { pg8::Gemm g{hb, (const bf16*)(wl + WO_WQ), M, 2048, D}; S.init(M, 2048, gridDim.x, cid); pg8::EpiBf16<0> E{B.PQ(), 2048, nullptr, 0, 0, 1.f};
        pg8::gemm_phase<pg8::EpiBf16<0>, pg8::StaticOrder, true, true>(L, g, S, E); }
}

typedef float f32x2 __attribute__((ext_vector_type(2)));
constexpr int S5_CH = 64, S5_NCH = SEQ / S5_CH, S5_BP = 132, S5_BT = 16 * S5_BP * 4, S5_XP = 136, S5_XT = 16 * S5_XP * 2, S5_LDS = NWAVES * (S5_BT + S5_XT);
struct S5Lane { float ar, ai; };
__device__ __forceinline__ void s5_coef(int l, int g, int pp, float dt, float& ar, float& ai, float& cr, float& ci) {
    const float lr = kin()[5][(l * S5G + g) * S5P + pp], li = kin()[6][(l * S5G + g) * S5P + pp];
    const float mag = fexp(lr * dt); float sn_, cs_; fsincos(li * dt, sn_, cs_); ar = mag * cs_; ai = mag * sn_;
    const float nr = ar - 1.f, ni = ai, den = lr * lr + li * li;
    cr = (nr * lr + ni * li) / den; ci = (ni * lr - nr * li) / den;
}
__device__ __forceinline__ S5Lane s5_setup(int l, int g, int lane, bf16x8 (&bf)[8]) {
    const int fr = lane & 15, fq = lane >> 4; const float dt = fexp(kin()[7][l * S5G + g]);
#pragma unroll
    for (int nt = 0; nt < 4; ++nt) { const int pp = fr + 16 * nt; float ar, ai, cr, ci; s5_coef(l, g, pp, dt, ar, ai, cr, ci);
        v4u re = {0u, 0u, 0u, 0u}, im = {0u, 0u, 0u, 0u};
        if (fq < 2) { const f32x4* br4 = (const f32x4*)(kin()[8] + ((size_t)(l * S5G + g) * S5P + pp) * 16 + 8 * fq); const f32x4* bi4 = (const f32x4*)(kin()[9] + ((size_t)(l * S5G + g) * S5P + pp) * 16 + 8 * fq);
            const f32x4 b0 = br4[0], b1 = br4[1], c0 = bi4[0], c1 = bi4[1];
            re = (v4u){pk2(cr * b0[0] - ci * c0[0], cr * b0[1] - ci * c0[1]), pk2(cr * b0[2] - ci * c0[2], cr * b0[3] - ci * c0[3]), pk2(cr * b1[0] - ci * c1[0], cr * b1[1] - ci * c1[1]), pk2(cr * b1[2] - ci * c1[2], cr * b1[3] - ci * c1[3])};
            im = (v4u){pk2(cr * c0[0] + ci * b0[0], cr * c0[1] + ci * b0[1]), pk2(cr * c0[2] + ci * b0[2], cr * c0[3] + ci * b0[3]), pk2(cr * c1[0] + ci * b1[0], cr * c1[1] + ci * b1[1]), pk2(cr * c1[2] + ci * b1[2], cr * c1[3] + ci * b1[3])}; }
        bf[nt] = __builtin_bit_cast(bf16x8, re); bf[4 + nt] = __builtin_bit_cast(bf16x8, im); }
    S5Lane L; float cr, ci; s5_coef(l, g, lane, dt, L.ar, L.ai, cr, ci); return L;
}
__device__ __forceinline__ void s5_tables_phase(const Params& p) {
    const int lane = otid() & 63, w = otid() >> 6, fr = lane & 15, fq = lane >> 4;
    for (int lg = blockIdx.x * NWAVES + w; lg < DEPTH * S5G; lg += gridDim.x * NWAVES) {
        const int l = lg / S5G, g = lg % S5G; unsigned char* wl = wl_ptr(p, l);
        bf16x8 bf[8]; const S5Lane L = s5_setup(l, g, lane, bf);
        v4u* dbf = (v4u*)(wl + WO_S5BF) + ((size_t)g * 64 + lane) * 8;
#pragma unroll
        for (int nt = 0; nt < 8; ++nt) dbf[nt] = __builtin_bit_cast(v4u, bf[nt]);
        v4u* dcf = (v4u*)(wl + WO_S5CF) + ((size_t)g * 64 + lane) * 4;
#pragma unroll
        for (int ks = 0; ks < 4; ++ks) { const float* src = (ks < 2 ? kin()[10] : kin()[11]) + ((size_t)(l * S5G + g) * 16 + fr) * S5P + 32 * (ks & 1) + 8 * fq; const float sg = ks < 2 ? 1.f : -1.f;
            const f32x4 a = *(const f32x4*)src, b = *(const f32x4*)(src + 4);
            dcf[ks] = (v4u){pk2(sg * a[0], sg * a[1]), pk2(sg * a[2], sg * a[3]), pk2(sg * b[0], sg * b[1]), pk2(sg * b[2], sg * b[3])}; }
    }
}
__device__ __forceinline__ S5Lane s5_fetch(const Params& p, int l, int g, int lane, bf16x8 (&bf)[8]) {
    const unsigned char* wl = wl_ptr(p, l); const v4u* sbf = (const v4u*)(wl + WO_S5BF) + ((size_t)g * 64 + lane) * 8;
#pragma unroll
    for (int nt = 0; nt < 8; ++nt) bf[nt] = __builtin_bit_cast(bf16x8, sbf[nt]);
    const float dt = fexp(kin()[7][l * S5G + g]); S5Lane L; float cr, ci; s5_coef(l, g, lane, dt, L.ar, L.ai, cr, ci); return L;
}
__device__ __forceinline__ void s5_bu_block(v4u uv, int lane, const bf16x8 (&bf)[8], LAS unsigned char* but) {
    const int fr = lane & 15, fq = lane >> 4;
    const bf16x8 af = __builtin_bit_cast(bf16x8, uv);
    float one = 1.f; asm volatile("" : "+v"(one));
#pragma unroll
    for (int nt = 0; nt < 8; ++nt) { f32x4 acc = {0.f, 0.f, 0.f, 0.f}; acc = __builtin_amdgcn_mfma_f32_16x16x32_bf16(af, bf[nt], acc, 0, 0, 0);
#pragma unroll
        for (int j = 0; j < 4; ++j) *(LAS float*)(but + ((4 * fq + j) * S5_BP + 16 * nt + fr) * 4) = acc[j] * one; }
    asm volatile("" :: "v"(af), "v"(bf[0]), "v"(bf[1]), "v"(bf[2]), "v"(bf[3]), "v"(bf[4]), "v"(bf[5]), "v"(bf[6]), "v"(bf[7]));
    LDS_WAIT(); asm volatile("" ::: "memory");
}
__device__ __forceinline__ void s5a_phase(const Params& p, const Bufs& B, int l, LAS unsigned char* lds) {
    const int tid = otid(), lane = tid & 63, w = tid >> 6;
    LAS unsigned char* but = lds + w * S5_BT;
    for (int task = blockIdx.x; task < NBP * S5_NCH; task += gridDim.x) {
        const int sq = task / S5_NCH, c = task % S5_NCH, row0 = sq * SEQ + c * S5_CH;
        for (int gi = 0; gi < 3; ++gi) { const int g = 3 * w + gi; bf16x8 bf[8]; const S5Lane L = s5_fetch(p, l, g, lane, bf);
            float xr = 0.f, xi = 0.f;
            v4u uvb[4];
#pragma unroll
            for (int bq = 0; bq < 4; ++bq) { uvb[bq] = (v4u){0u, 0u, 0u, 0u}; if ((lane >> 4) < 2) uvb[bq] = *(const v4u*)(B.PROJ() + (size_t)(row0 + 16 * bq + (lane & 15)) * PROJW + O_U + g * 16 + 8 * (lane >> 4)); }
#pragma unroll
            for (int bq = 0; bq < 4; ++bq) { const int tb = 16 * bq;
                s5_bu_block(uvb[bq], lane, bf, but);
#pragma unroll
                for (int tt = 0; tt < 16; ++tt) { const float bur = *(const LAS float*)(but + (tt * S5_BP + lane) * 4), bui = *(const LAS float*)(but + (tt * S5_BP + 64 + lane) * 4);
                    const float nxr = L.ar * xr - L.ai * xi + bur, nxi = L.ar * xi + L.ai * xr + bui; xr = nxr; xi = nxi; }
                LDS_WAIT(); asm volatile("" ::: "memory");
            }
            *(f32x2*)(B.ES() + ((((size_t)sq * S5_NCH + c) * S5G + g) * S5P + lane) * 2) = (f32x2){xr, xi};
        }
    }
    __syncthreads();
}
__device__ __forceinline__ void s5scan_phase(const Params& p, const Bufs& B, int l, int gtid, int gthreads) {
    const int nwg_ = gthreads / NTHR, wg_ = gtid / NTHR, th_ = gtid % NTHR;
    for (int ch = wg_ + nwg_ * th_; ch < NBP * S5G * S5P && th_ < (NBP * S5G * S5P + nwg_ - 1) / nwg_; ch += nwg_ * NTHR) {
        const int sq = ch / (S5G * S5P), rem = ch % (S5G * S5P), g = rem >> 6, pl = rem & 63;
        const float lr = kin()[5][(l * S5G + g) * S5P + pl], li = kin()[6][(l * S5G + g) * S5P + pl], dt = fexp(kin()[7][l * S5G + g]);
        float sn_, cs_; fsincos(li * dt * (float)S5_CH, sn_, cs_); const float mg = fexp(lr * dt * (float)S5_CH), Ar = mg * cs_, Ai = mg * sn_;
        f32x2* E = (f32x2*)B.ES() + (size_t)sq * S5_NCH * S5G * S5P + rem; const size_t cs = (size_t)S5G * S5P;
        float cr = 0.f, ci = 0.f; asm volatile("" : "+v"(cr), "+v"(ci));
        for (int c0 = 0; c0 < S5_NCH; c0 += 16) { f32x2 e[16];
#pragma unroll
            for (int k = 0; k < 16; ++k) e[k] = E[(size_t)(c0 + k) * cs];
#pragma unroll
            for (int k = 0; k < 16; ++k) { E[(size_t)(c0 + k) * cs] = (f32x2){cr, ci}; const float nr = Ar * cr - Ai * ci + e[k].x, ni = Ar * ci + Ai * cr + e[k].y; cr = nr; ci = ni; } }
    }
}
__device__ __forceinline__ void s5b_phase(const Params& p, const Bufs& B, int l, LAS unsigned char* lds) {
    const int tid = otid(), lane = tid & 63, w = tid >> 6, fr = lane & 15, fq = lane >> 4;
    LAS unsigned char* but = lds + w * S5_BT; LAS unsigned char* xt = lds + NWAVES * S5_BT + w * S5_XT;
    for (int task = blockIdx.x; task < NBP * S5_NCH; task += gridDim.x) {
        const int sq = task / S5_NCH, c = task % S5_NCH, row0 = sq * SEQ + c * S5_CH;
        for (int gi = 0; gi < 3; ++gi) { const int g = 3 * w + gi; bf16x8 bf[8]; const S5Lane L = s5_fetch(p, l, g, lane, bf);
            bf16x8 cf[4];
            { const v4u* scf = (const v4u*)(wl_ptr(p, l) + WO_S5CF) + ((size_t)g * 64 + lane) * 4;
#pragma unroll
              for (int ks = 0; ks < 4; ++ks) cf[ks] = __builtin_bit_cast(bf16x8, scf[ks]); }
            const float dsk = kin()[12][l * S5W + g * 16 + fr];
            const f32x2 cin = *(const f32x2*)(B.ES() + ((((size_t)sq * S5_NCH + c) * S5G + g) * S5P + lane) * 2);
            float xr = cin.x, xi = cin.y;
            v4u uvb[4];
#pragma unroll
            for (int bq = 0; bq < 4; ++bq) { uvb[bq] = (v4u){0u, 0u, 0u, 0u}; if (fq < 2) uvb[bq] = *(const v4u*)(B.PROJ() + (size_t)(row0 + 16 * bq + fr) * PROJW + O_U + g * 16 + 8 * fq); }
#pragma unroll
            for (int bq = 0; bq < 4; ++bq) { const int tb = 16 * bq;
                s5_bu_block(uvb[bq], lane, bf, but);
#pragma unroll
                for (int tt = 0; tt < 16; ++tt) { const float bur = *(const LAS float*)(but + (tt * S5_BP + lane) * 4), bui = *(const LAS float*)(but + (tt * S5_BP + 64 + lane) * 4);
                    const float nxr = L.ar * xr - L.ai * xi + bur, nxi = L.ar * xi + L.ai * xr + bui; xr = nxr; xi = nxi;
                    *(LAS unsigned short*)(xt + (tt * S5_XP + lane) * 2) = (unsigned short)f2bf(xr); *(LAS unsigned short*)(xt + (tt * S5_XP + 64 + lane) * 2) = (unsigned short)f2bf(xi); }
                LDS_WAIT(); asm volatile("" ::: "memory");
                f32x4 acc = zero4();
#pragma unroll
                for (int ks = 0; ks < 4; ++ks) { const bf16x8 a = *(const LAS bf16x8*)(xt + (fr * S5_XP + 32 * ks + 8 * fq) * 2); acc = __builtin_amdgcn_mfma_f32_16x16x32_bf16(a, cf[ks], acc, 0, 0, 0); asm volatile("" :: "v"(a), "v"(cf[ks])); }
                LDS_WAIT(); asm volatile("" ::: "memory");
#pragma unroll
                for (int j = 0; j < 4; ++j) { const size_t row = (size_t)(row0 + tb + 4 * fq + j); const float u = bf2f(B.PROJ()[row * PROJW + O_U + g * 16 + fr]);
                    B.Z()[row * S5W + g * 16 + fr] = (bf16)f2bf(gelu_t(acc[j] + dsk * u)); }
            }
        }
    }
    __syncthreads();
}

constexpr int SC = 128, NCK = M / SC;
constexpr int XC_RP = 136, XC_RAW = 131 * XC_RP * 2, XC_T = 128 * XC_RP * 2, XC_LDS = XC_RAW + XC_T;
__device__ __forceinline__ void xc_phase(const Params& p, const Bufs& B, int l, LAS unsigned char* lds) {
    const int tid = otid(), lane = tid & 63, w = tid >> 6;
    const float* cw = kin()[14] + (size_t)l * 4 * M2C; const float* cb_ = kin()[15] + l * M2C;
    LAS unsigned char* raw = lds; LAS unsigned char* T = lds + XC_RAW;
    for (int task = blockIdx.x; task < NCK * 8; task += gridDim.x) {
        const int ck = task >> 3, cb = task & 7, c = ck & 63, row0 = ck * SC, ch0 = cb * 128;
        for (int i = tid; i < 131 * 16; i += NTHR) { const int r = i >> 4, q = i & 15;
            v4u v = {0u, 0u, 0u, 0u}; if (!(c == 0 && r < 3)) v = *(const v4u*)(B.PROJ() + (size_t)(row0 - 3 + r) * PROJW + O_XBC + ch0 + q * 8);
            *(LAS v4u*)(raw + (r * XC_RP + q * 8) * 2) = v; }
        __syncthreads();
        const int cp = tid & 63, lq = tid >> 6; const int chA = ch0 + 2 * cp;
        float wk[4][2]; for (int k = 0; k < 4; ++k) { wk[k][0] = cw[k * M2C + chA]; wk[k][1] = cw[k * M2C + chA + 1]; }
        const float b0 = cb_[chA], b1 = cb_[chA + 1];
        const bool nat = cb >= 4, tr = cb < 6;
        bf16* dnat = cb >= 6 ? B.CN() + ((size_t)(ck * 2 + (cb - 6)) * SC) * 128 : B.BN() + ((size_t)(ck * 2 + (cb - 4)) * SC) * 128;
        for (int i = 0; i < 16; ++i) { const int ll = lq * 16 + i; float s0 = b0, s1 = b1;
#pragma unroll
            for (int k = 0; k < 4; ++k) { const unsigned x = *(const LAS unsigned*)(raw + ((ll + k) * XC_RP + 2 * cp) * 2); s0 = fmaf(wk[k][0], bflo(x), s0); s1 = fmaf(wk[k][1], bfhi(x), s1); }
            const float y0 = s0 * sigm_f(s0), y1 = s1 * sigm_f(s1);
            if (nat) *(unsigned*)(dnat + (size_t)ll * 128 + 2 * cp) = pk2(y0, y1);
            if (tr) { *(LAS unsigned short*)(T + ((2 * cp) * XC_RP + ll) * 2) = (unsigned short)f2bf(y0); *(LAS unsigned short*)(T + ((2 * cp + 1) * XC_RP + ll) * 2) = (unsigned short)f2bf(y1); } }
        __syncthreads();
        if (tr) { bf16* dT = cb < 4 ? B.XT() + ((size_t)(ck * 8 + 2 * cb) * 64) * SC : B.BT() + ((size_t)(ck * 2 + (cb - 4)) * 128) * SC;
            for (int i = tid; i < 128 * 16; i += NTHR) { const int cr = i >> 4, q = i & 15; *(v4u*)(dT + (size_t)cr * SC + q * 8) = *(const LAS v4u*)(T + (cr * XC_RP + q * 8) * 2); } }
        __syncthreads();
    }
    for (int ck = blockIdx.x * NWAVES + w; ck < NCK; ck += gridDim.x * NWAVES) {
        const size_t r0 = (size_t)ck * SC + lane, r1 = r0 + 64;
        const v4u d0 = *(const v4u*)(B.PROJ() + r0 * PROJW + O_DT), d1 = *(const v4u*)(B.PROJ() + r1 * PROJW + O_DT);
        float dtA[8], dtB[8];
        dtA[0] = bflo(d0.x); dtA[1] = bfhi(d0.x); dtA[2] = bflo(d0.y); dtA[3] = bfhi(d0.y); dtA[4] = bflo(d0.z); dtA[5] = bfhi(d0.z); dtA[6] = bflo(d0.w); dtA[7] = bfhi(d0.w);
        dtB[0] = bflo(d1.x); dtB[1] = bfhi(d1.x); dtB[2] = bflo(d1.y); dtB[3] = bfhi(d1.y); dtB[4] = bflo(d1.z); dtB[5] = bfhi(d1.z); dtB[6] = bflo(d1.w); dtB[7] = bfhi(d1.w);
#pragma unroll
        for (int h = 0; h < 8; ++h) {
            const float A = -fexp(kin()[17][l * M2H + h]), db = kin()[16][l * M2H + h];
            float ra = dtA[h] + db, rb = dtB[h] + db; ra = ra > 20.f ? ra : flog(1.f + fexp(ra)); rb = rb > 20.f ? rb : flog(1.f + fexp(rb));
            float ca = A * ra, cbv = A * rb;
#pragma unroll
            for (int o = 1; o < 64; o <<= 1) { const float ta = sup(ca, o), tb = sup(cbv, o); if (lane >= o) { ca += ta; cbv += tb; } }
            const float tot0 = sl(ca, 63); cbv += tot0; const float aend = sl(cbv, 63);
            B.SDT()[r0 * 8 + h] = ra; B.SDT()[r1 * 8 + h] = rb; B.SAC()[r0 * 8 + h] = ca; B.SAC()[r1 * 8 + h] = cbv;
            B.SW()[((size_t)ck * 8 + h) * SC + lane] = fexp(aend - ca) * ra; B.SW()[((size_t)ck * 8 + h) * SC + 64 + lane] = fexp(aend - cbv) * rb;
            if (lane == 0) B.CDEC()[ck * 8 + h] = fexp(aend);
        }
    }
}
__device__ __forceinline__ void ssd1_phase(const Bufs& B) {
    const int tid = otid(), lane = tid & 63, w = tid >> 6, fr = lane & 15, fq = lane >> 4, hh = w >> 1, ph = w & 1;
    for (int task = blockIdx.x; task < NCK * 2; task += gridDim.x) {
        const int ck = task >> 1, gr = task & 1, h = 4 * gr + hh;
        const bf16* xt = B.XT() + ((size_t)(ck * 8 + h) * 64 + 32 * ph + fr) * SC + 8 * fq;
        const float* sw = B.SW() + ((size_t)ck * 8 + h) * SC + 8 * fq;
        const bf16* bt = B.BT() + ((size_t)(ck * 2 + gr) * 128 + fr) * SC + 8 * fq;
        f32x4 acc[2][8];
#pragma unroll
        for (int mt = 0; mt < 2; ++mt)
#pragma unroll
            for (int nt = 0; nt < 8; ++nt) acc[mt][nt] = zero4();
#pragma unroll 2
        for (int ks = 0; ks < 4; ++ks) {
            const f32x4 wa = *(const f32x4*)(sw + 32 * ks), wb = *(const f32x4*)(sw + 32 * ks + 4);
            bf16x8 af[2];
#pragma unroll
            for (int mt = 0; mt < 2; ++mt) { const v4u xv = *(const v4u*)(xt + (size_t)(16 * mt) * SC + 32 * ks);
                af[mt] = __builtin_bit_cast(bf16x8, (v4u){pk2(bflo(xv.x) * wa[0], bfhi(xv.x) * wa[1]), pk2(bflo(xv.y) * wa[2], bfhi(xv.y) * wa[3]), pk2(bflo(xv.z) * wb[0], bfhi(xv.z) * wb[1]), pk2(bflo(xv.w) * wb[2], bfhi(xv.w) * wb[3])}); }
            bf16x8 bfg[8];
#pragma unroll
            for (int nt = 0; nt < 8; ++nt) bfg[nt] = *(const bf16x8*)(bt + (size_t)(16 * nt) * SC + 32 * ks);
#pragma unroll
            for (int mt = 0; mt < 2; ++mt)
#pragma unroll
                for (int nt = 0; nt < 8; ++nt) acc[mt][nt] = __builtin_amdgcn_mfma_f32_16x16x32_bf16(af[mt], bfg[nt], acc[mt][nt], 0, 0, 0);
            asm volatile("" :: "v"(af[0]), "v"(af[1]), "v"(bfg[0]), "v"(bfg[1]), "v"(bfg[2]), "v"(bfg[3]), "v"(bfg[4]), "v"(bfg[5]), "v"(bfg[6]), "v"(bfg[7]));
        }
        float* st = B.ST() + ((size_t)(ck * 8 + h) * 64 + 32 * ph + 4 * fq) * 128 + fr;
#pragma unroll
        for (int mt = 0; mt < 2; ++mt)
#pragma unroll
            for (int nt = 0; nt < 8; ++nt)
#pragma unroll
                for (int j = 0; j < 4; ++j) st[(size_t)(16 * mt + j) * 128 + 16 * nt] = acc[mt][nt][j];
    }
}
__device__ __forceinline__ void ssd2_phase(const Bufs& B, int gtid, int gthreads) {
    for (int e = gtid; e < NBP * 8 * 64 * 128; e += gthreads) {
        const int sq = e >> 16, rem = e & 65535, h = rem >> 13;
        const float* st = B.ST() + (size_t)sq * 64 * 65536 + rem; bf16* pv = B.PREV() + (size_t)sq * 64 * 65536 + rem; const float* cd = B.CDEC() + (size_t)sq * 64 * 8 + h;
        float carry = 0.f;
        for (int c0 = 0; c0 < 64; c0 += 8) { float v[8], d[8];
#pragma unroll
            for (int k = 0; k < 8; ++k) { v[k] = st[(size_t)(c0 + k) * 65536]; d[k] = cd[(c0 + k) * 8]; }
#pragma unroll
            for (int k = 0; k < 8; ++k) { pv[(size_t)(c0 + k) * 65536] = (bf16)f2bf(carry); carry = carry * d[k] + v[k]; } }
    }
}
constexpr int S3_CBP = 136, S3_CB = 128 * S3_CBP * 2, S3_AD = 4 * 128 * 2 * 4, S3_SS = 128 * 4 * 4, S3_LDS = S3_CB + S3_AD + S3_SS;
__device__ __forceinline__ void ssd3_phase(const Params& p, const Bufs& B, int l, LAS unsigned char* lds) {
    const int tid = otid(), lane = tid & 63, w = tid >> 6, fr = lane & 15, fq = lane >> 4, hh = w >> 1, lh = w & 1;
    LAS unsigned char* cbl = lds; LAS float* ad = (LAS float*)(lds + S3_CB); LAS float* ss = (LAS float*)(lds + S3_CB + S3_AD);
    for (int task = blockIdx.x; task < NCK * 2; task += gridDim.x) {
        const int ck = task >> 1, gr = task & 1, h = 4 * gr + hh; const size_t row0 = (size_t)ck * SC;
        const bf16* cn = B.CN() + (size_t)(ck * 2 + gr) * SC * 128; const bf16* bn = B.BN() + (size_t)(ck * 2 + gr) * SC * 128;
        for (int i = tid; i < 4 * 128; i += NTHR) { const int h4 = i >> 7, ll = i & 127; ad[i * 2] = B.SAC()[(row0 + ll) * 8 + 4 * gr + h4]; ad[i * 2 + 1] = B.SDT()[(row0 + ll) * 8 + 4 * gr + h4]; }
        {
            bf16x8 af[4];
#pragma unroll
            for (int ks = 0; ks < 4; ++ks) af[ks] = *(const bf16x8*)(cn + (size_t)(16 * w + fr) * 128 + 32 * ks + 8 * fq);
#pragma unroll
            for (int nt = 0; nt < 8; ++nt) { f32x4 acc = zero4();
#pragma unroll
                for (int ks = 0; ks < 4; ++ks) { const bf16x8 bfg = *(const bf16x8*)(bn + (size_t)(16 * nt + fr) * 128 + 32 * ks + 8 * fq); acc = __builtin_amdgcn_mfma_f32_16x16x32_bf16(af[ks], bfg, acc, 0, 0, 0); asm volatile("" :: "v"(af[ks]), "v"(bfg)); }
#pragma unroll
                for (int j = 0; j < 4; ++j) *(LAS unsigned short*)(cbl + ((16 * w + 4 * fq + j) * S3_CBP + 16 * nt + fr) * 2) = (unsigned short)f2bf(acc[j]); }
        }
        __syncthreads();
#pragma unroll 1
        for (int hq = 0; hq < 2; ++hq) {
        f32x4 acc[2][4];
#pragma unroll
        for (int mt = 0; mt < 2; ++mt)
#pragma unroll
            for (int nt = 0; nt < 4; ++nt) acc[mt][nt] = zero4();
        const int l0 = 64 * lh + 32 * hq;
        { const bf16* pv = B.PREV() + (size_t)(ck * 8 + h) * 64 * 128;
#pragma unroll
          for (int ks = 0; ks < 4; ++ks) { bf16x8 bfg[4], af[2];
#pragma unroll
            for (int nt = 0; nt < 4; ++nt) bfg[nt] = *(const bf16x8*)(pv + (size_t)(16 * nt + fr) * 128 + 32 * ks + 8 * fq);
#pragma unroll
            for (int mt = 0; mt < 2; ++mt) af[mt] = *(const bf16x8*)(cn + (size_t)(l0 + 16 * mt + fr) * 128 + 32 * ks + 8 * fq);
#pragma unroll
            for (int mt = 0; mt < 2; ++mt)
#pragma unroll
                for (int nt = 0; nt < 4; ++nt) acc[mt][nt] = __builtin_amdgcn_mfma_f32_16x16x32_bf16(af[mt], bfg[nt], acc[mt][nt], 0, 0, 0);
            asm volatile("" :: "v"(af[0]), "v"(af[1]), "v"(bfg[0]), "v"(bfg[1]), "v"(bfg[2]), "v"(bfg[3])); } }
#pragma unroll
        for (int mt = 0; mt < 2; ++mt)
#pragma unroll
            for (int j = 0; j < 4; ++j) { const float ea = __expf(ad[(hh * 128 + l0 + 16 * mt + 4 * fq + j) * 2]);
#pragma unroll
                for (int nt = 0; nt < 4; ++nt) acc[mt][nt][j] *= ea; }
        { const bf16* xt = B.XT() + (size_t)(ck * 8 + h) * 64 * SC; const float Dh = kin()[18][l * M2H + h];
#pragma unroll
          for (int ks = 0; ks < 4; ++ks) {
            if (32 * ks <= l0 + 31) {
                bf16x8 bfg[4];
#pragma unroll
                for (int nt = 0; nt < 4; ++nt) bfg[nt] = *(const bf16x8*)(xt + (size_t)(16 * nt + fr) * SC + 32 * ks + 8 * fq);
                float as_[8], ds_[8];
#pragma unroll
                for (int j = 0; j < 8; ++j) { as_[j] = ad[(hh * 128 + 32 * ks + 8 * fq + j) * 2]; ds_[j] = ad[(hh * 128 + 32 * ks + 8 * fq + j) * 2 + 1]; }
#pragma unroll
                for (int mt = 0; mt < 2; ++mt) { const int lrow = l0 + 16 * mt + fr;
                    if (32 * ks <= l0 + 16 * mt + 15) {
                        const float al = ad[(hh * 128 + lrow) * 2];
                        const v4u cv = *(const LAS v4u*)(cbl + (lrow * S3_CBP + 32 * ks + 8 * fq) * 2);
                        float cf[8] = {bflo(cv.x), bfhi(cv.x), bflo(cv.y), bfhi(cv.y), bflo(cv.z), bfhi(cv.z), bflo(cv.w), bfhi(cv.w)};
#pragma unroll
                        for (int j = 0; j < 8; ++j) { const int sidx = 32 * ks + 8 * fq + j; float v = cf[j] * __expf(fminf(al - as_[j], 0.f)) * ds_[j]; v = sidx <= lrow ? v : 0.f; cf[j] = v + (sidx == lrow ? Dh : 0.f); }
                        const bf16x8 af = __builtin_bit_cast(bf16x8, (v4u){pk2(cf[0], cf[1]), pk2(cf[2], cf[3]), pk2(cf[4], cf[5]), pk2(cf[6], cf[7])});
#pragma unroll
                        for (int nt = 0; nt < 4; ++nt) acc[mt][nt] = __builtin_amdgcn_mfma_f32_16x16x32_bf16(af, bfg[nt], acc[mt][nt], 0, 0, 0);
                        asm volatile("" :: "v"(af), "v"(bfg[0]), "v"(bfg[1]), "v"(bfg[2]), "v"(bfg[3]));
                    } }
            } } }
        const float* nw = kin()[19] + l * M2I + gr * 256 + hh * 64;
#pragma unroll
        for (int mt = 0; mt < 2; ++mt)
#pragma unroll
            for (int j = 0; j < 4; ++j) { const int lrow = l0 + 16 * mt + 4 * fq + j; const bf16* zr = B.PROJ() + (row0 + lrow) * PROJW + O_Z + gr * 256 + hh * 64; float q = 0.f;
#pragma unroll
                for (int nt = 0; nt < 4; ++nt) { const float zz = bf2f(zr[16 * nt + fr]); const float v = acc[mt][nt][j] * zz * sigm_f(zz); acc[mt][nt][j] = v; q += v * v; }
                q += sx(q, 1); q += sx(q, 2); q += sx(q, 4); q += sx(q, 8);
                if (fr == 0) ss[lrow * 4 + hh] = q; asm volatile("" ::: "memory"); }
        __syncthreads();
#pragma unroll
        for (int mt = 0; mt < 2; ++mt)
#pragma unroll
            for (int j = 0; j < 4; ++j) { const int lrow = l0 + 16 * mt + 4 * fq + j; const f32x4 s4 = *(const LAS f32x4*)(ss + lrow * 4);
                const float rs = __builtin_amdgcn_rsqf((s4[0] + s4[1] + s4[2] + s4[3]) * (1.f / 256.f) + 1e-6f); bf16* yr = B.YA() + (row0 + lrow) * YCW + YC_B + gr * 256 + hh * 64;
#pragma unroll
                for (int nt = 0; nt < 4; ++nt) yr[16 * nt + fr] = (bf16)f2bf(acc[mt][nt][j] * rs * nw[16 * nt + fr]); }
        }
        __syncthreads();
    }
}

constexpr int AT_KP = 104, AT_VP = 68, AT_KB = 64 * AT_KP * 2, AT_VB = 64 * AT_VP * 2, AT_LDS = 2 * AT_KB + 2 * AT_VB;
__device__ __forceinline__ int crow16(int r, int hi) { return (r & 3) + 8 * (r >> 2) + 4 * hi; }
constexpr float AT_THR = 8.f;
__device__ __forceinline__ void attn_tile(const LAS unsigned char* kb, const LAS unsigned char* vb, const bf16x8 (&qr)[6], f32x16& o0, f32x16& o1, float& mref, float& lrun,
                                          int k0, int qrow, int qmin, int q31, int hi, bool first) {
    const float nm = -mref;
    f32x16 s0 = {nm, nm, nm, nm, nm, nm, nm, nm, nm, nm, nm, nm, nm, nm, nm, nm}, s1 = s0;
#pragma unroll
    for (int ks = 0; ks < 6; ++ks) {
        const bf16x8 a0 = *(const LAS bf16x8*)(kb + q31 * (AT_KP * 2) + ks * 32 + hi * 16);
        const bf16x8 a1 = *(const LAS bf16x8*)(kb + (32 + q31) * (AT_KP * 2) + ks * 32 + hi * 16);
        s0 = __builtin_amdgcn_mfma_f32_32x32x16_bf16(a0, qr[ks], s0, 0, 0, 0);
        s1 = __builtin_amdgcn_mfma_f32_32x32x16_bf16(a1, qr[ks], s1, 0, 0, 0);
    }
    v2u vf[4][4];
#pragma unroll
    for (int st = 0; st < 4; ++st) { const LAS unsigned char* v0p = vb + q31 * (AT_VP * 2) + (16 * st + 4 * hi) * 2;
        vf[st][0] = *(const LAS v2u*)(v0p); vf[st][1] = *(const LAS v2u*)(v0p + 16); vf[st][2] = *(const LAS v2u*)(v0p + 32 * (AT_VP * 2)); vf[st][3] = *(const LAS v2u*)(v0p + 32 * (AT_VP * 2) + 16); }
    if (k0 + 63 > qmin) {
#pragma unroll
        for (int r = 0; r < 16; ++r) { const int kv = k0 + crow16(r, hi); if (kv > qrow) s0[r] = -INFINITY; if (kv + 32 > qrow) s1[r] = -INFINITY; }
    }
    float mx = fmaxf(s0[0], s1[0]);
#pragma unroll
    for (int r = 1; r < 16; ++r) mx = fmaxf(mx, fmaxf(s0[r], s1[r]));
    { const auto rr = __builtin_amdgcn_permlane32_swap(__builtin_bit_cast(unsigned, mx), __builtin_bit_cast(unsigned, mx), false, false); mx = fmaxf(__builtin_bit_cast(float, rr[0]), __builtin_bit_cast(float, rr[1])); }
    if (first || __any(mx > AT_THR)) {
        const float dl = first ? mx : fmaxf(mx, 0.f), f = __builtin_amdgcn_exp2f(-dl); mref += dl; lrun *= f;
#pragma unroll
        for (int r = 0; r < 16; ++r) { s0[r] -= dl; s1[r] -= dl; o0[r] *= f; o1[r] *= f; }
    }
    float ps = 0.f;
#pragma unroll
    for (int r = 0; r < 16; ++r) { s0[r] = __builtin_amdgcn_exp2f(s0[r]); s1[r] = __builtin_amdgcn_exp2f(s1[r]); ps += s0[r] + s1[r]; }
    lrun += ps;
#pragma unroll
    for (int st = 0; st < 4; ++st) {
        v4u pw;
        if (st == 0) pw = (v4u){pk2(s0[0], s0[1]), pk2(s0[2], s0[3]), pk2(s0[4], s0[5]), pk2(s0[6], s0[7])};
        if (st == 1) pw = (v4u){pk2(s0[8], s0[9]), pk2(s0[10], s0[11]), pk2(s0[12], s0[13]), pk2(s0[14], s0[15])};
        if (st == 2) pw = (v4u){pk2(s1[0], s1[1]), pk2(s1[2], s1[3]), pk2(s1[4], s1[5]), pk2(s1[6], s1[7])};
        if (st == 3) pw = (v4u){pk2(s1[8], s1[9]), pk2(s1[10], s1[11]), pk2(s1[12], s1[13]), pk2(s1[14], s1[15])};
        const bf16x8 pb = __builtin_bit_cast(bf16x8, pw);
        o0 = __builtin_amdgcn_mfma_f32_32x32x16_bf16(__builtin_bit_cast(bf16x8, (v4u){vf[st][0].x, vf[st][0].y, vf[st][1].x, vf[st][1].y}), pb, o0, 0, 0, 0);
        o1 = __builtin_amdgcn_mfma_f32_32x32x16_bf16(__builtin_bit_cast(bf16x8, (v4u){vf[st][2].x, vf[st][2].y, vf[st][3].x, vf[st][3].y}), pb, o1, 0, 0, 0);
    }
}
__device__ __forceinline__ void attn_unit(const Bufs& B, const int* pos, int b, int h, int qb, LAS unsigned char* lds) {
    const int tid = otid(), lane = tid & 63, w = tid >> 6, q31 = lane & 31, hi = lane >> 5;
    const size_t rb = (size_t)b * SEQ; const int q0 = qb * 256, qmin = q0 + 32 * w, qrow = qmin + q31;
    bf16x8 qr[6];
    {
        v4u qv[6];
#pragma unroll
        for (int ks = 0; ks < 6; ++ks) qv[ks] = *(const v4u*)(B.Q() + (rb + qrow) * 768 + h * 96 + 16 * ks + 8 * hi);
        const float sc = 0.10206207261596577f * 1.4426950408889634f; const float posf = (float)pos[rb + qrow];
        float x1[8], x2[8];
        x1[0] = bflo(qv[4].x); x1[1] = bfhi(qv[4].x); x1[2] = bflo(qv[4].y); x1[3] = bfhi(qv[4].y); x1[4] = bflo(qv[4].z); x1[5] = bfhi(qv[4].z); x1[6] = bflo(qv[4].w); x1[7] = bfhi(qv[4].w);
        x2[0] = bflo(qv[5].x); x2[1] = bfhi(qv[5].x); x2[2] = bflo(qv[5].y); x2[3] = bfhi(qv[5].y); x2[4] = bflo(qv[5].z); x2[5] = bfhi(qv[5].z); x2[6] = bflo(qv[5].w); x2[7] = bfhi(qv[5].w);
#pragma unroll
        for (int j = 0; j < 8; ++j) { const float inv = __builtin_amdgcn_exp2f(-(float)(2 * (8 * hi + j)) * (13.287712379549449f / 32.f)); float sn, cs; fsincos(posf * inv, sn, cs);
            const float a = (x1[j] * cs - x2[j] * sn) * sc, b2 = (x2[j] * cs + x1[j] * sn) * sc; x1[j] = a; x2[j] = b2; }
#pragma unroll
        for (int ks = 0; ks < 4; ++ks) { const v4u v = qv[ks];
            qr[ks] = __builtin_bit_cast(bf16x8, (v4u){pk2(bflo(v.x) * sc, bfhi(v.x) * sc), pk2(bflo(v.y) * sc, bfhi(v.y) * sc), pk2(bflo(v.z) * sc, bfhi(v.z) * sc), pk2(bflo(v.w) * sc, bfhi(v.w) * sc)}); }
        qr[4] = __builtin_bit_cast(bf16x8, (v4u){pk2(x1[0], x1[1]), pk2(x1[2], x1[3]), pk2(x1[4], x1[5]), pk2(x1[6], x1[7])});
        qr[5] = __builtin_bit_cast(bf16x8, (v4u){pk2(x2[0], x2[1]), pk2(x2[2], x2[3]), pk2(x2[4], x2[5]), pk2(x2[6], x2[7])});
    }
    f32x16 o0 = {}, o1 = {}; float mrun = 0.f, lrun = 0.f;
    const int NT = (q0 + 256) / 64;
    const int kr_ = tid >> 3, kc = tid & 7;
    const int rr_ = (tid & 255) >> 2, rc = tid & 3;
    const bf16* kn_src = B.KN() + (rb + kr_) * 512 + h * 64 + kc * 8;
    const bf16* kr_src = B.KR() + (rb + rr_) * 32 + rc * 8;
    const bf16* vt_src = B.VT() + (size_t)(h * 64 + kr_) * VT_P + rb + kc * 8;
    const bool rope_thr = tid < 256;
    LAS unsigned char* const kw = lds + kr_ * (AT_KP * 2) + kc * 16; LAS unsigned char* const rw = lds + rr_ * (AT_KP * 2) + 128 + rc * 16; LAS unsigned char* const vw = lds + 2 * AT_KB + kr_ * (AT_VP * 2) + kc * 16;
#define AT_LOAD(t, gk, gr, gv) do { gk = *(const v4u*)(kn_src + (size_t)(t) * 64 * 512); if (rope_thr) gr = *(const v4u*)(kr_src + (size_t)(t) * 64 * 32); gv = *(const v4u*)(vt_src + (t) * 64); } while (0)
#define AT_STORE(buf, gk, gr, gv) do { *(LAS v4u*)(kw + (buf) * AT_KB) = gk; if (rope_thr) *(LAS v4u*)(rw + (buf) * AT_KB) = gr; *(LAS v2u*)(vw + (buf) * AT_VB) = (v2u){gv.x, gv.y}; *(LAS v2u*)(vw + (buf) * AT_VB + 8) = (v2u){gv.z, gv.w}; } while (0)
    v4u gkA, grA, gvA, gkB, grB, gvB;
    AT_LOAD(0, gkA, grA, gvA); AT_LOAD(1, gkB, grB, gvB);
    AT_STORE(0, gkA, grA, gvA);
    __syncthreads();
    for (int t = 0; t < NT; t += 2) {
        if (t + 2 < NT) AT_LOAD(t + 2, gkA, grA, gvA);
        if (64 * t <= qmin + 31) attn_tile(lds, lds + 2 * AT_KB, qr, o0, o1, mrun, lrun, 64 * t, qrow, qmin, q31, hi, t == 0);
        AT_STORE(1, gkB, grB, gvB);
        __syncthreads();
        if (t + 3 < NT) AT_LOAD(t + 3, gkB, grB, gvB);
        if (64 * (t + 1) <= qmin + 31) attn_tile(lds + AT_KB, lds + 2 * AT_KB + AT_VB, qr, o0, o1, mrun, lrun, 64 * (t + 1), qrow, qmin, q31, hi, false);
        if (t + 2 < NT) AT_STORE(0, gkA, grA, gvA);
        __syncthreads();
    }
#undef AT_LOAD
#undef AT_STORE
    lrun += sx(lrun, 32);
    const float il = 1.f / lrun;
    bf16* orow = B.YA() + (rb + qrow) * YCW + YC_C + h * 64;
#pragma unroll
    for (int g4 = 0; g4 < 4; ++g4) {
        const v2u a = {pk2(o0[4 * g4] * il, o0[4 * g4 + 1] * il), pk2(o0[4 * g4 + 2] * il, o0[4 * g4 + 3] * il)};
        const v2u c = {pk2(o1[4 * g4] * il, o1[4 * g4 + 1] * il), pk2(o1[4 * g4 + 2] * il, o1[4 * g4 + 3] * il)};
        *(v2u*)(orow + 8 * g4 + 4 * hi) = a; *(v2u*)(orow + 32 + 8 * g4 + 4 * hi) = c;
    }
}
__device__ __forceinline__ void attn_phase(const Bufs& B, int pass, LAS unsigned char* lds) {
    const int* pos = (const int*)kin()[1] + (size_t)pass * M;
    const int c = blockIdx.x;
    for (int u = c; u < 2 * 256; u += gridDim.x) {
        const int c8 = u & 255, second = u >> 8; const int cc = (c8 & 7) * 32 + (c8 >> 3);
        const int bh = cc >> 4, s = cc & 15;
        attn_unit(B, pos, bh >> 3, bh & 7, second ? 31 - s : s, lds);
    }
}

template <int N, int K, int J> struct BitonicDesc {
    static __device__ __forceinline__ void run(float (&v)[N]) {
#pragma unroll
        for (int i = 0; i < N; ++i) { const int l = i ^ J; if (l > i) { const bool desc = ((i & K) == 0) || (K == N); const float a = v[i], b = v[l]; const float mx = __builtin_fmaxf(a, b), mn = __builtin_fminf(a, b); v[i] = desc ? mx : mn; v[l] = desc ? mn : mx; } }
        if constexpr (J > 1) BitonicDesc<N, K, J / 2>::run(v); else if constexpr (K < N) BitonicDesc<N, 2 * K, K>::run(v);
    }
};
__device__ __forceinline__ void sort16_desc(float (&v)[16]) { BitonicDesc<16, 2, 1>::run(v); }
__device__ __forceinline__ void merge16_desc(float (&a)[16], const float (&b)[16]) {
#pragma unroll
    for (int i = 0; i < 16; ++i) a[i] = __builtin_fmaxf(a[i], b[15 - i]);
    BitonicDesc<16, 16, 8>::run(a);
}
__device__ __forceinline__ void xmerge16_desc(float (&a)[16]) {
    float o[16];
#pragma unroll
    for (int i = 0; i < 16; ++i) o[i] = sx(a[i], 32);
    merge16_desc(a, o);
}
constexpr int SK_P = 136, SEL_LDS = 2 * PK * SK_P * 2;
__device__ __forceinline__ void sel_phase(const Params& p, const Bufs& B, int l, LAS unsigned char* lds) {
    const int tid = otid(), lane = tid & 63, w = tid >> 6, n = lane & 31, hi = lane >> 5;
    const bf16* sk = (const bf16*)(wl_ptr(p, l) + WO_SK);
    for (int i = tid; i < 2 * PK * 16; i += NTHR) { const int row = i >> 4, ch = i & 15; *(LAS v4u*)(lds + row * (SK_P * 2) + ch * 16) = *(const v4u*)(sk + row * 128 + ch * 8); }
    __syncthreads();
    for (int task = blockIdx.x * NWAVES + w; task < M * 8 / 32; task += gridDim.x * NWAVES) {
        const int pair = task * 32 + n, t = pair >> 3, h = pair & 7;
        const bf16* qrow = B.PQ() + (size_t)t * 2048 + h * 256;
        float a0[16], a1[16];
#pragma unroll
        for (int j = 0; j < 2; ++j) {
            bf16x8 qf[8];
#pragma unroll
            for (int ks = 0; ks < 8; ++ks) qf[ks] = *(const bf16x8*)(qrow + j * 128 + 16 * ks + 8 * hi);
            float run[16];
#pragma unroll
            for (int kb = 0; kb < 4; ++kb) { f32x16 acc = {};
#pragma unroll
                for (int ks = 0; ks < 8; ++ks) { const bf16x8 A = *(const LAS bf16x8*)(lds + ((j * PK + kb * 32 + n) * SK_P + 16 * ks + 8 * hi) * 2); acc = __builtin_amdgcn_mfma_f32_32x32x16_bf16(A, qf[ks], acc, 0, 0, 0); }
                float v[16];
#pragma unroll
                for (int r = 0; r < 16; ++r) v[r] = bitsf((fbits(acc[r]) & ~127u) | (unsigned)(kb * 32 + (r & 3) + 8 * (r >> 2) + 4 * hi));
                sort16_desc(v);
                if (kb == 0) {
#pragma unroll
                    for (int i = 0; i < 16; ++i) run[i] = v[i]; }
                else merge16_desc(run, v);
                asm volatile("" ::: "memory");
            }
            xmerge16_desc(run);
#pragma unroll
            for (int i = 0; i < 16; ++i) { if (j == 0) a0[i] = run[i]; else a1[i] = run[i]; }
        }
        unsigned k0[16], k1[16];
#pragma unroll
        for (int i = 0; i < 16; ++i) { k0[i] = (fbits(a0[i]) & 127u) << 7; k1[i] = fbits(a1[i]) & 127u; }
        float cc[32];
#pragma unroll
        for (int s_ = 0; s_ < 32; ++s_) cc[s_] = -INFINITY;
        {
            int cnt = 0;
#pragma unroll
            for (int i = 0; i < 16; ++i)
#pragma unroll
                for (int j = 0; j < 16; ++j) if ((i + 1) * (j + 1) <= 16) {
                    const float vv = bitsf((fbits(a0[i] + a1[j]) & ~0x3FFFu) | k0[i] | k1[j]);
                    if ((cnt & 1) == 0) { cc[cnt >> 1] = hi ? cc[cnt >> 1] : vv; } else { cc[cnt >> 1] = hi ? vv : cc[cnt >> 1]; }
                    ++cnt; }
        }
        float c0[16], c1[16];
#pragma unroll
        for (int i = 0; i < 16; ++i) { c0[i] = cc[i]; c1[i] = cc[16 + i]; }
        sort16_desc(c0); sort16_desc(c1); merge16_desc(c0, c1); xmerge16_desc(c0);
        const float m0 = bitsf(fbits(c0[0]) & ~0x3FFFu);
        float e[16]; float sum = 0.f;
#pragma unroll
        for (int i = 0; i < 16; ++i) { e[i] = __builtin_amdgcn_exp2f((bitsf(fbits(c0[i]) & ~0x3FFFu) - m0) * 1.4426950408889634f); sum += e[i]; }
        const float inv = 1.f / sum;
        v4u ia, ib; f32x4 ga, gb; const unsigned hm = 0u - (unsigned)hi;
#define SELH(a, b) ((fbits((a)) & ~hm) | (fbits((b)) & hm))
#pragma unroll
        for (int q = 0; q < 4; ++q) { ia[q] = SELH(c0[q], c0[8 + q]) & 0x3FFFu; ib[q] = SELH(c0[4 + q], c0[12 + q]) & 0x3FFFu;
            ga[q] = bitsf(SELH(e[q], e[8 + q])) * inv; gb[q] = bitsf(SELH(e[4 + q], e[12 + q])) * inv; }
#undef SELH
        const size_t ob = (size_t)t * 128 + h * 16 + 8 * hi;
        *(v4u*)(B.IDX() + ob) = ia; *(v4u*)(B.IDX() + ob + 4) = ib; *(f32x4*)(B.GW() + ob) = ga; *(f32x4*)(B.GW() + ob + 4) = gb;
    }
}

__device__ __forceinline__ float ub0(unsigned w) { return (float)(w & 0xffu); }
__device__ __forceinline__ float ub1(unsigned w) { return (float)((w >> 8) & 0xffu); }
__device__ __forceinline__ float ub2(unsigned w) { return (float)((w >> 16) & 0xffu); }
__device__ __forceinline__ float ub3(unsigned w) { return (float)(w >> 24); }
constexpr int EXP_LDS = NWAVES * 8 * 128 * 4;
__device__ __forceinline__ void exp_sort128(unsigned& k0, unsigned& k1, int lane) {
#pragma unroll
    for (int k = 2; k <= 128; k <<= 1) {
#pragma unroll
        for (int j = k >> 1; j > 0; j >>= 1) {
            if (j == 64) { const unsigned lo = k0 < k1 ? k0 : k1, hi = k0 < k1 ? k1 : k0; k0 = lo; k1 = hi; }
            else {
                const unsigned p0 = (unsigned)__builtin_amdgcn_ds_bpermute(((lane ^ j) << 2), (int)k0), p1 = (unsigned)__builtin_amdgcn_ds_bpermute(((lane ^ j) << 2), (int)k1);
                const bool upper = (lane & j) != 0;
                const bool asc0 = (k == 128) ? true : ((lane & k) == 0), asc1 = (k == 128) ? true : (((64 + lane) & k) == 0);
                const unsigned mn0 = k0 < p0 ? k0 : p0, mx0 = k0 < p0 ? p0 : k0, mn1 = k1 < p1 ? k1 : p1, mx1 = k1 < p1 ? p1 : k1;
                k0 = (upper == asc0) ? mx0 : mn0; k1 = (upper == asc1) ? mx1 : mn1;
            }
        }
    }
}
__device__ __forceinline__ void exp_u_group(const unsigned char* TU, int idsel, float gwsel, float susel, float svsel, const v4u& xq, int g, LAS float* crow, int lane) {
    v4u U[8];
#pragma unroll
    for (int e = 0; e < 8; ++e) { const int idk = __builtin_amdgcn_readlane(idsel, (8 * g + e) & 63); U[e] = *(const v4u*)(TU + (size_t)idk * D + 16 * lane); }
    int sd[8];
#pragma unroll
    for (int e = 0; e < 8; ++e) { int a = 0; a = __builtin_amdgcn_sdot4((int)U[e].x, (int)xq.x, a, false); a = __builtin_amdgcn_sdot4((int)U[e].y, (int)xq.y, a, false);
        a = __builtin_amdgcn_sdot4((int)U[e].z, (int)xq.z, a, false); a = __builtin_amdgcn_sdot4((int)U[e].w, (int)xq.w, a, false); sd[e] = a; }
    const bool hi = lane >= 32, b4 = (lane >> 4) & 1, b3 = (lane >> 3) & 1;
    float r[4];
#pragma unroll
    for (int q = 0; q < 4; ++q) { const float keep = (float)(hi ? sd[4 + q] : sd[q]), send = (float)(hi ? sd[q] : sd[4 + q]); r[q] = keep + sx(send, 32); }
    const float r0 = (b4 ? r[2] : r[0]) + sx(b4 ? r[0] : r[2], 16), r1 = (b4 ? r[3] : r[1]) + sx(b4 ? r[1] : r[3], 16);
    float qv = (b3 ? r1 : r0) + sx(b3 ? r0 : r1, 8);
    qv += sx(qv, 4); qv += sx(qv, 2); qv += sx(qv, 1);
    const int src = (8 * g + (lane >> 3)) & 63;
    const float ck = sl(gwsel, src) * gelu_t(qv * sl(susel, src)) * sl(svsel, src);
    if ((lane & 7) == 0) crow[8 * g + (lane >> 3)] = ck;
}
__device__ __forceinline__ void exp_v_group(const unsigned char* TV, int idsel, float csel, int g, float (&o)[16], int lane) {
    v4u V[8];
#pragma unroll
    for (int e = 0; e < 8; ++e) { const int idk = __builtin_amdgcn_readlane(idsel, (8 * g + e) & 63); V[e] = *(const v4u*)(TV + (size_t)idk * D + 16 * lane); }
#pragma unroll
    for (int e = 0; e < 8; ++e) { const float a = __builtin_bit_cast(float, __builtin_amdgcn_readlane(__builtin_bit_cast(int, csel), (8 * g + e) & 63));
        const unsigned w0 = V[e].x, w1 = V[e].y, w2 = V[e].z, w3 = V[e].w;
        o[0] = fmaf(a, ub0(w0), o[0]); o[1] = fmaf(a, ub1(w0), o[1]); o[2] = fmaf(a, ub2(w0), o[2]); o[3] = fmaf(a, ub3(w0), o[3]);
        o[4] = fmaf(a, ub0(w1), o[4]); o[5] = fmaf(a, ub1(w1), o[5]); o[6] = fmaf(a, ub2(w1), o[6]); o[7] = fmaf(a, ub3(w1), o[7]);
        o[8] = fmaf(a, ub0(w2), o[8]); o[9] = fmaf(a, ub1(w2), o[9]); o[10] = fmaf(a, ub2(w2), o[10]); o[11] = fmaf(a, ub3(w2), o[11]);
        o[12] = fmaf(a, ub0(w3), o[12]); o[13] = fmaf(a, ub1(w3), o[13]); o[14] = fmaf(a, ub2(w3), o[14]); o[15] = fmaf(a, ub3(w3), o[15]); }
}
__device__ __forceinline__ void exp_phase(const Params& p, const Bufs& B, int l, int pass, int final_, bool dry, LAS unsigned char* lds) {
    const int tid = otid(), lane = tid & 63, w = tid >> 6;
    LAS float* cbuf = (LAS float*)(lds + w * (8 * 128 * 4));
    const int gw_ = blockIdx.x * NWAVES + w, ngw_ = gridDim.x * NWAVES;
    const unsigned char* TU = B.TABU() + (size_t)l * PE * D; const unsigned char* TV = B.TABV() + (size_t)l * PE * D;
    for (int tb_ = gw_; tb_ < M; tb_ += 8 * ngw_) {
        int id0[8], id1[8];
        {
            const float* SUl = B.SU() + l * PE; const float* SVl = B.SV() + l * PE;
            float g0[8], g1[8], su0[8], su1[8], sv0[8], sv1[8]; v4u xq[8];
#pragma unroll
            for (int j = 0; j < 8; ++j) { const int t = min(tb_ + j * ngw_, M - 1);
                const bf16* hrow = B.HB() + ((size_t)pass * M + t) * D;
                const v4u xa = *(const v4u*)(hrow + 16 * lane), xb = *(const v4u*)(hrow + 16 * lane + 8);
                const float xf[16] = {bflo(xa.x), bfhi(xa.x), bflo(xa.y), bfhi(xa.y), bflo(xa.z), bfhi(xa.z), bflo(xa.w), bfhi(xa.w), bflo(xb.x), bfhi(xb.x), bflo(xb.y), bfhi(xb.y), bflo(xb.z), bfhi(xb.z), bflo(xb.w), bfhi(xb.w)};
                float am = 0.f;
#pragma unroll
                for (int i = 0; i < 16; ++i) am = fmaxf(am, fabsf(xf[i]));
#pragma unroll
                for (int o_ = 32; o_ > 0; o_ >>= 1) am = fmaxf(am, sx(am, o_));
                const float sxs = am > 0.f ? am * (1.f / 127.f) : 1.f, xinv = 1.f / sxs;
#pragma unroll
                for (int q = 0; q < 4; ++q) { unsigned wv = 0u;
#pragma unroll
                    for (int e = 0; e < 4; ++e) wv |= ((unsigned)(int)rintf(xf[4 * q + e] * xinv) & 0xffu) << (8 * e);
                    xq[j][q] = wv; }
                const int ia = B.IDX()[(size_t)t * 128 + lane], ib = B.IDX()[(size_t)t * 128 + 64 + lane];
                const float ga = B.GW()[(size_t)t * 128 + lane], gb = B.GW()[(size_t)t * 128 + 64 + lane];
                unsigned k0 = ((unsigned)ia << 7) | (unsigned)lane, k1 = ((unsigned)ib << 7) | (unsigned)(64 + lane);
                exp_sort128(k0, k1, lane);
                id0[j] = (int)(k0 >> 7); id1[j] = (int)(k1 >> 7);
                const int s0 = (int)(k0 & 127u), s1 = (int)(k1 & 127u);
                const float a0 = sl(ga, s0 & 63), b0 = sl(gb, s0 & 63), a1 = sl(ga, s1 & 63), b1 = sl(gb, s1 & 63);
                g0[j] = s0 < 64 ? a0 : b0; g1[j] = s1 < 64 ? a1 : b1;
                su0[j] = SUl[id0[j]] * sxs; su1[j] = SUl[id1[j]] * sxs; sv0[j] = SVl[id0[j]]; sv1[j] = SVl[id1[j]]; }
            for (int g = 0; g < 16; ++g) {
#pragma unroll
                for (int j = 0; j < 8; ++j) exp_u_group(TU, g < 8 ? id0[j] : id1[j], g < 8 ? g0[j] : g1[j], g < 8 ? su0[j] : su1[j], g < 8 ? sv0[j] : sv1[j], xq[j], g, cbuf + j * 128, lane);
            }
        }
        LDS_WAIT(); asm volatile("" ::: "memory");
        const float* g2 = kin()[34] + l * D; const float* b2 = kin()[35] + l * D;
        { constexpr int hr = 0;
            float c0[8], c1[8], o[8][16];
#pragma unroll
            for (int jj = 0; jj < 8; ++jj) { c0[jj] = cbuf[(4 * hr + jj) * 128 + lane]; c1[jj] = cbuf[(4 * hr + jj) * 128 + 64 + lane];
#pragma unroll
                for (int i = 0; i < 16; ++i) o[jj][i] = 0.f; }
            for (int g = 0; g < 16; ++g) {
#pragma unroll
                for (int jj = 0; jj < 8; ++jj) exp_v_group(TV, g < 8 ? id0[4 * hr + jj] : id1[4 * hr + jj], g < 8 ? c0[jj] : c1[jj], g, o[jj], lane);
            }
#pragma unroll
            for (int jj = 0; jj < 8; ++jj) { const int t = tb_ + (4 * hr + jj) * ngw_;
                if (t < M) {
                    bf16* hrow = B.HB() + ((size_t)pass * M + t) * D;
                    const v4u xa = *(const v4u*)(hrow + 16 * lane), xb = *(const v4u*)(hrow + 16 * lane + 8);
                    const float coff = 128.f * wsum(c0[jj] + c1[jj]);
                    const float xg[16] = {bflo(xa.x), bfhi(xa.x), bflo(xa.y), bfhi(xa.y), bflo(xa.z), bfhi(xa.z), bflo(xa.w), bfhi(xa.w), bflo(xb.x), bfhi(xb.x), bflo(xb.y), bfhi(xb.y), bflo(xb.z), bfhi(xb.z), bflo(xb.w), bfhi(xb.w)};
                    float y[16]; float sm = 0.f;
#pragma unroll
                    for (int i = 0; i < 16; ++i) { y[i] = ALPHA * xg[i] + (o[jj][i] - coff); sm += y[i]; }
                    const float mu = wsum(sm) * (1.f / D); float sq = 0.f;
#pragma unroll
                    for (int i = 0; i < 16; ++i) { y[i] -= mu; sq += y[i] * y[i]; }
                    const float rs = __builtin_amdgcn_rsqf(wsum(sq) * (1.f / D) + 1e-5f);
                    const int c0_ = 16 * lane; f32x4 yo[4];
#pragma unroll
                    for (int q = 0; q < 4; ++q) { const f32x4 ga = *(const f32x4*)(g2 + c0_ + 4 * q), ba = *(const f32x4*)(b2 + c0_ + 4 * q);
#pragma unroll
                        for (int e = 0; e < 4; ++e) yo[q][e] = y[4 * q + e] * rs * ga[e] + ba[e]; }
                    if (dry) { if (yo[0][0] == 12345.678f) B.TS()[t] = yo[1][1] + yo[2][2] + yo[3][3]; }
                    else {
                        *(v4u*)(hrow + c0_) = (v4u){pk2(yo[0][0], yo[0][1]), pk2(yo[0][2], yo[0][3]), pk2(yo[1][0], yo[1][1]), pk2(yo[1][2], yo[1][3])};
                        *(v4u*)(hrow + c0_ + 8) = (v4u){pk2(yo[2][0], yo[2][1]), pk2(yo[2][2], yo[2][3]), pk2(yo[3][0], yo[3][1]), pk2(yo[3][2], yo[3][3])};
                        if (final_) { float* orow = p.out + ((size_t)pass * M + t) * D + c0_;
#pragma unroll
                            for (int q = 0; q < 4; ++q) *(f32x4*)(orow + 4 * q) = yo[q]; } }
                }
            }
        }
        LDS_WAIT(); asm volatile("" ::: "memory");
    }
    __syncthreads();
}

__device__ __forceinline__ void rms_phase(const Params& p, const Bufs& B, int l, int pass) {
    const int lane = otid() & 63, w = otid() >> 6;
    const float* gq = kin()[20] + l * QR; const float* gk = kin()[22] + l * KVR;
    const f32x4 g4 = *(const f32x4*)(gq + 4 * lane); const f32x2 k2 = *(const f32x2*)(gk + 2 * lane);
    const int* posr = (const int*)kin()[1] + (size_t)pass * M;
    for (int t = blockIdx.x * NWAVES + w; t < M; t += gridDim.x * NWAVES) {
        const bf16* pr = B.PROJ() + (size_t)t * PROJW;
        const v2u q = *(const v2u*)(pr + O_CQ + 4 * lane); const unsigned k = *(const unsigned*)(pr + O_CKV + 2 * lane);
        const float q0 = bflo(q.x), q1 = bfhi(q.x), q2 = bflo(q.y), q3 = bfhi(q.y), k0 = bflo(k), k1 = bfhi(k);
        const float rq = __builtin_amdgcn_rsqf(wsum(q0 * q0 + q1 * q1 + q2 * q2 + q3 * q3) * (1.f / QR) + 1e-6f), rk = __builtin_amdgcn_rsqf(wsum(k0 * k0 + k1 * k1) * (1.f / KVR) + 1e-6f);
        *(v2u*)(B.CQN() + (size_t)t * 256 + 4 * lane) = (v2u){pk2(q0 * rq * g4[0], q1 * rq * g4[1]), pk2(q2 * rq * g4[2], q3 * rq * g4[3])};
        *(unsigned*)(B.CKVN() + (size_t)t * 256 + 2 * lane) = pk2(k0 * rk * k2[0], k1 * rk * k2[1]);
        *(unsigned*)(B.CKVN() + (size_t)t * 256 + 128 + 2 * lane) = 0u;
        if (lane < 16) {
            const float inv = __builtin_amdgcn_exp2f(-(float)(2 * lane) * (13.287712379549449f / 32.f)); float sn, cs; fsincos((float)posr[t] * inv, sn, cs);
            const float k1 = bf2f(pr[O_KR + lane]), k2r = bf2f(pr[O_KR + 16 + lane]);
            B.KR()[(size_t)t * 32 + lane] = (bf16)f2bf(k1 * cs - k2r * sn); B.KR()[(size_t)t * 32 + 16 + lane] = (bf16)f2bf(k2r * cs + k1 * sn); }
    }
}
__device__ __forceinline__ void ln1_phase(const Params& p, const Bufs& B, int l, int pass) {
    const int lane = otid() & 63, w = otid() >> 6;
    const float* g1 = kin()[28] + l * D; const float* b1 = kin()[29] + l * D;
    for (int t = blockIdx.x * NWAVES + w; t < M; t += gridDim.x * NWAVES) {
        bf16* hrow = B.HB() + ((size_t)pass * M + t) * D; const float* mrow = B.F32() + (size_t)t * D;
        const v4u x0 = *(const v4u*)(hrow + 8 * lane), x1 = *(const v4u*)(hrow + 512 + 8 * lane);
        const f32x4 m0 = *(const f32x4*)(mrow + 8 * lane), m1 = *(const f32x4*)(mrow + 8 * lane + 4), m2 = *(const f32x4*)(mrow + 512 + 8 * lane), m3 = *(const f32x4*)(mrow + 512 + 8 * lane + 4);
        float y[16]; float sm = 0.f;
        y[0] = ALPHA * bflo(x0.x) + m0[0]; y[1] = ALPHA * bfhi(x0.x) + m0[1]; y[2] = ALPHA * bflo(x0.y) + m0[2]; y[3] = ALPHA * bfhi(x0.y) + m0[3];
        y[4] = ALPHA * bflo(x0.z) + m1[0]; y[5] = ALPHA * bfhi(x0.z) + m1[1]; y[6] = ALPHA * bflo(x0.w) + m1[2]; y[7] = ALPHA * bfhi(x0.w) + m1[3];
        y[8] = ALPHA * bflo(x1.x) + m2[0]; y[9] = ALPHA * bfhi(x1.x) + m2[1]; y[10] = ALPHA * bflo(x1.y) + m2[2]; y[11] = ALPHA * bfhi(x1.y) + m2[3];
        y[12] = ALPHA * bflo(x1.z) + m3[0]; y[13] = ALPHA * bfhi(x1.z) + m3[1]; y[14] = ALPHA * bflo(x1.w) + m3[2]; y[15] = ALPHA * bfhi(x1.w) + m3[3];
#pragma unroll
        for (int i = 0; i < 16; ++i) sm += y[i];
        const float mu = wsum(sm) * (1.f / D); float sq = 0.f;
#pragma unroll
        for (int i = 0; i < 16; ++i) { y[i] -= mu; sq += y[i] * y[i]; }
        const float rs = __builtin_amdgcn_rsqf(wsum(sq) * (1.f / D) + 1e-5f);
#pragma unroll
        for (int hf = 0; hf < 2; ++hf) { const int c0 = hf * 512 + 8 * lane;
            const f32x4 ga = *(const f32x4*)(g1 + c0), gb = *(const f32x4*)(g1 + c0 + 4), ba = *(const f32x4*)(b1 + c0), bb = *(const f32x4*)(b1 + c0 + 4);
            f32x4 ya, yb;
#pragma unroll
            for (int q = 0; q < 4; ++q) { ya[q] = y[hf * 8 + q] * rs * ga[q] + ba[q]; yb[q] = y[hf * 8 + 4 + q] * rs * gb[q] + bb[q]; }
            *(v4u*)(hrow + c0) = (v4u){pk2(ya[0], ya[1]), pk2(ya[2], ya[3]), pk2(yb[0], yb[1]), pk2(yb[2], yb[3])}; }
    }
}

constexpr int LDS_BYTES = 147456, MISC_OFF = LDS_BYTES - 128;
constexpr int CW_BAR = 4096;
static_assert(EXP_LDS <= MISC_OFF && S5_LDS <= MISC_OFF && XC_LDS <= MISC_OFF && SEL_LDS <= MISC_OFF && S3_LDS <= MISC_OFF && AT_LDS <= MISC_OFF && 131072 <= MISC_OFF && (CW_BAR + XCD_BAR_WORDS) * 4 <= (int)CTL_ZERO_BYTES, "LDS / control map");
constexpr int NPH_LAYER = 11, NPH = 1 + DEPTH * NPASS * NPH_LAYER;
__global__ void __launch_bounds__(NTHR, 2) mega(Params p, int ph_lo, int ph_hi, int sub) {
    extern __shared__ __attribute__((aligned(16))) unsigned char lds_raw[];
    LAS unsigned char* lds = (LAS unsigned char*)lds_raw;
    const Bufs B = make_bufs(p);
    const int tid = threadIdx.x, bid = blockIdx.x, G = gridDim.x;
    volatile LAS unsigned* MISC = (volatile LAS unsigned*)(lds + MISC_OFF);
    if (tid < 32) MISC[tid] = 0u;
    __syncthreads();
    XcdBarrier bar; bar.bar = (unsigned*)(p.ws + WS_CTL) + CW_BAR; bar.x = 0; bar.st = MISC + 8;
    if (ph_hi - ph_lo > 1) bar = xcd_barrier_post((unsigned*)(p.ws + WS_CTL) + CW_BAR, MISC + 8);
    int ph = 0;
#define OPQ(x) asm volatile("" : "+s"(x) :: "memory")
#ifndef PHMASK
#define PHMASK 0xFFF
#endif
#define PH_EN(b) (((PHMASK) >> (b)) & 1)
#ifndef DUPMASK
#define DUPMASK 0
#endif
#define REP(k) for (int rep_ = 0; rep_ < 1 + (((DUPMASK) >> (k)) & 1); ++rep_)
#define RUN(k) (ph_lo <= (k) && (k) < ph_hi)
#define SEAM(k) do { if (RUN(k) && RUN((k) + 1)) { xcd_barrier(bar); } } while (0)
    if (PH_EN(0) && RUN(ph)) { prologue_phase(p, B, lds); tables_phase(p, B); s5_tables_phase(p); }
    SEAM(ph); ++ph;
    for (int l = 0; l < DEPTH; ++l) {
        for (int pass = 0; pass < NPASS; ++pass) {
            if (PH_EN(1) && RUN(ph)) REP(1) { gemm_ph<G_PROJ>(p, B, l, pass, bid, lds); }
            SEAM(ph); ++ph;
            if (PH_EN(2) && RUN(ph)) REP(2) { if (sub & 1) s5a_phase(p, B, l, lds); if (sub & 2) xc_phase(p, B, l, lds); if (sub & 4) rms_phase(p, B, l, pass); }
            SEAM(ph); ++ph;
            if (PH_EN(3) && RUN(ph)) REP(3) { if (rep_ == 0 && (sub & 1)) s5scan_phase(p, B, l, bid * NTHR + otid(), G * NTHR); if (sub & 2) ssd1_phase(B);
                if (sub & 4) { int c0 = bid; OPQ(c0); gemm_ph<G_Q>(p, B, l, pass, c0, lds); int c1 = (bid + 64) % G; OPQ(c1); gemm_ph<G_KN>(p, B, l, pass, c1, lds); int c2 = (bid + G - 64) % G; OPQ(c2); gemm_ph<G_VT>(p, B, l, pass, c2, lds); } }
            SEAM(ph); ++ph;
            if (PH_EN(4) && RUN(ph)) REP(4) { if (sub & 1) ssd2_phase(B, bid * NTHR + otid(), G * NTHR); if (sub & 4) s5b_phase(p, B, l, lds); }
            SEAM(ph); ++ph;
            if (PH_EN(5) && RUN(ph)) REP(5) { if (sub & 1) attn_phase(B, pass, lds); int lq = l; OPQ(lq); if (sub & 2) ssd3_phase(p, B, lq, lds); int c0 = (bid + 128) % G; OPQ(c0); if (sub & 4) gemm_ph<G_GLU>(p, B, l, pass, c0, lds); }
            SEAM(ph); ++ph;
            if (PH_EN(6) && RUN(ph)) REP(6) { gemm_ph<G_M0>(p, B, l, pass, bid, lds); }
            SEAM(ph); ++ph;
            if (PH_EN(7) && RUN(ph)) REP(7) gemm_ph<G_OUT>(p, B, l, pass, bid, lds);
            SEAM(ph); ++ph;
            if (PH_EN(8) && RUN(ph)) ln1_phase(p, B, l, pass);
            SEAM(ph); ++ph;
            if (PH_EN(9) && RUN(ph)) REP(9) gemm_ph<G_PQ>(p, B, l, pass, bid, lds);
            SEAM(ph); ++ph;
            if (PH_EN(10) && RUN(ph)) REP(10) sel_phase(p, B, l, lds);
            SEAM(ph); ++ph;
            if (PH_EN(11) && RUN(ph)) REP(11) exp_phase(p, B, l, pass, l == DEPTH - 1 ? 1 : 0, rep_ != 0, lds);
            SEAM(ph); ++ph;
        }
    }
#undef RUN
#undef SEAM
}

#ifndef MK_SPLIT
#define MK_SPLIT 0
#endif
extern "C" void kernel_launch(void* const* d_in, const int* in_sizes, int n_in, void* d_out, int out_size, void* d_ws, size_t ws_size, hipStream_t stream) {
    if (n_in != 36 || ws_size < WS_END || out_size != NB * SEQ * D) { fprintf(stderr, "kernel_launch: unexpected sizes (n_in %d, ws %zu, out %d)\n", n_in, ws_size, out_size); return; }
    static int grid = 0;
    if (grid == 0) {
        int dev = 0, cus = 0, per_cu = 0;
        if (hipGetDevice(&dev) != hipSuccess || hipDeviceGetAttribute(&cus, hipDeviceAttributeMultiprocessorCount, dev) != hipSuccess) { fprintf(stderr, "kernel_launch: device query failed\n"); grid = -1; return; }
        if (hipFuncSetAttribute((const void*)mega, hipFuncAttributeMaxDynamicSharedMemorySize, LDS_BYTES) != hipSuccess) { fprintf(stderr, "kernel_launch: hipFuncSetAttribute failed\n"); grid = -1; return; }
        if (hipOccupancyMaxActiveBlocksPerMultiprocessor(&per_cu, (const void*)mega, NTHR, LDS_BYTES) != hipSuccess || per_cu < 1) fprintf(stderr, "kernel_launch: note: occupancy query reports %d workgroups per CU\n", per_cu);
        (void)hipGetLastError();
        grid = cus;
    }
    if (grid < 0) return;
    Params p{};
    for (int i = 0; i < 36; ++i) p.in[i] = (const float*)d_in[i];
    p.out = (float*)d_out; p.ws = (unsigned char*)d_ws;
    (void)hipMemsetAsync((char*)d_ws + WS_CTL, 0, CTL_ZERO_BYTES, stream);
#ifdef PROBE_PRE
    for (int r = 0; r < PROBE_REP; ++r) hipLaunchKernelGGL(mega, dim3(grid), dim3(NTHR), LDS_BYTES, stream, p, NPH - NPH_LAYER + (PROBE_PRE), NPH - NPH_LAYER + (PROBE_PRE) + 1, PROBE_SUB);
#endif
#if MK_SPLIT
    for (int k = 0; k < NPH; ++k) hipLaunchKernelGGL(mega, dim3(grid), dim3(NTHR), LDS_BYTES, stream, p, k, k + 1, -1);
#else
    hipLaunchKernelGGL(mega, dim3(grid), dim3(NTHR), LDS_BYTES, stream, p, 0, NPH, -1);
#endif
#ifdef PROBE_ABS
    for (int r = 0; r < PROBE_REP; ++r) hipLaunchKernelGGL(mega, dim3(grid), dim3(NTHR), LDS_BYTES, stream, p, PROBE_ABS, PROBE_ABS + 1, -1);
#endif
#ifdef PROBE_PH
    for (int r = 0; r < PROBE_REP; ++r) hipLaunchKernelGGL(mega, dim3(grid), dim3(NTHR), LDS_BYTES, stream, p, NPH - NPH_LAYER + (PROBE_PH), NPH - NPH_LAYER + (PROBE_PH) + 1, PROBE_SUB);
#endif
}
```

```cpp
#include <hip/hip_runtime.h>
#include <cstdio>
#include <cstdint>
#include <cmath>
__device__ __forceinline__ int otid() { int t = threadIdx.x; asm volatile("" : "+v"(t)); __builtin_assume(t >= 0 && t < 512); return t; }
struct KIn { __device__ __forceinline__ const float* operator[](int i) const { int o_ = i * 8; asm volatile("" : "+v"(o_)); o_ = __builtin_amdgcn_readfirstlane(o_);
    const __attribute__((address_space(4))) char* base = (const __attribute__((address_space(4))) char*)__builtin_amdgcn_kernarg_segment_ptr();
    return (const float*)*(const __attribute__((address_space(1))) float* const __attribute__((address_space(4)))*)(base + o_); } };
__device__ __forceinline__ KIn kin() { return KIn{}; }
namespace pg8 {
#define PG8_LAS __attribute__((address_space(3)))
typedef unsigned short bf16_t;
typedef short bf16x8 __attribute__((ext_vector_type(8)));
typedef float f32x4 __attribute__((ext_vector_type(4)));
typedef unsigned u32x4 __attribute__((ext_vector_type(4)));
constexpr int BM = 256, BK = 64, HALF = 128, HTB = HALF * BK * 2  , STAGE_BYTES = 8 * HTB, NXCD = 8, WGM = 8;

__host__ __device__ __forceinline__ int lds_byte(int r, int c) { const int st = (r >> 4) * 2 + (c >> 5), rr = r & 15, cc = c & 31, ob = rr * 64 + cc * 2; return st * 1024 + (ob ^ (((ob >> 9) & 1) << 5)); }
__host__ __device__ __forceinline__ void stage_rc(int b, int& R, int& C) { const int st = b / 1024, sb = b % 1024, swz = sb ^ (((sb >> 9) & 1) << 5); R = (st >> 1) * 16 + swz / 64; C = (st & 1) * 32 + (swz % 64) / 2; }
__host__ __device__ __forceinline__ int perm32(int rho) { const int n = rho >> 4, i = rho & 15; return 8 * (i >> 2) + 4 * n + (i & 3); }

struct Unit { int pm, pn; };
struct Gemm { const bf16_t* A; const bf16_t* Bt; int M, N, K; };

struct StaticOrder {
    int nM, nN, nwg, G, c;
    __host__ __device__ void init(int M, int N, int G_, int c_) { nM = M / BM; nN = N / BM; nwg = nM * nN; G = G_; c = c_; }
    __host__ __device__ bool next(int i, Unit& u) const {
        const long L = (long)i * G + c; if (L >= nwg) return false;
        int wgid = (int)L; { const int q = nwg / NXCD, r = nwg % NXCD, xcd = wgid % NXCD, off = wgid / NXCD; wgid = (xcd < r ? xcd * (q + 1) : r * (q + 1) + (xcd - r) * q) + off; }
        const int nig = WGM * nN, gid = wgid / nig, fm = gid * WGM, gsz = (nM - fm) < WGM ? (nM - fm) : WGM;
        u.pm = fm + ((wgid % nig) % gsz); u.pn = (wgid % nig) / gsz; return true;
    }
    __device__ __forceinline__ void a_ready(const Unit&) const {}
    __device__ __forceinline__ void done(const Unit&) const {}
};

__device__ __forceinline__ unsigned cvt_pk_bf16(float lo, float hi) { unsigned r; asm volatile("v_cvt_pk_bf16_f32 %0, %1, %2" : "=v"(r) : "v"(lo), "v"(hi)); return r; }
typedef float f32x2 __attribute__((ext_vector_type(2)));
__device__ __forceinline__ f32x2 gelu_pk(f32x2 v) {
    const f32x2 av = __builtin_elementwise_abs(v), d = av * 0.2316418882f + 1.0f;
    f32x2 t; t.x = __builtin_amdgcn_rcpf(d.x); t.y = __builtin_amdgcn_rcpf(d.y);
    f32x2 q = t * 0.5307027145f + (-0.7265760135f); q = q * t + 0.7107068705f; q = q * t + (-0.142248368f); q = q * t + 0.127414796f; q = q * t;
    const f32x2 s = (v * v) * (-0.72134752044f);
    f32x2 e; e.x = __builtin_amdgcn_exp2f(s.x); e.y = __builtin_amdgcn_exp2f(s.y);
    const f32x2 m = v * (q * e), r = v - m;
    f32x2 o; o.x = v.x < 0.f ? m.x : r.x; o.y = v.y < 0.f ? m.y : r.y; return o;
}

template <int ACT  > struct EpiBf16 {
    static constexpr bool PERM = true, AFTER_DRAIN = false, MIDK = false; static_assert(ACT == 0 || ACT == 1, "EpiBf16: ACT is 0 (none) or 1 (gelu_pk)");
    bf16_t* O; int ldc; const float* bias; int split_cols; size_t split_stride; float scale0;
    __device__ __forceinline__ void operator()(const f32x4 (&acc)[2][2][4][2], const Unit& u, int wr, int wc, int fr_, int fq_) const {
        const int lane_ = otid() & 63, fr = lane_ & 15, fq = lane_ >> 4;
        const int row0 = u.pm * BM + wr * 64 + fr; int colt = u.pn * BM; bf16_t* base = O;
        float sc = 1.f; if (split_cols) { const int t = colt / split_cols; base += (size_t)t * split_stride; colt -= t * split_cols; if (t == 0) sc = scale0; }
        const int col0 = colt + wc * 32 + 8 * fq, bcol0 = u.pn * BM + wc * 32 + 8 * fq;
        f32x4 bv[2][2];
#pragma unroll
        for (int bj = 0; bj < 2; ++bj)
#pragma unroll
            for (int n = 0; n < 2; ++n) bv[bj][n] = bias ? *(const f32x4*)(bias + bcol0 + bj * HALF + 4 * n) : (f32x4){0.f, 0.f, 0.f, 0.f};
#pragma unroll
        for (int ai = 0; ai < 2; ++ai)
#pragma unroll
            for (int m = 0; m < 4; ++m) { bf16_t* rowp = base + (size_t)(row0 + ai * HALF + m * 16) * ldc + col0;
#pragma unroll
                for (int bj = 0; bj < 2; ++bj) { f32x4 v0 = acc[ai][bj][m][0] + bv[bj][0], v1 = acc[ai][bj][m][1] + bv[bj][1];
                    if (ACT == 1) { f32x2 a = gelu_pk((f32x2){v0[0], v0[1]}), b = gelu_pk((f32x2){v0[2], v0[3]}), c = gelu_pk((f32x2){v1[0], v1[1]}), d = gelu_pk((f32x2){v1[2], v1[3]});
                        v0 = (f32x4){a.x, a.y, b.x, b.y}; v1 = (f32x4){c.x, c.y, d.x, d.y}; }
                    v0 = v0 * sc; v1 = v1 * sc; u32x4 w; w.x = cvt_pk_bf16(v0[0], v0[1]); w.y = cvt_pk_bf16(v0[2], v0[3]); w.z = cvt_pk_bf16(v1[0], v1[1]); w.w = cvt_pk_bf16(v1[2], v1[3]);
                    *(u32x4*)(rowp + bj * HALF) = w; } }
    }
};

struct PanelStats {
    unsigned* xbuf;
    unsigned* cnt;
    unsigned* tmo;
    int ntn; float eps;
    unsigned code;
    __device__ __forceinline__ bool run(const f32x4 (&v)[2][2][4][2], const Unit& u, int wr, int wc, int fr, int fq, PG8_LAS unsigned char* lds, int wid, int lane) const {
        typedef float f32x2v __attribute__((ext_vector_type(2)));
        PG8_LAS f32x2v* P = (PG8_LAS f32x2v*)lds;
        PG8_LAS f32x2v* S = (PG8_LAS f32x2v*)(lds + 8192);
        PG8_LAS unsigned* flag = (PG8_LAS unsigned*)(lds + 8192 + 2048);
#pragma unroll
        for (int ai = 0; ai < 2; ++ai)
#pragma unroll
            for (int m = 0; m < 4; ++m) {
                float s = 0.f;
#pragma unroll
                for (int bj = 0; bj < 2; ++bj)
#pragma unroll
                    for (int n = 0; n < 2; ++n) { const f32x4 x = v[ai][bj][m][n]; s += (x[0] + x[1]) + (x[2] + x[3]); }
                s += __shfl_xor(s, 16); s += __shfl_xor(s, 32);
                const float mw = s * (1.0f / 64.0f); float q = 0.f;
#pragma unroll
                for (int bj = 0; bj < 2; ++bj)
#pragma unroll
                    for (int n = 0; n < 2; ++n) { const f32x4 d = v[ai][bj][m][n] - mw; q += (d[0] * d[0] + d[1] * d[1]) + (d[2] * d[2] + d[3] * d[3]); }
                q += __shfl_xor(q, 16); q += __shfl_xor(q, 32);
                if (fq == 0) P[(ai * HALF + wr * 64 + m * 16 + fr) * 4 + wc] = (f32x2v){mw, q};
            }
        asm volatile("s_waitcnt lgkmcnt(0)" ::: "memory"); __builtin_amdgcn_s_barrier(); asm volatile("" ::: "memory");
#if defined(BROKEN_EXCHANGE_NO_WAIT)
#warning BROKEN CONTROL BUILD: the row-statistics exchange does not wait; results are wrong by design
        if (blockIdx.x >= 64) { const long long t0_ = clock64(); while (clock64() - t0_ < 60000) __builtin_amdgcn_s_sleep(8); }
#endif
        const int row = wid * 32 + (lane & 31);
        if (lane < 32) {
            const f32x2v a = P[row * 4 + 0], b = P[row * 4 + 1], c = P[row * 4 + 2], d = P[row * 4 + 3];
            const float mt = (a.x + b.x + c.x + d.x) * 0.25f;
            const float da = a.x - mt, db = b.x - mt, dc = c.x - mt, dd = d.x - mt;
            const float m2 = (a.y + b.y) + (c.y + d.y) + 64.0f * ((da * da + db * db) + (dc * dc + dd * dd));
            unsigned long long* slot = (unsigned long long*)xbuf + ((size_t)(u.pm * BM + row) * 4 + u.pn);
            __hip_atomic_store(slot, ((unsigned long long)__float_as_uint(m2) << 32) | __float_as_uint(mt), __ATOMIC_RELAXED, __HIP_MEMORY_SCOPE_AGENT);
        }
        asm volatile("s_waitcnt vmcnt(0)" ::: "memory");
        if (lane == 0) __hip_atomic_fetch_add(cnt + 64 * u.pm, 1u, __ATOMIC_RELAXED, __HIP_MEMORY_SCOPE_AGENT);
        if (wid == 0) {
            bool dead = false; const unsigned long long t0 = __builtin_amdgcn_s_memrealtime(); const unsigned want = 8u * (unsigned)ntn;
            for (;;) {
#if defined(BROKEN_EXCHANGE_NO_WAIT)
                break;
#endif
                if ((unsigned)__builtin_amdgcn_readfirstlane(__hip_atomic_load(cnt + 64 * u.pm, __ATOMIC_RELAXED, __HIP_MEMORY_SCOPE_AGENT)) >= want) break;
                if (__builtin_amdgcn_s_memrealtime() - t0 > 2000000ull) {
                    if (lane == 0) { unsigned expect = 0u; __hip_atomic_compare_exchange_strong(tmo + 1, &expect, code | (unsigned)(u.pm & 0xff), __ATOMIC_RELAXED, __ATOMIC_RELAXED, __HIP_MEMORY_SCOPE_AGENT);
                                     __hip_atomic_store(tmo, 1u, __ATOMIC_RELAXED, __HIP_MEMORY_SCOPE_AGENT); }
                    dead = true; break; }
                __builtin_amdgcn_s_sleep(2);
            }
            __builtin_amdgcn_fence(__ATOMIC_ACQUIRE, "agent");
            if (lane == 0) flag[0] = dead ? 1u : 0u;
        }
        asm volatile("s_waitcnt vmcnt(0) lgkmcnt(0)" ::: "memory"); __builtin_amdgcn_s_barrier(); asm volatile("" ::: "memory");
        const bool bad = flag[0] != 0u;
        if (lane < 32) {
            const unsigned long long* slot = (const unsigned long long*)xbuf + (size_t)(u.pm * BM + row) * 4; float mt[4], m2[4]; float ms = 0.f;
#pragma unroll
            for (int t = 0; t < 4; ++t) { if (t < ntn) { const unsigned long long w = __hip_atomic_load(slot + t, __ATOMIC_RELAXED, __HIP_MEMORY_SCOPE_AGENT); mt[t] = __uint_as_float((unsigned)w); m2[t] = __uint_as_float((unsigned)(w >> 32)); } else { mt[t] = 0.f; m2[t] = 0.f; } ms += mt[t]; }
            const float mean = ms / (float)ntn; float q = 0.f;
#pragma unroll
            for (int t = 0; t < 4; ++t) if (t < ntn) { const float dm = mt[t] - mean; q += m2[t] + 256.0f * dm * dm; }
            S[row] = (f32x2v){mean, 1.0f / sqrtf(q / (256.0f * (float)ntn) + eps)};
        }
        asm volatile("s_waitcnt lgkmcnt(0)" ::: "memory"); __builtin_amdgcn_s_barrier(); asm volatile("" ::: "memory");
        return bad;
    }
};
struct EpiLnRes {
    static constexpr bool PERM = false, AFTER_DRAIN = true;
    const float* base; float* out; int ldc; const float* bias; PanelStats st; unsigned poison;
    __device__ __forceinline__ void fused(f32x4 (&acc)[2][2][4][2], const Unit& u, int wr, int wc, int fr, int fq, PG8_LAS unsigned char* lds, int wid, int lane) const {
        typedef float f32x2v __attribute__((ext_vector_type(2)));
        const PG8_LAS f32x2v* S = (const PG8_LAS f32x2v*)(lds + 8192);
        const int col0 = u.pn * BM + wc * 32 + 4 * fq;
#pragma unroll
        for (int bj = 0; bj < 2; ++bj)
#pragma unroll
            for (int n = 0; n < 2; ++n) { const f32x4 bv = bias ? *(const f32x4*)(bias + col0 + bj * HALF + n * 16) : (f32x4){0.f, 0.f, 0.f, 0.f};
#pragma unroll
                for (int ai = 0; ai < 2; ++ai)
#pragma unroll
                    for (int m = 0; m < 4; ++m) acc[ai][bj][m][n] += bv; }
        f32x4 pre[4][2][2];
#pragma unroll
        for (int m = 0; m < 4; ++m) { const size_t off = (size_t)(u.pm * BM + wr * 64 + m * 16 + fr) * ldc + col0;
#pragma unroll
            for (int bj = 0; bj < 2; ++bj)
#pragma unroll
                for (int n = 0; n < 2; ++n) pre[m][bj][n] = *(const f32x4*)(base + off + bj * HALF + n * 16); }
        const bool bad = st.run(acc, u, wr, wc, fr, fq, lds, wid, lane) || poison != 0u;
        const float qnan = __builtin_nanf("");
#pragma unroll
        for (int ai = 0; ai < 2; ++ai)
#pragma unroll
            for (int m = 0; m < 4; ++m) { const int r = ai * HALF + wr * 64 + m * 16 + fr; const f32x2v sr = S[r]; const size_t off = (size_t)(u.pm * BM + r) * ldc + col0;
#pragma unroll
                for (int bj = 0; bj < 2; ++bj)
#pragma unroll
                    for (int n = 0; n < 2; ++n) { const f32x4 bs = ai == 0 ? pre[m][bj][n] : *(const f32x4*)(base + off + bj * HALF + n * 16); f32x4 o = bs + (acc[ai][bj][m][n] - sr.x) * sr.y;
                        if (bad) o = (f32x4){qnan, qnan, qnan, qnan}; *(f32x4*)(out + off + bj * HALF + n * 16) = o; }
                if (m & 1) asm volatile("" ::: "memory"); }
    }
};
struct EpiLnResLn {
    static constexpr bool PERM = false, AFTER_DRAIN = true;
    const float* base; float* out; bf16_t* xn; int ldc; const float* bias; PanelStats st1, st2; unsigned poison;
    __device__ __forceinline__ void fused(f32x4 (&acc)[2][2][4][2], const Unit& u, int wr, int wc, int fr, int fq, PG8_LAS unsigned char* lds, int wid, int lane) const {
        typedef float f32x2v __attribute__((ext_vector_type(2))); typedef unsigned u32x2v __attribute__((ext_vector_type(2)));
        const PG8_LAS f32x2v* S = (const PG8_LAS f32x2v*)(lds + 8192);
        const int col0 = u.pn * BM + wc * 32 + 4 * fq;
#pragma unroll
        for (int bj = 0; bj < 2; ++bj)
#pragma unroll
            for (int n = 0; n < 2; ++n) { const f32x4 bv = bias ? *(const f32x4*)(bias + col0 + bj * HALF + n * 16) : (f32x4){0.f, 0.f, 0.f, 0.f};
#pragma unroll
                for (int ai = 0; ai < 2; ++ai)
#pragma unroll
                    for (int m = 0; m < 4; ++m) acc[ai][bj][m][n] += bv; }
        bool bad = st1.run(acc, u, wr, wc, fr, fq, lds, wid, lane) || poison != 0u;
        const float qnan = __builtin_nanf("");
#pragma unroll
        for (int ai = 0; ai < 2; ++ai)
#pragma unroll
            for (int m = 0; m < 4; ++m) { const int r = ai * HALF + wr * 64 + m * 16 + fr; const f32x2v sr = S[r]; const size_t off = (size_t)(u.pm * BM + r) * ldc + col0;
#pragma unroll
                for (int bj = 0; bj < 2; ++bj)
#pragma unroll
                    for (int n = 0; n < 2; ++n) { const f32x4 bs = *(const f32x4*)(base + off + bj * HALF + n * 16); acc[ai][bj][m][n] = bs + (acc[ai][bj][m][n] - sr.x) * sr.y; }
                asm volatile("" : "+v"(acc[ai][0][m][0]), "+v"(acc[ai][0][m][1]), "+v"(acc[ai][1][m][0]), "+v"(acc[ai][1][m][1]));
                if (m & 1) asm volatile("" ::: "memory"); }
        const bool bad1 = bad;
        bad = st2.run(acc, u, wr, wc, fr, fq, lds, wid, lane) || bad;
#pragma unroll
        for (int ai = 0; ai < 2; ++ai)
#pragma unroll
            for (int m = 0; m < 4; ++m) { const int r = ai * HALF + wr * 64 + m * 16 + fr; const f32x2v sr = S[r]; const size_t off = (size_t)(u.pm * BM + r) * ldc + col0;
#pragma unroll
                for (int bj = 0; bj < 2; ++bj)
#pragma unroll
                    for (int n = 0; n < 2; ++n) { const f32x4 x1 = acc[ai][bj][m][n]; *(f32x4*)(out + off + bj * HALF + n * 16) = bad1 ? (f32x4){qnan, qnan, qnan, qnan} : x1;
                        const f32x4 o = (x1 - sr.x) * sr.y; u32x2v w; w.x = cvt_pk_bf16(o[0], o[1]); w.y = cvt_pk_bf16(o[2], o[3]);
                        if (bad) { w.x = 0x7fc07fc0u; w.y = 0x7fc07fc0u; } *(u32x2v*)(xn + off + bj * HALF + n * 16) = w; }
                asm volatile("" ::: "memory"); }
    }
};

template <class Epi, class Sched, bool ALIGN_EPI = false, bool SP2 = false>
__device__ __forceinline__ void gemm_phase(PG8_LAS unsigned char* lds, const Gemm g, const Sched& S, const Epi& E) {
    const int tid = otid(), wid = __builtin_amdgcn_readfirstlane(tid >> 6), lane = tid & 63, wr = wid >> 2, wc = wid & 3, fr = lane & 15, fq = lane >> 4;
    const int K = g.K, nt = K / BK;
    unsigned voffA[2], voffB[2];
#pragma unroll
    for (int i = 0; i < 2; ++i) { int R, C; stage_rc(tid * 16 + i * 8192, R, C); const int Rb = Epi::PERM ? ((R & ~31) + perm32(R & 31)) : R;
        voffA[i] = (unsigned)(R * K + C) * 2u; voffB[i] = (unsigned)(Rb * K + C) * 2u; }
    const size_t kstep = (size_t)(BK * 2);
    const size_t hstep = (size_t)HALF * K * 2;
    const size_t tstep = 2 * hstep;
    const unsigned ldsw = (unsigned)wid * 1024u;
    const int aoff = lds_byte(wr * 64 + fr, fq * 8), boff = lds_byte(wc * 32 + fr, fq * 8);
#define PG8_SA(b, h) (((b) * 2 + (h)) * HTB)
#define PG8_SB(b, h) ((4 + (b) * 2 + (h)) * HTB)
#define PG8_STAGE(bufoff, gbase, voff) do { _Pragma("unroll") for (int _i = 0; _i < 2; ++_i) \
        __builtin_amdgcn_global_load_lds((const unsigned*)((const char*)(gbase) + (voff)[_i]), (PG8_LAS unsigned*)(lds + (bufoff) + ldsw + _i * 8192), 16, 0, 0); } while (0)
#define PG8_LDA(dst, b, h) do { _Pragma("unroll") for (int m = 0; m < 4; ++m) _Pragma("unroll") for (int k = 0; k < 2; ++k) dst[m][k] = *(const PG8_LAS bf16x8*)(lds + PG8_SA(b, h) + aoff + m * 2048 + k * 1024); } while (0)
#define PG8_LDB(dst, b, h) do { _Pragma("unroll") for (int n = 0; n < 2; ++n) _Pragma("unroll") for (int k = 0; k < 2; ++k) dst[n][k] = *(const PG8_LAS bf16x8*)(lds + PG8_SB(b, h) + boff + n * 2048 + k * 1024); } while (0)
#define PG8_MMA(ai, bj, At, Bt) do { __builtin_amdgcn_s_setprio(1); _Pragma("unroll") for (int m = 0; m < 4; ++m) _Pragma("unroll") for (int n = 0; n < 2; ++n) _Pragma("unroll") for (int k = 0; k < 2; ++k) \
        acc[ai][bj][m][n] = __builtin_amdgcn_mfma_f32_16x16x32_bf16(Bt[n][k], At[m][k], acc[ai][bj][m][n], 0, 0, 0); __builtin_amdgcn_s_setprio(0); } while (0)
#define PG8_WAIT_V(n) asm volatile("s_waitcnt vmcnt(" #n ")" ::: "memory")
#define PG8_WAIT_L(n) asm volatile("s_waitcnt lgkmcnt(" #n ")" ::: "memory")
#define PG8_BAR __builtin_amdgcn_s_barrier()
#define PG8_SCHED __builtin_amdgcn_sched_barrier(0)
    Unit cur, nxt; int ui = 0;
    if (!S.next(0, cur)) return;
    f32x4 acc[2][2][4][2];
#pragma unroll
    for (int a = 0; a < 2; ++a)
#pragma unroll
        for (int b = 0; b < 2; ++b)
#pragma unroll
            for (int m = 0; m < 4; ++m)
#pragma unroll
                for (int n = 0; n < 2; ++n) acc[a][b][m][n] = (f32x4){0.f, 0.f, 0.f, 0.f};
    bf16x8 At[4][2], B0[2][2], B1[2][2];
    const char* cA = (const char*)g.A + (size_t)cur.pm * tstep; const char* cB = (const char*)g.Bt + (size_t)cur.pn * tstep;
    S.a_ready(cur);
    if constexpr (SP2) {
        PG8_STAGE(PG8_SB(0, 0), cB, voffB); PG8_STAGE(PG8_SB(0, 1), cB + hstep, voffB); PG8_STAGE(PG8_SA(0, 0), cA, voffA); PG8_STAGE(PG8_SA(0, 1), cA + hstep, voffA);
        if (wr == 1) PG8_BAR;
        PG8_WAIT_V(2); PG8_BAR;
        PG8_STAGE(PG8_SB(1, 0), cB + kstep, voffB); PG8_STAGE(PG8_SA(1, 0), cA + kstep, voffA); PG8_STAGE(PG8_SB(1, 1), cB + hstep + kstep, voffB);
        PG8_WAIT_V(6); PG8_BAR;
    } else {
        PG8_STAGE(PG8_SB(0, 0), cB, voffB); PG8_STAGE(PG8_SA(0, 0), cA, voffA); PG8_STAGE(PG8_SB(0, 1), cB + hstep, voffB); PG8_STAGE(PG8_SA(0, 1), cA + hstep, voffA);
        if (wr == 1) PG8_BAR;
        PG8_WAIT_V(4); PG8_BAR;
        PG8_STAGE(PG8_SB(1, 0), cB + kstep, voffB); PG8_STAGE(PG8_SA(1, 0), cA + kstep, voffA); PG8_STAGE(PG8_SB(1, 1), cB + hstep + kstep, voffB);
        PG8_WAIT_V(6); PG8_BAR;
    }
    for (;;) {
        const bool has_next = S.next(ui + 1, nxt);
        const char* nA = has_next ? (const char*)g.A + (size_t)nxt.pm * tstep : cA; const char* nB = has_next ? (const char*)g.Bt + (size_t)nxt.pn * tstep : cB;
        for (int t = 0; t < nt; t += 2) {
            const bool last = (t == nt - 2);
            const char* a1 = cA + (size_t)(t + 1) * kstep;
            const char* a2 = last ? nA : cA + (size_t)(t + 2) * kstep; const char* b2 = last ? nB : cB + (size_t)(t + 2) * kstep;
            const char* a3 = a2 + kstep; const char* b3 = b2 + kstep;
            if (last && has_next) S.a_ready(nxt);
            if constexpr (SP2) {
            PG8_LDB(B0, 0, 0); PG8_LDB(B1, 0, 1); PG8_SCHED; PG8_LDA(At, 0, 0); PG8_STAGE(PG8_SA(1, 1), a1 + hstep, voffA);
            PG8_WAIT_V(8); PG8_WAIT_L(0); PG8_BAR; PG8_MMA(0, 0, At, B0); PG8_MMA(0, 1, At, B1); PG8_BAR; PG8_SCHED;
            PG8_LDA(At, 0, 1); PG8_STAGE(PG8_SB(0, 0), b2, voffB); PG8_STAGE(PG8_SB(0, 1), b2 + hstep, voffB); PG8_STAGE(PG8_SA(0, 0), a2, voffA);
            PG8_WAIT_V(8); PG8_WAIT_L(0); PG8_BAR; PG8_MMA(1, 0, At, B0); PG8_MMA(1, 1, At, B1); PG8_BAR; PG8_SCHED;
            PG8_LDB(B0, 1, 0); PG8_LDB(B1, 1, 1); PG8_SCHED; PG8_LDA(At, 1, 0); PG8_STAGE(PG8_SA(0, 1), a2 + hstep, voffA);
            PG8_WAIT_V(8); PG8_WAIT_L(0); PG8_BAR; PG8_MMA(0, 0, At, B0); PG8_MMA(0, 1, At, B1); PG8_BAR; PG8_SCHED;
            PG8_LDA(At, 1, 1); PG8_STAGE(PG8_SB(1, 0), b3, voffB); PG8_STAGE(PG8_SB(1, 1), b3 + hstep, voffB); PG8_STAGE(PG8_SA(1, 0), a3, voffA);
            PG8_WAIT_V(8); PG8_WAIT_L(0); PG8_BAR; PG8_MMA(1, 0, At, B0); PG8_MMA(1, 1, At, B1); PG8_BAR; PG8_SCHED;
            } else {
            PG8_LDB(B0, 0, 0); PG8_SCHED; PG8_LDA(At, 0, 0); PG8_STAGE(PG8_SA(1, 1), a1 + hstep, voffA);
            PG8_WAIT_L(8); PG8_BAR; PG8_WAIT_L(0); PG8_MMA(0, 0, At, B0); PG8_BAR; PG8_SCHED;
            PG8_LDB(B1, 0, 1); PG8_STAGE(PG8_SB(0, 0), b2, voffB);
            PG8_BAR; PG8_WAIT_L(0); PG8_MMA(0, 1, At, B1); PG8_BAR;
            PG8_LDA(At, 0, 1); PG8_STAGE(PG8_SA(0, 0), a2, voffA);
            PG8_BAR; PG8_WAIT_L(0); PG8_MMA(1, 0, At, B0); PG8_BAR; PG8_SCHED;
            PG8_STAGE(PG8_SB(0, 1), b2 + hstep, voffB);
            PG8_WAIT_V(6); PG8_BAR; PG8_MMA(1, 1, At, B1); PG8_BAR;
            PG8_LDB(B0, 1, 0); PG8_SCHED; PG8_LDA(At, 1, 0); PG8_STAGE(PG8_SA(0, 1), a2 + hstep, voffA);
            PG8_WAIT_L(8); PG8_BAR; PG8_WAIT_L(0); PG8_MMA(0, 0, At, B0); PG8_BAR; PG8_SCHED;
            PG8_LDB(B1, 1, 1); PG8_STAGE(PG8_SB(1, 0), b3, voffB);
            PG8_BAR; PG8_WAIT_L(0); PG8_MMA(0, 1, At, B1); PG8_BAR;
            PG8_LDA(At, 1, 1); PG8_STAGE(PG8_SA(1, 0), a3, voffA);
            PG8_BAR; PG8_WAIT_L(0); PG8_MMA(1, 0, At, B0); PG8_BAR; PG8_SCHED;
            PG8_STAGE(PG8_SB(1, 1), b3 + hstep, voffB);
            PG8_WAIT_V(6); PG8_BAR; PG8_MMA(1, 1, At, B1); PG8_BAR;
            }
            if constexpr (Epi::MIDK) { if (E.is_boundary(t + 2)) E.mid(acc, cur, t + 2, wr, wc); }
        }
        if constexpr (ALIGN_EPI) { if (wr == 0) PG8_BAR; }
        if constexpr (!Epi::AFTER_DRAIN) { E(acc, cur, wr, wc, fr, fq); S.done(cur); }
        if (!has_next) break;
#pragma unroll
        for (int a = 0; a < 2; ++a)
#pragma unroll
            for (int b = 0; b < 2; ++b)
#pragma unroll
                for (int m = 0; m < 4; ++m)
#pragma unroll
                    for (int n = 0; n < 2; ++n) acc[a][b][m][n] = (f32x4){0.f, 0.f, 0.f, 0.f};
        cur = nxt; cA = nA; cB = nB; ++ui;
        if constexpr (ALIGN_EPI) { if (wr == 1) PG8_BAR; }
    }
    PG8_WAIT_V(0);
    if constexpr (!ALIGN_EPI) { if (wr == 0) PG8_BAR; }
    PG8_BAR;
    if constexpr (Epi::AFTER_DRAIN) { E.fused(acc, cur, wr, wc, fr, fq, lds, wid, lane); S.done(cur); }
#undef PG8_SA
#undef PG8_SB
#undef PG8_STAGE
#undef PG8_LDA
#undef PG8_LDB
#undef PG8_MMA
#undef PG8_WAIT_V
#undef PG8_WAIT_L
#undef PG8_BAR
#undef PG8_SCHED
}
}
#define GAS __attribute__((address_space(1)))
#define LAS __attribute__((address_space(3)))
typedef unsigned short bf16;
typedef unsigned v4u __attribute__((ext_vector_type(4)));
typedef unsigned v2u __attribute__((ext_vector_type(2)));
typedef float f32x4 __attribute__((ext_vector_type(4)));
typedef float f32x16 __attribute__((ext_vector_type(16)));
typedef short bf16x8 __attribute__((ext_vector_type(8)));
typedef GAS unsigned gu32;
typedef GAS unsigned long long gu64;
#define RLX_AGENT __ATOMIC_RELAXED, __HIP_MEMORY_SCOPE_AGENT
#define LDS_WAIT() asm volatile("s_waitcnt lgkmcnt(0)" ::: "memory")
#define VM_WAIT() asm volatile("s_waitcnt vmcnt(0)" ::: "memory")
typedef float f32x2_cv __attribute__((ext_vector_type(2))); typedef __bf16 bf16x2_cv __attribute__((ext_vector_type(2)));
__device__ __forceinline__ unsigned pk2(float lo, float hi) { const f32x2_cv v = {lo, hi}; const bf16x2_cv b = __builtin_convertvector(v, bf16x2_cv); return __builtin_bit_cast(unsigned, b); }
__device__ __forceinline__ unsigned f2bf(float f) { return pk2(f, 0.f) & 0xffffu; }
__device__ __forceinline__ float bf2f(unsigned short v) { return __builtin_bit_cast(float, (unsigned)v << 16); }
__device__ __forceinline__ float bflo(unsigned w) { return __builtin_bit_cast(float, w << 16); }
__device__ __forceinline__ float bfhi(unsigned w) { return __builtin_bit_cast(float, w & 0xffff0000u); }
__device__ __forceinline__ float sx(float v, int m) { const int a = ((otid() & 63) ^ m) << 2; return __builtin_bit_cast(float, __builtin_amdgcn_ds_bpermute(a, __builtin_bit_cast(int, v))); }
__device__ __forceinline__ float sl(float v, int srcl) { int a = srcl << 2; return __builtin_bit_cast(float, __builtin_amdgcn_ds_bpermute(a, __builtin_bit_cast(int, v))); }
__device__ __forceinline__ float sup(float v, int o) { const int l = otid() & 63; const int a = (l >= o ? l - o : l) << 2; return __builtin_bit_cast(float, __builtin_amdgcn_ds_bpermute(a, __builtin_bit_cast(int, v))); }
#define XB_TMO      128
#define XB_XCNT(j)  (256  + 64 * (j))
#define XB_XSUB(j)  (1280 + 64 * (j))
#define XB_XGEN(j)  (2304 + 64 * (j))
#define XB_TOP      3328
#define XB_TOPGEN   3392
#define XCD_BAR_WORDS 3456
#define XB_SPIN_CAP (1u << 18)

__device__ __forceinline__ unsigned xb_ld(unsigned* p)              { return __hip_atomic_load(p, __ATOMIC_RELAXED, __HIP_MEMORY_SCOPE_AGENT); }
__device__ __forceinline__ unsigned xb_add(unsigned* p, unsigned v) { return __hip_atomic_fetch_add(p, v, __ATOMIC_RELAXED, __HIP_MEMORY_SCOPE_AGENT); }
__device__ __forceinline__ unsigned xb_xcc_id() { return (unsigned)__builtin_amdgcn_s_getreg((3 << 11) | 20) & 0xFu; }
#define XB_SPIN(cond, bar) do { unsigned _sp = 0; while (cond) { __builtin_amdgcn_s_sleep(1); \
    if ((++_sp & 255u) == 0u) { if (xb_ld(&(bar)[XB_TMO])) break; if (_sp > XB_SPIN_CAP) { atomicAdd(&(bar)[XB_TMO], 1u); break; } } } } while (0)

struct XcdBarrier {
    unsigned* bar; unsigned x;
    volatile LAS unsigned* st;
};

__device__ __forceinline__ XcdBarrier xcd_barrier_post(unsigned* bar, volatile LAS unsigned* st) {
    XcdBarrier b; b.bar = bar; b.x = xb_xcc_id(); b.st = st;
    if (threadIdx.x == 0) (void)xb_add(&bar[XB_XCNT(b.x)], 1u);
    return b;
}
__device__ __forceinline__ void xcd_barrier_complete(unsigned* bar, unsigned x, unsigned& nloc, unsigned& nx) {
    const unsigned G = gridDim.x * gridDim.y * gridDim.z;
    unsigned sum, cnt, mine, sp = 0u;
    for (;;) {
        sum = 0u; cnt = 0u; mine = 0u;
#pragma unroll
        for (unsigned j = 0; j < 16; ++j) { const unsigned c = xb_ld(&bar[XB_XCNT(j)]); sum += c; cnt += (c > 0u) ? 1u : 0u; mine = (j == x) ? c : mine; }
        if (sum == G) break;
        __builtin_amdgcn_s_sleep(1);
        if ((++sp & 255u) == 0u) { if (xb_ld(&bar[XB_TMO])) break; if (sp > XB_SPIN_CAP) { atomicAdd(&bar[XB_TMO], 1u); break; } }
    }
    nloc = mine > 0u ? mine : 1u; nx = cnt > 0u ? cnt : 1u;
}

__device__ __forceinline__ void xcd_barrier(const XcdBarrier& b) {
    asm volatile("s_waitcnt vmcnt(0)" ::: "memory");
    __syncthreads();
    if (threadIdx.x == 0) {
        unsigned* bar = b.bar;
        __builtin_amdgcn_s_waitcnt(0);
        unsigned nloc = b.st[0], nx = b.st[1];
        if (nloc == 0u) { xcd_barrier_complete(bar, b.x, nloc, nx); b.st[0] = nloc; b.st[1] = nx; }
        const unsigned old = xb_add(&bar[XB_XSUB(b.x)], 1u);
        const unsigned gen = old / nloc;
        if (old + 1u == (gen + 1u) * nloc) {
            __builtin_amdgcn_fence(__ATOMIC_RELEASE, "agent");
            asm volatile("s_waitcnt vmcnt(0)" ::: "memory");
            const unsigned og = xb_add(&bar[XB_TOP], 1u);
            const unsigned tg = og / nx;
            if (og + 1u == (tg + 1u) * nx) xb_add(&bar[XB_TOPGEN], 1u);
            else XB_SPIN(xb_ld(&bar[XB_TOPGEN]) == tg, bar);
            __builtin_amdgcn_fence(__ATOMIC_ACQUIRE, "agent");
            xb_add(&bar[XB_XGEN(b.x)], 1u);
            asm volatile("s_waitcnt vmcnt(0)" ::: "memory");
        } else {
            XB_SPIN(xb_ld(&bar[XB_XGEN(b.x)]) == gen, bar);
            __builtin_amdgcn_fence(__ATOMIC_ACQUIRE, "agent");
            asm volatile("s_waitcnt vmcnt(0)" ::: "memory");
        }
    }
    __syncthreads();
}
constexpr int D = 1024, NB = 4, SEQ = 8192, DEPTH = 2;
constexpr int NBP = 2, M = NBP * SEQ, NPASS = NB / NBP;
constexpr int INW = 5416, PROJW = 2560, GATEW = 3072, WIN_N = PROJW + GATEW;
constexpr int O_U = 0, O_Z = 384, O_XBC = 896, O_DT = 1920, O_CQ = 1928, O_CKV = 2184, O_KR = 2312, O_G = 2344;
constexpr int S5W = 384, S5G = 24, S5P = 64;
constexpr int M2I = 512, M2H = 8, M2P = 64, M2N = 128, M2C = 1024;
constexpr int QR = 256, KVR = 128, AH = 8;
constexpr int PK = 128, PT = 16, PE = 16384;
constexpr float ALPHA = 1.41421356237f;
constexpr int NWAVES = 8, NTHR = 512;

constexpr size_t MiB = 1u << 20;
constexpr size_t WS_CTL = 0, CTL_ZERO_BYTES = 1 * MiB;
constexpr size_t WS_W = 1 * MiB, WL_BYTES = 22 * MiB;
constexpr size_t WO_WIN = 0, WO_WQ = 11 * MiB, WO_WOUT = 15 * MiB, WO_BRA = 17 * MiB, WO_BRB = 17 * MiB + 768 * 1024, WO_BRC = 18 * MiB + 768 * 1024,
                 WO_GLU = 19 * MiB + 768 * 1024, WO_UQ = 20 * MiB + 128 * 1024, WO_KN = 20 * MiB + 512 * 1024, WO_VW = 20 * MiB + 768 * 1024, WO_SK = 21 * MiB,
                 WO_S5BF = 21 * MiB + 64 * 1024, WO_S5CF = 21 * MiB + 256 * 1024, WO_S5AB = 21 * MiB + 352 * 1024;
constexpr size_t WS_WEND = WS_W + DEPTH * WL_BYTES;
constexpr size_t WS_TABU = 45 * MiB, WS_TABV = 77 * MiB;
constexpr size_t WS_SU = 256 * 1024, WS_SV = 384 * 1024;
constexpr size_t WS_HB = 109 * MiB;
constexpr size_t WS_PROJ = 173 * MiB;
constexpr size_t WS_GATES = 253 * MiB;
constexpr int YCW = 1408, YC_A = 0, YC_B = 384, YC_C = 896;
constexpr size_t WS_YA = 349 * MiB;
constexpr size_t WS_TMP = 393 * MiB;
constexpr size_t WS_Z = WS_TMP, WS_XT = WS_TMP + 12 * MiB, WS_BN = WS_TMP + 28 * MiB, WS_BT = WS_TMP + 36 * MiB, WS_CN = WS_TMP + 44 * MiB, WS_ST = WS_TMP + 52 * MiB, WS_PREV = WS_TMP + 84 * MiB,
                 WS_CQN = WS_TMP + 100 * MiB, WS_CKVN = WS_TMP + 108 * MiB, WS_ES = WS_TMP + 116 * MiB;
constexpr size_t WS_END = 512 * MiB;
constexpr size_t WS_MERGED = WS_PROJ, WS_TS = WS_PROJ + 32 * MiB, WS_TI = WS_PROJ + 48 * MiB, WS_IDX = WS_PROJ, WS_GW = WS_PROJ + 8 * MiB;
constexpr size_t WS_PQ = WS_GATES;
constexpr int VT_P = M + 64;
constexpr size_t OS_Q = 0, OS_KN = 24 * MiB, OS_VT = 40 * MiB, OS_KR = 57 * MiB;
constexpr size_t OS_SDT = 58 * MiB, OS_SAC = 59 * MiB, OS_SW = 60 * MiB, OS_CDEC = 61 * MiB;
constexpr size_t OS_F32 = 0;

struct Params {
    const float* in[36];
    float* out; unsigned char* ws;
};

__device__ __forceinline__ float fexp(float x) { return __builtin_amdgcn_exp2f(x * 1.4426950408889634f); }
__device__ __forceinline__ float flog(float x) { return __builtin_amdgcn_logf(x) * 0.6931471805599453f; }
__device__ __forceinline__ void fsincos(float ang, float& sn, float& cs) { const float rev = __builtin_amdgcn_fractf(ang * 0.15915494309189535f); sn = __builtin_amdgcn_sinf(rev); cs = __builtin_amdgcn_cosf(rev); }
__device__ __forceinline__ f32x4 zero4() { f32x4 z = {0.f, 0.f, 0.f, 0.f}; asm volatile("" : "+v"(z)); return z; }
__device__ __forceinline__ float sigm_f(float x) { return __builtin_amdgcn_rcpf(1.f + __builtin_amdgcn_exp2f(-1.4426950408889634f * x)); }
__device__ __forceinline__ float gelu_t(float x) { const float u = 0.7978845608028654f * (x + 0.044715f * x * x * x); const float e = __builtin_amdgcn_exp2f(2.885390081777927f * u); return x * (1.f - __builtin_amdgcn_rcpf(1.f + e)); }
typedef _Float16 h2_t __attribute__((ext_vector_type(2)));
typedef __bf16 b2_t __attribute__((ext_vector_type(2)));
__device__ __forceinline__ unsigned pkh2(float lo, float hi) { const h2_t h = {(_Float16)lo, (_Float16)hi}; return __builtin_bit_cast(unsigned, h); }
typedef __bf16 b8_t __attribute__((ext_vector_type(8)));
__device__ __forceinline__ float dot8bf(v4u a, v4u b, float c) {
    const b8_t x = __builtin_bit_cast(b8_t, a), y = __builtin_bit_cast(b8_t, b);
    c = __builtin_amdgcn_fdot2_f32_bf16(__builtin_shufflevector(x, x, 0, 1), __builtin_shufflevector(y, y, 0, 1), c, false);
    c = __builtin_amdgcn_fdot2_f32_bf16(__builtin_shufflevector(x, x, 2, 3), __builtin_shufflevector(y, y, 2, 3), c, false);
    c = __builtin_amdgcn_fdot2_f32_bf16(__builtin_shufflevector(x, x, 4, 5), __builtin_shufflevector(y, y, 4, 5), c, false);
    c = __builtin_amdgcn_fdot2_f32_bf16(__builtin_shufflevector(x, x, 6, 7), __builtin_shufflevector(y, y, 6, 7), c, false);
    return c; }
__device__ __forceinline__ unsigned fbits(float f) { return __builtin_bit_cast(unsigned, f); }
__device__ __forceinline__ float bitsf(unsigned u) { return __builtin_bit_cast(float, u); }
__device__ __forceinline__ float hlo(unsigned w) { const h2_t h = __builtin_bit_cast(h2_t, w); return (float)h.x; }
__device__ __forceinline__ float hhi(unsigned w) { const h2_t h = __builtin_bit_cast(h2_t, w); return (float)h.y; }
__device__ __forceinline__ float wsum(float v) {
#pragma unroll
    for (int o = 32; o > 0; o >>= 1) v += sx(v, o);
    return v; }

namespace pg8 {
struct EpiProj {
    static constexpr bool PERM = true, AFTER_DRAIN = false, MIDK = false;
    bf16_t* proj; bf16_t* gates;
    __device__ __forceinline__ void operator()(const f32x4 (&acc)[2][2][4][2], const Unit& u, int wr, int wc, int fr_, int fq_) const {
        const int tid_ = otid(), lane_ = tid_ & 63, fr = lane_ & 15, fq = lane_ >> 4;
        const int row0 = u.pm * BM + wr * 64 + fr; const bool isg = u.pn >= 10;
        const int col0 = u.pn * BM + wc * 32 + 8 * fq;
        u32x4* gt = (u32x4*)gates + ((size_t)(u.pm * 12 + (u.pn - 10)) * 16) * 512 + tid_;
#pragma unroll
        for (int ai = 0; ai < 2; ++ai)
#pragma unroll
            for (int m = 0; m < 4; ++m) { bf16_t* rowp = proj + (size_t)(row0 + ai * HALF + m * 16) * 2560 + col0;
#pragma unroll
                for (int bj = 0; bj < 2; ++bj) { f32x4 v0 = acc[ai][bj][m][0], v1 = acc[ai][bj][m][1];
                    if (isg) {
#pragma unroll
                        for (int e = 0; e < 4; ++e) { v0[e] = sigm_f(v0[e]); v1[e] = sigm_f(v1[e]); } }
                    u32x4 w; w.x = cvt_pk_bf16(v0[0], v0[1]); w.y = cvt_pk_bf16(v0[2], v0[3]); w.z = cvt_pk_bf16(v1[0], v1[1]); w.w = cvt_pk_bf16(v1[2], v1[3]);
                    if (isg) gt[((ai * 4 + m) * 2 + bj) * 512] = w; else *(u32x4*)(rowp + bj * HALF) = w; } }
    }
};
struct EpiGlu {
    static constexpr bool PERM = true, AFTER_DRAIN = false, MIDK = false;
    const bf16_t* z; bf16_t* ya;
    __device__ __forceinline__ void operator()(const f32x4 (&acc)[2][2][4][2], const Unit& u, int wr, int wc, int fr_, int fq_) const {
        const int lane_ = otid() & 63, fr = lane_ & 15, fq = lane_ >> 4;
        const int row0 = u.pm * BM + wr * 64 + fr; const int col0 = u.pn * BM + wc * 32 + 8 * fq;
#pragma unroll
        for (int ai = 0; ai < 2; ++ai)
#pragma unroll
            for (int m = 0; m < 4; ++m) { const size_t ro = (size_t)(row0 + ai * HALF + m * 16) * 384, ry = (size_t)(row0 + ai * HALF + m * 16) * 1408;
#pragma unroll
                for (int bj = 0; bj < 2; ++bj) { const int c = col0 + bj * HALF; if (c < 384) {
                    const u32x4 zz = *(const u32x4*)(z + ro + c); const f32x4 v0 = acc[ai][bj][m][0], v1 = acc[ai][bj][m][1];
                    float zf[8] = {__builtin_bit_cast(float, zz.x << 16), __builtin_bit_cast(float, zz.x & 0xffff0000u), __builtin_bit_cast(float, zz.y << 16), __builtin_bit_cast(float, zz.y & 0xffff0000u),
                                   __builtin_bit_cast(float, zz.z << 16), __builtin_bit_cast(float, zz.z & 0xffff0000u), __builtin_bit_cast(float, zz.w << 16), __builtin_bit_cast(float, zz.w & 0xffff0000u)};
                    u32x4 w; w.x = cvt_pk_bf16(zf[0] * sigm_f(v0[0]), zf[1] * sigm_f(v0[1])); w.y = cvt_pk_bf16(zf[2] * sigm_f(v0[2]), zf[3] * sigm_f(v0[3]));
                    w.z = cvt_pk_bf16(zf[4] * sigm_f(v1[0]), zf[5] * sigm_f(v1[1])); w.w = cvt_pk_bf16(zf[6] * sigm_f(v1[2]), zf[7] * sigm_f(v1[3]));
                    *(u32x4*)(ya + ry + c) = w; } }
                asm volatile("" ::: "memory"); }
    }
};
struct EpiMergeCat {
    static constexpr bool PERM = true, AFTER_DRAIN = false, MIDK = true;
    const bf16_t* gates; bf16_t* merged;
    __device__ __forceinline__ bool is_boundary(int kt) const { return kt == 6 || kt == 14; }
    __device__ __forceinline__ const u32x4* gtile(const Unit& u, int gi, int tid_) const { return (const u32x4*)gates + ((size_t)(u.pm * 12 + gi * 4 + u.pn) * 16) * 512 + tid_; }
    static __device__ __forceinline__ float glo(unsigned w) { return fmaxf(__builtin_bit_cast(float, w << 16), 1e-20f); }
    static __device__ __forceinline__ float ghi(unsigned w) { return fmaxf(__builtin_bit_cast(float, w & 0xffff0000u), 1e-20f); }
    __device__ __forceinline__ void mid(f32x4 (&acc)[2][2][4][2], const Unit& u, int kt, int wr, int wc) const {
        const int tid_ = otid(); const int gi = kt == 6 ? 0 : 1;
        const u32x4* gx = gtile(u, gi, tid_); const u32x4* gy = gtile(u, gi + 1, tid_);
#pragma unroll
        for (int ai = 0; ai < 2; ++ai)
#pragma unroll
            for (int m = 0; m < 4; ++m) {
#pragma unroll
                for (int bj = 0; bj < 2; ++bj) { const int slot = ((ai * 4 + m) * 2 + bj) * 512; const u32x4 x = gx[slot], y = gy[slot];
                    f32x4 v0 = acc[ai][bj][m][0], v1 = acc[ai][bj][m][1];
                    v0[0] *= glo(x.x) * __builtin_amdgcn_rcpf(glo(y.x)); v0[1] *= ghi(x.x) * __builtin_amdgcn_rcpf(ghi(y.x)); v0[2] *= glo(x.y) * __builtin_amdgcn_rcpf(glo(y.y)); v0[3] *= ghi(x.y) * __builtin_amdgcn_rcpf(ghi(y.y));
                    v1[0] *= glo(x.z) * __builtin_amdgcn_rcpf(glo(y.z)); v1[1] *= ghi(x.z) * __builtin_amdgcn_rcpf(ghi(y.z)); v1[2] *= glo(x.w) * __builtin_amdgcn_rcpf(glo(y.w)); v1[3] *= ghi(x.w) * __builtin_amdgcn_rcpf(ghi(y.w));
                    acc[ai][bj][m][0] = v0; acc[ai][bj][m][1] = v1; }
                asm volatile("" ::: "memory"); }
    }
    __device__ __forceinline__ void operator()(const f32x4 (&acc)[2][2][4][2], const Unit& u, int wr, int wc, int fr_, int fq_) const {
        const int tid_ = otid(), lane_ = tid_ & 63, fr = lane_ & 15, fq = lane_ >> 4;
        const int row0 = u.pm * BM + wr * 64 + fr; const int col0 = u.pn * BM + wc * 32 + 8 * fq;
        const u32x4* gc = gtile(u, 2, tid_);
#pragma unroll
        for (int ai = 0; ai < 2; ++ai)
#pragma unroll
            for (int m = 0; m < 4; ++m) { bf16_t* rowp = merged + (size_t)(row0 + ai * HALF + m * 16) * 1024 + col0;
#pragma unroll
                for (int bj = 0; bj < 2; ++bj) { const u32x4 g = gc[((ai * 4 + m) * 2 + bj) * 512]; const f32x4 v0 = acc[ai][bj][m][0], v1 = acc[ai][bj][m][1];
                    u32x4 w; w.x = cvt_pk_bf16(v0[0] * glo(g.x), v0[1] * ghi(g.x)); w.y = cvt_pk_bf16(v0[2] * glo(g.y), v0[3] * ghi(g.y)); w.z = cvt_pk_bf16(v1[0] * glo(g.z), v1[1] * ghi(g.z)); w.w = cvt_pk_bf16(v1[2] * glo(g.w), v1[3] * ghi(g.w));
                    *(u32x4*)(rowp + bj * HALF) = w; }
                asm volatile("" ::: "memory"); }
    }
};
struct EpiF32 {
    static constexpr bool PERM = false, AFTER_DRAIN = false, MIDK = false;
    float* O; int ldc;
    __device__ __forceinline__ void operator()(const f32x4 (&acc)[2][2][4][2], const Unit& u, int wr, int wc, int fr_, int fq_) const {
        const int lane_ = otid() & 63, fr = lane_ & 15, fq = lane_ >> 4;
        const int row0 = u.pm * BM + wr * 64 + fr; const int col0 = u.pn * BM + wc * 32 + 4 * fq;
#pragma unroll
        for (int ai = 0; ai < 2; ++ai)
#pragma unroll
            for (int m = 0; m < 4; ++m) { float* rowp = O + (size_t)(row0 + ai * HALF + m * 16) * ldc + col0;
#pragma unroll
                for (int bj = 0; bj < 2; ++bj)
#pragma unroll
                    for (int n = 0; n < 2; ++n) *(f32x4*)(rowp + bj * HALF + 16 * n) = acc[ai][bj][m][n]; }
    }
};
}

struct Bufs {
    unsigned char* ws; unsigned char* os;
    __device__ __forceinline__ bf16* HB() const { unsigned o_ = (unsigned)WS_HB; asm volatile("" : "+v"(o_)); return (bf16*)(ws + (unsigned)__builtin_amdgcn_readfirstlane((int)o_)); }
    __device__ __forceinline__ bf16* PROJ() const { unsigned o_ = (unsigned)WS_PROJ; asm volatile("" : "+v"(o_)); return (bf16*)(ws + (unsigned)__builtin_amdgcn_readfirstlane((int)o_)); }
    __device__ __forceinline__ bf16* GATES() const { unsigned o_ = (unsigned)WS_GATES; asm volatile("" : "+v"(o_)); return (bf16*)(ws + (unsigned)__builtin_amdgcn_readfirstlane((int)o_)); }
    __device__ __forceinline__ bf16* YA() const { unsigned o_ = (unsigned)WS_YA; asm volatile("" : "+v"(o_)); return (bf16*)(ws + (unsigned)__builtin_amdgcn_readfirstlane((int)o_)); }
    __device__ __forceinline__ bf16* Z() const { unsigned o_ = (unsigned)WS_Z; asm volatile("" : "+v"(o_)); return (bf16*)(ws + (unsigned)__builtin_amdgcn_readfirstlane((int)o_)); }
    __device__ __forceinline__ bf16* XT() const { unsigned o_ = (unsigned)WS_XT; asm volatile("" : "+v"(o_)); return (bf16*)(ws + (unsigned)__builtin_amdgcn_readfirstlane((int)o_)); }
    __device__ __forceinline__ bf16* BN() const { unsigned o_ = (unsigned)WS_BN; asm volatile("" : "+v"(o_)); return (bf16*)(ws + (unsigned)__builtin_amdgcn_readfirstlane((int)o_)); }
    __device__ __forceinline__ bf16* BT() const { unsigned o_ = (unsigned)WS_BT; asm volatile("" : "+v"(o_)); return (bf16*)(ws + (unsigned)__builtin_amdgcn_readfirstlane((int)o_)); }
    __device__ __forceinline__ bf16* CN() const { unsigned o_ = (unsigned)WS_CN; asm volatile("" : "+v"(o_)); return (bf16*)(ws + (unsigned)__builtin_amdgcn_readfirstlane((int)o_)); }
    __device__ __forceinline__ bf16* PREV() const { unsigned o_ = (unsigned)WS_PREV; asm volatile("" : "+v"(o_)); return (bf16*)(ws + (unsigned)__builtin_amdgcn_readfirstlane((int)o_)); }
    __device__ __forceinline__ bf16* CQN() const { unsigned o_ = (unsigned)WS_CQN; asm volatile("" : "+v"(o_)); return (bf16*)(ws + (unsigned)__builtin_amdgcn_readfirstlane((int)o_)); }
    __device__ __forceinline__ bf16* CKVN() const { unsigned o_ = (unsigned)WS_CKVN; asm volatile("" : "+v"(o_)); return (bf16*)(ws + (unsigned)__builtin_amdgcn_readfirstlane((int)o_)); }
    __device__ __forceinline__ bf16* MERGED() const { unsigned o_ = (unsigned)WS_MERGED; asm volatile("" : "+v"(o_)); return (bf16*)(ws + (unsigned)__builtin_amdgcn_readfirstlane((int)o_)); }
    __device__ __forceinline__ bf16* PQ() const { unsigned o_ = (unsigned)WS_PQ; asm volatile("" : "+v"(o_)); return (bf16*)(ws + (unsigned)__builtin_amdgcn_readfirstlane((int)o_)); }
    __device__ __forceinline__ bf16* Q() const { unsigned o_ = (unsigned)OS_Q; asm volatile("" : "+v"(o_)); return (bf16*)(os + (unsigned)__builtin_amdgcn_readfirstlane((int)o_)); }
    __device__ __forceinline__ bf16* KN() const { unsigned o_ = (unsigned)OS_KN; asm volatile("" : "+v"(o_)); return (bf16*)(os + (unsigned)__builtin_amdgcn_readfirstlane((int)o_)); }
    __device__ __forceinline__ bf16* VT() const { unsigned o_ = (unsigned)OS_VT; asm volatile("" : "+v"(o_)); return (bf16*)(os + (unsigned)__builtin_amdgcn_readfirstlane((int)o_)); }
    __device__ __forceinline__ bf16* KR() const { unsigned o_ = (unsigned)OS_KR; asm volatile("" : "+v"(o_)); return (bf16*)(os + (unsigned)__builtin_amdgcn_readfirstlane((int)o_)); }
    __device__ __forceinline__ unsigned char* TABU() const { unsigned o_ = (unsigned)WS_TABU; asm volatile("" : "+v"(o_)); return ws + (unsigned)__builtin_amdgcn_readfirstlane((int)o_); }
    __device__ __forceinline__ unsigned char* TABV() const { unsigned o_ = (unsigned)WS_TABV; asm volatile("" : "+v"(o_)); return ws + (unsigned)__builtin_amdgcn_readfirstlane((int)o_); }
    __device__ __forceinline__ float* SU() const { unsigned o_ = (unsigned)WS_SU; asm volatile("" : "+v"(o_)); return (float*)(ws + (unsigned)__builtin_amdgcn_readfirstlane((int)o_)); }
    __device__ __forceinline__ float* SV() const { unsigned o_ = (unsigned)WS_SV; asm volatile("" : "+v"(o_)); return (float*)(ws + (unsigned)__builtin_amdgcn_readfirstlane((int)o_)); }
    __device__ __forceinline__ float* ST() const { unsigned o_ = (unsigned)WS_ST; asm volatile("" : "+v"(o_)); return (float*)(ws + (unsigned)__builtin_amdgcn_readfirstlane((int)o_)); }
    __device__ __forceinline__ float* TS() const { unsigned o_ = (unsigned)WS_TS; asm volatile("" : "+v"(o_)); return (float*)(ws + (unsigned)__builtin_amdgcn_readfirstlane((int)o_)); }
    __device__ __forceinline__ float* GW() const { unsigned o_ = (unsigned)WS_GW; asm volatile("" : "+v"(o_)); return (float*)(ws + (unsigned)__builtin_amdgcn_readfirstlane((int)o_)); }
    __device__ __forceinline__ float* ES() const { unsigned o_ = (unsigned)WS_ES; asm volatile("" : "+v"(o_)); return (float*)(ws + (unsigned)__builtin_amdgcn_readfirstlane((int)o_)); }
    __device__ __forceinline__ float* SDT() const { unsigned o_ = (unsigned)OS_SDT; asm volatile("" : "+v"(o_)); return (float*)(os + (unsigned)__builtin_amdgcn_readfirstlane((int)o_)); }
    __device__ __forceinline__ float* SAC() const { unsigned o_ = (unsigned)OS_SAC; asm volatile("" : "+v"(o_)); return (float*)(os + (unsigned)__builtin_amdgcn_readfirstlane((int)o_)); }
    __device__ __forceinline__ float* SW() const { unsigned o_ = (unsigned)OS_SW; asm volatile("" : "+v"(o_)); return (float*)(os + (unsigned)__builtin_amdgcn_readfirstlane((int)o_)); }
    __device__ __forceinline__ float* CDEC() const { unsigned o_ = (unsigned)OS_CDEC; asm volatile("" : "+v"(o_)); return (float*)(os + (unsigned)__builtin_amdgcn_readfirstlane((int)o_)); }
    __device__ __forceinline__ float* F32() const { unsigned o_ = (unsigned)OS_F32; asm volatile("" : "+v"(o_)); return (float*)(os + (unsigned)__builtin_amdgcn_readfirstlane((int)o_)); }
    __device__ __forceinline__ int* TI() const { unsigned o_ = (unsigned)WS_TI; asm volatile("" : "+v"(o_)); return (int*)(ws + (unsigned)__builtin_amdgcn_readfirstlane((int)o_)); }
    __device__ __forceinline__ int* IDX() const { unsigned o_ = (unsigned)WS_IDX; asm volatile("" : "+v"(o_)); return (int*)(ws + (unsigned)__builtin_amdgcn_readfirstlane((int)o_)); }
};
__device__ __forceinline__ Bufs make_bufs(const Params& p) { Bufs b; b.ws = p.ws; b.os = (unsigned char*)p.out + 64 * MiB; return b; }
__device__ __forceinline__ unsigned char* wl_ptr(const Params& p, int l) { unsigned o_ = (unsigned)(WS_W + (size_t)l * WL_BYTES); asm volatile("" : "+v"(o_)); return p.ws + (unsigned)__builtin_amdgcn_readfirstlane((int)o_); }

__device__ __forceinline__ void tr_item(const float* W, int ldw, int col0, int ncols, bf16* WT, int Kd, int row0, int koff, LAS float* scr, int item, int lane) {
    const int nblk = (ncols + 63) / 64, kb = item / nblk, nb = item % nblk, k0 = 64 * kb, n0 = 64 * nb;
    const int nn = n0 + lane; const bool cv = nn < ncols; const float* src = W + (size_t)k0 * ldw + col0 + nn;
#pragma unroll 16
    for (int i = 0; i < 64; ++i) scr[i * 65 + lane] = cv ? src[(size_t)i * ldw] : 0.f;
    LDS_WAIT(); asm volatile("" ::: "memory");
    const int c = lane & 7;
#pragma unroll
    for (int j = 0; j < 8; ++j) { const int n = (lane >> 3) + 8 * j; const LAS float* sp = scr + (8 * c) * 65 + n;
        v4u o; o.x = pk2(sp[0 * 65], sp[1 * 65]); o.y = pk2(sp[2 * 65], sp[3 * 65]); o.z = pk2(sp[4 * 65], sp[5 * 65]); o.w = pk2(sp[6 * 65], sp[7 * 65]);
        if (n0 + n < ncols) *(GAS v4u*)(WT + (size_t)(row0 + n0 + n) * Kd + koff + k0 + 8 * c) = o; }
    LDS_WAIT(); asm volatile("" ::: "memory");
}
constexpr int NSEG = 25;
struct Seg { const float* W; int ldw, Ks, col0, ncols; bf16* WT; int Kd, row0, koff; };
__device__ __forceinline__ Seg get_seg(const Params& p, const Bufs& B, int s) {
    const int l = s / NSEG, k = s % NSEG; unsigned char* wl = wl_ptr(p, l); Seg g;
    switch (k) {
    case 0: g = Seg{kin()[4] + (size_t)l * D * INW, INW, D, 0, O_G, (bf16*)(wl + WO_WIN), D, 0, 0}; break;
    case 1: g = Seg{kin()[4] + (size_t)l * D * INW, INW, D, O_G, 3072, (bf16*)(wl + WO_WIN), D, PROJW, 0}; break;
    case 2: g = Seg{kin()[30] + (size_t)l * D * 2048, 2048, D, 0, 2048, (bf16*)(wl + WO_WQ), D, 0, 0}; break;
    case 3: g = Seg{kin()[27] + (size_t)l * D * D, D, D, 0, D, (bf16*)(wl + WO_WOUT), D, 0, 0}; break;
    case 4: g = Seg{kin()[24] + (size_t)l * S5W * D, D, S5W, 0, D, (bf16*)(wl + WO_BRA), YCW, 0, YC_A}; break;
    case 5: g = Seg{kin()[25] + (size_t)l * M2I * D, D, M2I, 0, D, (bf16*)(wl + WO_BRA), YCW, 0, YC_B}; break;
    case 6: g = Seg{kin()[26] + (size_t)l * 512 * D, D, 512, 0, D, (bf16*)(wl + WO_BRA), YCW, 0, YC_C}; break;
    case 7: g = Seg{kin()[13] + (size_t)l * S5W * S5W, S5W, S5W, 0, S5W, (bf16*)(wl + WO_GLU), S5W, 0, 0}; break;
    case 8: g = Seg{kin()[21] + (size_t)l * QR * 768, 768, QR, 0, 768, (bf16*)(wl + WO_UQ), QR, 0, 0}; break;
    default: { const int hh = (k - 9) >> 1, isv = (k - 9) & 1;
        g = Seg{kin()[23] + (size_t)l * KVR * 1024, 1024, KVR, hh * 128 + isv * 64, 64, (bf16*)(wl + (isv ? WO_VW : WO_KN)), 256, hh * 64, 0}; } break;
    }
    return g;
}
__device__ __forceinline__ void prologue_phase(const Params& p, const Bufs& B, LAS unsigned char* lds) {
    const int tid = otid(), lane = tid & 63, wave = tid >> 6;
    LAS float* scr = (LAS float*)(lds + wave * 16640);
    const int gw = blockIdx.x * NWAVES + wave, NGW = gridDim.x * NWAVES;
    {
        int total = 0;
        for (int sg = 0; sg < DEPTH * NSEG; ++sg) { const Seg g = get_seg(p, B, sg); total += ((g.ncols + 63) / 64) * (g.Ks / 64); }
        for (int it = gw; it < total; it += NGW) {
            int sg = 0, base = 0; Seg g = get_seg(p, B, 0); int n = ((g.ncols + 63) / 64) * (g.Ks / 64);
            while (it >= base + n) { base += n; ++sg; g = get_seg(p, B, sg); n = ((g.ncols + 63) / 64) * (g.Ks / 64); }
            tr_item(g.W, g.ldw, g.col0, g.ncols, g.WT, g.Kd, g.row0, g.koff, scr, it - base, lane);
        }
    }
    for (int l = 0; l < DEPTH; ++l) { unsigned char* wl = wl_ptr(p, l); const v4u z4 = {0u, 0u, 0u, 0u};
        v4u* a = (v4u*)(wl + WO_WIN + (size_t)O_G * D * 2); for (int i = gw * 64 + lane; i < (PROJW - O_G) * D * 2 / 16; i += NGW * 64) a[i] = z4;
        v4u* b = (v4u*)(wl + WO_GLU + (size_t)S5W * S5W * 2); for (int i = gw * 64 + lane; i < (512 - S5W) * S5W * 2 / 16; i += NGW * 64) b[i] = z4;
        for (int i = gw * 64 + lane; i < 2 * 512 * 16; i += NGW * 64) { const int m = i >> 13, r = (i >> 4) & 511, c = i & 15; *(v4u*)(wl + (m ? WO_VW : WO_KN) + (size_t)r * 512 + 256 + c * 16) = z4; } }
    for (int l = 0; l < DEPTH; ++l) { const float* sk = kin()[31] + (size_t)l * 2 * PK * 128; bf16* dk = (bf16*)(wl_ptr(p, l) + WO_SK);
        for (int i = gw * 64 + lane; i < 2 * PK * 128; i += NGW * 64) dk[i] = (bf16)f2bf(sk[i]); }
    const float* gg = kin()[2]; const float* bb = kin()[3];
    for (int r = gw; r < NB * SEQ; r += NGW) {
        const GAS f32x4* xr = (const GAS f32x4*)(kin()[0] + (size_t)r * D) + lane;
        f32x4 v[4]; float s = 0.f;
#pragma unroll
        for (int j = 0; j < 4; ++j) { v[j] = xr[64 * j]; s += (v[j].x + v[j].y) + (v[j].z + v[j].w); }
        const float mean = wsum(s) * (1.f / D); float s2 = 0.f;
#pragma unroll
        for (int j = 0; j < 4; ++j) { v[j] = v[j] - mean; s2 += (v[j].x * v[j].x + v[j].y * v[j].y) + (v[j].z * v[j].z + v[j].w * v[j].w); }
        const float rstd = __builtin_amdgcn_rsqf(wsum(s2) * (1.f / D) + 1e-5f);
        GAS unsigned long long* o8 = (GAS unsigned long long*)(B.HB() + (size_t)r * D) + lane;
#pragma unroll
        for (int j = 0; j < 4; ++j) { const f32x4 g4 = *(const f32x4*)(gg + 4 * lane + 256 * j), b4 = *(const f32x4*)(bb + 4 * lane + 256 * j);
            o8[64 * j] = (unsigned long long)pk2(v[j].x * rstd * g4.x + b4.x, v[j].y * rstd * g4.y + b4.y) | ((unsigned long long)pk2(v[j].z * rstd * g4.z + b4.z, v[j].w * rstd * g4.w + b4.w) << 32); }
    }
}
__device__ __forceinline__ void tables_phase(const Params& p, const Bufs& B) {
    const int lane = otid() & 63, w = otid() >> 6;
    for (int r = blockIdx.x * NWAVES + w; r < 2 * DEPTH * PE; r += gridDim.x * NWAVES) {
        const int isv = r >= DEPTH * PE, rr = isv ? r - DEPTH * PE : r;
        const f32x4* src = (const f32x4*)(kin()[isv ? 33 : 32] + (size_t)rr * D) + lane;
        f32x4 v[4]; float am = 0.f;
#pragma unroll
        for (int q = 0; q < 4; ++q) { v[q] = src[64 * q]; am = fmaxf(am, fmaxf(fmaxf(fabsf(v[q][0]), fabsf(v[q][1])), fmaxf(fabsf(v[q][2]), fabsf(v[q][3])))); }
#pragma unroll
        for (int o = 32; o > 0; o >>= 1) am = fmaxf(am, sx(am, o));
        const float sc = am > 0.f ? am * (isv ? 1.f / 224.f : 1.f / 127.f) : 1.f, inv = 1.f / sc;
        unsigned* dst = (unsigned*)((isv ? B.TABV() : B.TABU()) + (size_t)rr * D) + lane;
#pragma unroll
        for (int q = 0; q < 4; ++q) { unsigned wv = 0u;
            if (isv) { int pk = __builtin_amdgcn_cvt_pk_fp8_f32(v[q][0] * inv, v[q][1] * inv, 0, false); pk = __builtin_amdgcn_cvt_pk_fp8_f32(v[q][2] * inv, v[q][3] * inv, pk, true); wv = (unsigned)pk; }
            else {
#pragma unroll
                for (int e = 0; e < 4; ++e) wv |= ((unsigned)(int)rintf(v[q][e] * inv) & 0xffu) << (8 * e); }
            dst[64 * q] = wv; }
        if (lane == 0) (isv ? B.SV() : B.SU())[rr] = sc;
    }
}

enum { G_PROJ = 0, G_GLU, G_Q, G_KN, G_VT, G_M0, G_M1, G_M2, G_OUT, G_PQ };
template <int KIND> __device__ __forceinline__ void gemm_ph(const Params& p, const Bufs& B, int l, int pass, int cid, LAS unsigned char* lds) {
    unsigned char* wl = wl_ptr(p, l);
    PG8_LAS unsigned char* L = (PG8_LAS unsigned char*)lds;
    const bf16* hb = B.HB() + (size_t)pass * M * D;
    pg8::StaticOrder S;
    if constexpr (KIND == G_PROJ) { pg8::Gemm g{hb, (const bf16*)(wl + WO_WIN), M, WIN_N, D}; S.init(M, WIN_N, gridDim.x, cid); pg8::EpiProj E{B.PROJ(), B.GATES()};
        pg8::gemm_phase<pg8::EpiProj, pg8::StaticOrder, true, true>(L, g, S, E); }
    if constexpr (KIND == G_GLU) { pg8::Gemm g{B.Z(), (const bf16*)(wl + WO_GLU), M, 512, S5W}; S.init(M, 512, gridDim.x, cid); pg8::EpiGlu E{B.Z(), B.YA()};
        pg8::gemm_phase<pg8::EpiGlu, pg8::StaticOrder, true, true>(L, g, S, E); }
    if constexpr (KIND == G_Q) { pg8::Gemm g{B.CQN(), (const bf16*)(wl + WO_UQ), M, 768, QR}; S.init(M, 768, gridDim.x, cid); pg8::EpiBf16<0> E{B.Q(), 768, nullptr, 0, 0, 1.f};
        pg8::gemm_phase<pg8::EpiBf16<0>, pg8::StaticOrder, true, true>(L, g, S, E); }
    if constexpr (KIND == G_KN) { pg8::Gemm g{B.CKVN(), (const bf16*)(wl + WO_KN), M, 512, 256}; S.init(M, 512, gridDim.x, cid); pg8::EpiBf16<0> E{B.KN(), 512, nullptr, 0, 0, 1.f};
        pg8::gemm_phase<pg8::EpiBf16<0>, pg8::StaticOrder, true, true>(L, g, S, E); }
    if constexpr (KIND == G_VT) { pg8::Gemm g{(const bf16*)(wl + WO_VW), B.CKVN(), 512, M, 256}; S.init(512, M, gridDim.x, cid); pg8::EpiBf16<0> E{B.VT(), VT_P, nullptr, 0, 0, 1.f};
        pg8::gemm_phase<pg8::EpiBf16<0>, pg8::StaticOrder, true, true>(L, g, S, E); }
    if constexpr (KIND == G_M0) { pg8::Gemm g{B.YA(), (const bf16*)(wl + WO_BRA), M, D, YCW}; S.init(M, D, gridDim.x, cid); pg8::EpiMergeCat E{B.GATES(), B.MERGED()};
        pg8::gemm_phase<pg8::EpiMergeCat, pg8::StaticOrder, true, true>(L, g, S, E); }
    if constexpr (KIND == G_OUT) { pg8::Gemm g{B.MERGED(), (const bf16*)(wl + WO_WOUT), M, D, D}; S.init(M, D, gridDim.x, cid); pg8::EpiF32 E{B.F32(), D};
        pg8::gemm_phase<pg8::EpiF32, pg8::StaticOrder, true, true>(L, g, S, E); }
    if constexpr (KIND == G_PQ) { pg8::Gemm g{hb, (const bf16*)(wl + WO_WQ), M, 2048, D}; S.init(M, 2048, gridDim.x, cid); pg8::EpiBf16<0> E{B.PQ(), 2048, nullptr, 0, 0, 1.f};
        pg8::gemm_phase<pg8::EpiBf16<0>, pg8::StaticOrder, true, true>(L, g, S, E); }
}

typedef float f32x2 __attribute__((ext_vector_type(2)));
constexpr int S5_CH = 64, S5_NCH = SEQ / S5_CH, S5_BP = 132, S5_BT = 16 * S5_BP * 4, S5_XP = 136, S5_XT = 16 * S5_XP * 2, S5_LDS = NWAVES * (S5_BT + S5_XT);
struct S5Lane { float ar, ai; };
__device__ __forceinline__ void s5_coef(int l, int g, int pp, float dt, float& ar, float& ai, float& cr, float& ci) {
    const float lr = kin()[5][(l * S5G + g) * S5P + pp], li = kin()[6][(l * S5G + g) * S5P + pp];
    const float mag = fexp(lr * dt); float sn_, cs_; fsincos(li * dt, sn_, cs_); ar = mag * cs_; ai = mag * sn_;
    const float nr = ar - 1.f, ni = ai, den = lr * lr + li * li;
    cr = (nr * lr + ni * li) / den; ci = (ni * lr - nr * li) / den;
}
__device__ __forceinline__ S5Lane s5_setup(int l, int g, int lane, bf16x8 (&bf)[8]) {
    const int fr = lane & 15, fq = lane >> 4; const float dt = fexp(kin()[7][l * S5G + g]);
#pragma unroll
    for (int nt = 0; nt < 4; ++nt) { const int pp = fr + 16 * nt; float ar, ai, cr, ci; s5_coef(l, g, pp, dt, ar, ai, cr, ci);
        v4u re = {0u, 0u, 0u, 0u}, im = {0u, 0u, 0u, 0u};
        if (fq < 2) { const f32x4* br4 = (const f32x4*)(kin()[8] + ((size_t)(l * S5G + g) * S5P + pp) * 16 + 8 * fq); const f32x4* bi4 = (const f32x4*)(kin()[9] + ((size_t)(l * S5G + g) * S5P + pp) * 16 + 8 * fq);
            const f32x4 b0 = br4[0], b1 = br4[1], c0 = bi4[0], c1 = bi4[1];
            re = (v4u){pk2(cr * b0[0] - ci * c0[0], cr * b0[1] - ci * c0[1]), pk2(cr * b0[2] - ci * c0[2], cr * b0[3] - ci * c0[3]), pk2(cr * b1[0] - ci * c1[0], cr * b1[1] - ci * c1[1]), pk2(cr * b1[2] - ci * c1[2], cr * b1[3] - ci * c1[3])};
            im = (v4u){pk2(cr * c0[0] + ci * b0[0], cr * c0[1] + ci * b0[1]), pk2(cr * c0[2] + ci * b0[2], cr * c0[3] + ci * b0[3]), pk2(cr * c1[0] + ci * b1[0], cr * c1[1] + ci * b1[1]), pk2(cr * c1[2] + ci * b1[2], cr * c1[3] + ci * b1[3])}; }
        bf[nt] = __builtin_bit_cast(bf16x8, re); bf[4 + nt] = __builtin_bit_cast(bf16x8, im); }
    S5Lane L; float cr, ci; s5_coef(l, g, lane, dt, L.ar, L.ai, cr, ci); return L;
}
__device__ __forceinline__ void s5_tables_phase(const Params& p) {
    const int lane = otid() & 63, w = otid() >> 6, fr = lane & 15, fq = lane >> 4;
    for (int lg = blockIdx.x * NWAVES + w; lg < DEPTH * S5G; lg += gridDim.x * NWAVES) {
        const int l = lg / S5G, g = lg % S5G; unsigned char* wl = wl_ptr(p, l);
        bf16x8 bf[8]; const S5Lane L = s5_setup(l, g, lane, bf);
        v4u* dbf = (v4u*)(wl + WO_S5BF) + ((size_t)g * 64 + lane) * 8;
#pragma unroll
        for (int nt = 0; nt < 8; ++nt) dbf[nt] = __builtin_bit_cast(v4u, bf[nt]);
        v4u* dcf = (v4u*)(wl + WO_S5CF) + ((size_t)g * 64 + lane) * 4;
#pragma unroll
        for (int ks = 0; ks < 4; ++ks) { const float* src = (ks < 2 ? kin()[10] : kin()[11]) + ((size_t)(l * S5G + g) * 16 + fr) * S5P + 32 * (ks & 1) + 8 * fq; const float sg = ks < 2 ? 1.f : -1.f;
            const f32x4 a = *(const f32x4*)src, b = *(const f32x4*)(src + 4);
            dcf[ks] = (v4u){pk2(sg * a[0], sg * a[1]), pk2(sg * a[2], sg * a[3]), pk2(sg * b[0], sg * b[1]), pk2(sg * b[2], sg * b[3])}; }
    }
}
__device__ __forceinline__ S5Lane s5_fetch(const Params& p, int l, int g, int lane, bf16x8 (&bf)[8]) {
    const unsigned char* wl = wl_ptr(p, l); const v4u* sbf = (const v4u*)(wl + WO_S5BF) + ((size_t)g * 64 + lane) * 8;
#pragma unroll
    for (int nt = 0; nt < 8; ++nt) bf[nt] = __builtin_bit_cast(bf16x8, sbf[nt]);
    const float dt = fexp(kin()[7][l * S5G + g]); S5Lane L; float cr, ci; s5_coef(l, g, lane, dt, L.ar, L.ai, cr, ci); return L;
}
__device__ __forceinline__ void s5_bu_block(v4u uv, int lane, const bf16x8 (&bf)[8], LAS unsigned char* but) {
    const int fr = lane & 15, fq = lane >> 4;
    const bf16x8 af = __builtin_bit_cast(bf16x8, uv);
    float one = 1.f; asm volatile("" : "+v"(one));
#pragma unroll
    for (int nt = 0; nt < 8; ++nt) { f32x4 acc = {0.f, 0.f, 0.f, 0.f}; acc = __builtin_amdgcn_mfma_f32_16x16x32_bf16(af, bf[nt], acc, 0, 0, 0);
#pragma unroll
        for (int j = 0; j < 4; ++j) *(LAS float*)(but + ((4 * fq + j) * S5_BP + 16 * nt + fr) * 4) = acc[j] * one; }
    asm volatile("" :: "v"(af), "v"(bf[0]), "v"(bf[1]), "v"(bf[2]), "v"(bf[3]), "v"(bf[4]), "v"(bf[5]), "v"(bf[6]), "v"(bf[7]));
    LDS_WAIT(); asm volatile("" ::: "memory");
}
__device__ __forceinline__ void s5a_phase(const Params& p, const Bufs& B, int l, LAS unsigned char* lds) {
    const int tid = otid(), lane = tid & 63, w = tid >> 6;
    LAS unsigned char* but = lds + w * S5_BT;
    for (int task = blockIdx.x; task < NBP * S5_NCH; task += gridDim.x) {
        const int sq = task / S5_NCH, c = task % S5_NCH, row0 = sq * SEQ + c * S5_CH;
        for (int gi = 0; gi < 3; ++gi) { const int g = 3 * w + gi; bf16x8 bf[8]; const S5Lane L = s5_fetch(p, l, g, lane, bf);
            float xr = 0.f, xi = 0.f;
            v4u uvb[4];
#pragma unroll
            for (int bq = 0; bq < 4; ++bq) { uvb[bq] = (v4u){0u, 0u, 0u, 0u}; if ((lane >> 4) < 2) uvb[bq] = *(const v4u*)(B.PROJ() + (size_t)(row0 + 16 * bq + (lane & 15)) * PROJW + O_U + g * 16 + 8 * (lane >> 4)); }
#pragma unroll
            for (int bq = 0; bq < 4; ++bq) { const int tb = 16 * bq;
                s5_bu_block(uvb[bq], lane, bf, but);
#pragma unroll
                for (int tt = 0; tt < 16; ++tt) { const float bur = *(const LAS float*)(but + (tt * S5_BP + lane) * 4), bui = *(const LAS float*)(but + (tt * S5_BP + 64 + lane) * 4);
                    const float nxr = L.ar * xr - L.ai * xi + bur, nxi = L.ar * xi + L.ai * xr + bui; xr = nxr; xi = nxi; }
                LDS_WAIT(); asm volatile("" ::: "memory");
            }
            *(f32x2*)(B.ES() + ((((size_t)sq * S5_NCH + c) * S5G + g) * S5P + lane) * 2) = (f32x2){xr, xi};
        }
    }
    __syncthreads();
}
__device__ __forceinline__ void s5scan_phase(const Params& p, const Bufs& B, int l, int gtid, int gthreads) {
    const int nwg_ = gthreads / NTHR, wg_ = gtid / NTHR, th_ = gtid % NTHR;
    for (int ch = wg_ + nwg_ * th_; ch < NBP * S5G * S5P && th_ < (NBP * S5G * S5P + nwg_ - 1) / nwg_; ch += nwg_ * NTHR) {
        const int sq = ch / (S5G * S5P), rem = ch % (S5G * S5P), g = rem >> 6, pl = rem & 63;
        const float lr = kin()[5][(l * S5G + g) * S5P + pl], li = kin()[6][(l * S5G + g) * S5P + pl], dt = fexp(kin()[7][l * S5G + g]);
        float sn_, cs_; fsincos(li * dt * (float)S5_CH, sn_, cs_); const float mg = fexp(lr * dt * (float)S5_CH), Ar = mg * cs_, Ai = mg * sn_;
        f32x2* E = (f32x2*)B.ES() + (size_t)sq * S5_NCH * S5G * S5P + rem; const size_t cs = (size_t)S5G * S5P;
        float cr = 0.f, ci = 0.f; asm volatile("" : "+v"(cr), "+v"(ci));
        for (int c0 = 0; c0 < S5_NCH; c0 += 16) { f32x2 e[16];
#pragma unroll
            for (int k = 0; k < 16; ++k) e[k] = E[(size_t)(c0 + k) * cs];
#pragma unroll
            for (int k = 0; k < 16; ++k) { E[(size_t)(c0 + k) * cs] = (f32x2){cr, ci}; const float nr = Ar * cr - Ai * ci + e[k].x, ni = Ar * ci + Ai * cr + e[k].y; cr = nr; ci = ni; } }
    }
}
__device__ __forceinline__ void s5b_phase(const Params& p, const Bufs& B, int l, LAS unsigned char* lds) {
    const int tid = otid(), lane = tid & 63, w = tid >> 6, fr = lane & 15, fq = lane >> 4;
    LAS unsigned char* but = lds + w * S5_BT; LAS unsigned char* xt = lds + NWAVES * S5_BT + w * S5_XT;
    for (int task = blockIdx.x; task < NBP * S5_NCH; task += gridDim.x) {
        const int sq = task / S5_NCH, c = task % S5_NCH, row0 = sq * SEQ + c * S5_CH;
        for (int gi = 0; gi < 3; ++gi) { const int g = 3 * w + gi; bf16x8 bf[8]; const S5Lane L = s5_fetch(p, l, g, lane, bf);
            bf16x8 cf[4];
            { const v4u* scf = (const v4u*)(wl_ptr(p, l) + WO_S5CF) + ((size_t)g * 64 + lane) * 4;
#pragma unroll
              for (int ks = 0; ks < 4; ++ks) cf[ks] = __builtin_bit_cast(bf16x8, scf[ks]); }
            const float dsk = kin()[12][l * S5W + g * 16 + fr];
            const f32x2 cin = *(const f32x2*)(B.ES() + ((((size_t)sq * S5_NCH + c) * S5G + g) * S5P + lane) * 2);
            float xr = cin.x, xi = cin.y;
            v4u uvb[4];
#pragma unroll
            for (int bq = 0; bq < 4; ++bq) { uvb[bq] = (v4u){0u, 0u, 0u, 0u}; if (fq < 2) uvb[bq] = *(const v4u*)(B.PROJ() + (size_t)(row0 + 16 * bq + fr) * PROJW + O_U + g * 16 + 8 * fq); }
#pragma unroll
            for (int bq = 0; bq < 4; ++bq) { const int tb = 16 * bq;
                s5_bu_block(uvb[bq], lane, bf, but);
#pragma unroll
                for (int tt = 0; tt < 16; ++tt) { const float bur = *(const LAS float*)(but + (tt * S5_BP + lane) * 4), bui = *(const LAS float*)(but + (tt * S5_BP + 64 + lane) * 4);
                    const float nxr = L.ar * xr - L.ai * xi + bur, nxi = L.ar * xi + L.ai * xr + bui; xr = nxr; xi = nxi;
                    *(LAS unsigned short*)(xt + (tt * S5_XP + lane) * 2) = (unsigned short)f2bf(xr); *(LAS unsigned short*)(xt + (tt * S5_XP + 64 + lane) * 2) = (unsigned short)f2bf(xi); }
                LDS_WAIT(); asm volatile("" ::: "memory");
                f32x4 acc = zero4();
#pragma unroll
                for (int ks = 0; ks < 4; ++ks) { const bf16x8 a = *(const LAS bf16x8*)(xt + (fr * S5_XP + 32 * ks + 8 * fq) * 2); acc = __builtin_amdgcn_mfma_f32_16x16x32_bf16(a, cf[ks], acc, 0, 0, 0); asm volatile("" :: "v"(a), "v"(cf[ks])); }
                LDS_WAIT(); asm volatile("" ::: "memory");
#pragma unroll
                for (int j = 0; j < 4; ++j) { const size_t row = (size_t)(row0 + tb + 4 * fq + j); const float u = bf2f(B.PROJ()[row * PROJW + O_U + g * 16 + fr]);
                    B.Z()[row * S5W + g * 16 + fr] = (bf16)f2bf(gelu_t(acc[j] + dsk * u)); }
            }
        }
    }
    __syncthreads();
}

constexpr int SC = 128, NCK = M / SC;
constexpr int XC_RP = 136, XC_RAW = 131 * XC_RP * 2, XC_T = 128 * XC_RP * 2, XC_LDS = XC_RAW + XC_T;
__device__ __forceinline__ void xc_phase(const Params& p, const Bufs& B, int l, LAS unsigned char* lds) {
    const int tid = otid(), lane = tid & 63, w = tid >> 6;
    const float* cw = kin()[14] + (size_t)l * 4 * M2C; const float* cb_ = kin()[15] + l * M2C;
    LAS unsigned char* raw = lds; LAS unsigned char* T = lds + XC_RAW;
    for (int task = blockIdx.x; task < NCK * 8; task += gridDim.x) {
        const int ck = task >> 3, cb = task & 7, c = ck & 63, row0 = ck * SC, ch0 = cb * 128;
        for (int i = tid; i < 131 * 16; i += NTHR) { const int r = i >> 4, q = i & 15;
            v4u v = {0u, 0u, 0u, 0u}; if (!(c == 0 && r < 3)) v = *(const v4u*)(B.PROJ() + (size_t)(row0 - 3 + r) * PROJW + O_XBC + ch0 + q * 8);
            *(LAS v4u*)(raw + (r * XC_RP + q * 8) * 2) = v; }
        __syncthreads();
        const int cp = tid & 63, lq = tid >> 6; const int chA = ch0 + 2 * cp;
        float wk[4][2]; for (int k = 0; k < 4; ++k) { wk[k][0] = cw[k * M2C + chA]; wk[k][1] = cw[k * M2C + chA + 1]; }
        const float b0 = cb_[chA], b1 = cb_[chA + 1];
        const bool nat = cb >= 4, tr = cb < 6;
        bf16* dnat = cb >= 6 ? B.CN() + ((size_t)(ck * 2 + (cb - 6)) * SC) * 128 : B.BN() + ((size_t)(ck * 2 + (cb - 4)) * SC) * 128;
        for (int i = 0; i < 16; ++i) { const int ll = lq * 16 + i; float s0 = b0, s1 = b1;
#pragma unroll
            for (int k = 0; k < 4; ++k) { const unsigned x = *(const LAS unsigned*)(raw + ((ll + k) * XC_RP + 2 * cp) * 2); s0 = fmaf(wk[k][0], bflo(x), s0); s1 = fmaf(wk[k][1], bfhi(x), s1); }
            const float y0 = s0 * sigm_f(s0), y1 = s1 * sigm_f(s1);
            if (nat) *(unsigned*)(dnat + (size_t)ll * 128 + 2 * cp) = pk2(y0, y1);
            if (tr) { *(LAS unsigned short*)(T + ((2 * cp) * XC_RP + ll) * 2) = (unsigned short)f2bf(y0); *(LAS unsigned short*)(T + ((2 * cp + 1) * XC_RP + ll) * 2) = (unsigned short)f2bf(y1); } }
        __syncthreads();
        if (tr) { bf16* dT = cb < 4 ? B.XT() + ((size_t)(ck * 8 + 2 * cb) * 64) * SC : B.BT() + ((size_t)(ck * 2 + (cb - 4)) * 128) * SC;
            for (int i = tid; i < 128 * 16; i += NTHR) { const int cr = i >> 4, q = i & 15; *(v4u*)(dT + (size_t)cr * SC + q * 8) = *(const LAS v4u*)(T + (cr * XC_RP + q * 8) * 2); } }
        __syncthreads();
    }
    for (int ck = blockIdx.x * NWAVES + w; ck < NCK; ck += gridDim.x * NWAVES) {
        const size_t r0 = (size_t)ck * SC + lane, r1 = r0 + 64;
        const v4u d0 = *(const v4u*)(B.PROJ() + r0 * PROJW + O_DT), d1 = *(const v4u*)(B.PROJ() + r1 * PROJW + O_DT);
        float dtA[8], dtB[8];
        dtA[0] = bflo(d0.x); dtA[1] = bfhi(d0.x); dtA[2] = bflo(d0.y); dtA[3] = bfhi(d0.y); dtA[4] = bflo(d0.z); dtA[5] = bfhi(d0.z); dtA[6] = bflo(d0.w); dtA[7] = bfhi(d0.w);
        dtB[0] = bflo(d1.x); dtB[1] = bfhi(d1.x); dtB[2] = bflo(d1.y); dtB[3] = bfhi(d1.y); dtB[4] = bflo(d1.z); dtB[5] = bfhi(d1.z); dtB[6] = bflo(d1.w); dtB[7] = bfhi(d1.w);
#pragma unroll
        for (int h = 0; h < 8; ++h) {
            const float A = -fexp(kin()[17][l * M2H + h]), db = kin()[16][l * M2H + h];
            float ra = dtA[h] + db, rb = dtB[h] + db; ra = ra > 20.f ? ra : flog(1.f + fexp(ra)); rb = rb > 20.f ? rb : flog(1.f + fexp(rb));
            float ca = A * ra, cbv = A * rb;
#pragma unroll
            for (int o = 1; o < 64; o <<= 1) { const float ta = sup(ca, o), tb = sup(cbv, o); if (lane >= o) { ca += ta; cbv += tb; } }
            const float tot0 = sl(ca, 63); cbv += tot0; const float aend = sl(cbv, 63);
            B.SDT()[r0 * 8 + h] = ra; B.SDT()[r1 * 8 + h] = rb; B.SAC()[r0 * 8 + h] = ca; B.SAC()[r1 * 8 + h] = cbv;
            B.SW()[((size_t)ck * 8 + h) * SC + lane] = fexp(aend - ca) * ra; B.SW()[((size_t)ck * 8 + h) * SC + 64 + lane] = fexp(aend - cbv) * rb;
            if (lane == 0) B.CDEC()[ck * 8 + h] = fexp(aend);
        }
    }
}
__device__ __forceinline__ void ssd1_phase(const Bufs& B) {
    const int tid = otid(), lane = tid & 63, w = tid >> 6, fr = lane & 15, fq = lane >> 4, hh = w >> 1, ph = w & 1;
    for (int task = blockIdx.x; task < NCK * 2; task += gridDim.x) {
        const int ck = task >> 1, gr = task & 1, h = 4 * gr + hh;
        const bf16* xt = B.XT() + ((size_t)(ck * 8 + h) * 64 + 32 * ph + fr) * SC + 8 * fq;
        const float* sw = B.SW() + ((size_t)ck * 8 + h) * SC + 8 * fq;
        const bf16* bt = B.BT() + ((size_t)(ck * 2 + gr) * 128 + fr) * SC + 8 * fq;
        f32x4 acc[2][8];
#pragma unroll
        for (int mt = 0; mt < 2; ++mt)
#pragma unroll
            for (int nt = 0; nt < 8; ++nt) acc[mt][nt] = zero4();
#pragma unroll 2
        for (int ks = 0; ks < 4; ++ks) {
            const f32x4 wa = *(const f32x4*)(sw + 32 * ks), wb = *(const f32x4*)(sw + 32 * ks + 4);
            bf16x8 af[2];
#pragma unroll
            for (int mt = 0; mt < 2; ++mt) { const v4u xv = *(const v4u*)(xt + (size_t)(16 * mt) * SC + 32 * ks);
                af[mt] = __builtin_bit_cast(bf16x8, (v4u){pk2(bflo(xv.x) * wa[0], bfhi(xv.x) * wa[1]), pk2(bflo(xv.y) * wa[2], bfhi(xv.y) * wa[3]), pk2(bflo(xv.z) * wb[0], bfhi(xv.z) * wb[1]), pk2(bflo(xv.w) * wb[2], bfhi(xv.w) * wb[3])}); }
            bf16x8 bfg[8];
#pragma unroll
            for (int nt = 0; nt < 8; ++nt) bfg[nt] = *(const bf16x8*)(bt + (size_t)(16 * nt) * SC + 32 * ks);
#pragma unroll
            for (int mt = 0; mt < 2; ++mt)
#pragma unroll
                for (int nt = 0; nt < 8; ++nt) acc[mt][nt] = __builtin_amdgcn_mfma_f32_16x16x32_bf16(af[mt], bfg[nt], acc[mt][nt], 0, 0, 0);
            asm volatile("" :: "v"(af[0]), "v"(af[1]), "v"(bfg[0]), "v"(bfg[1]), "v"(bfg[2]), "v"(bfg[3]), "v"(bfg[4]), "v"(bfg[5]), "v"(bfg[6]), "v"(bfg[7]));
        }
        float* st = B.ST() + ((size_t)(ck * 8 + h) * 64 + 32 * ph + 4 * fq) * 128 + fr;
#pragma unroll
        for (int mt = 0; mt < 2; ++mt)
#pragma unroll
            for (int nt = 0; nt < 8; ++nt)
#pragma unroll
                for (int j = 0; j < 4; ++j) st[(size_t)(16 * mt + j) * 128 + 16 * nt] = acc[mt][nt][j];
    }
}
__device__ __forceinline__ void ssd2_phase(const Bufs& B, int gtid, int gthreads) {
    for (int e = gtid; e < NBP * 8 * 64 * 128; e += gthreads) {
        const int sq = e >> 16, rem = e & 65535, h = rem >> 13;
        const float* st = B.ST() + (size_t)sq * 64 * 65536 + rem; bf16* pv = B.PREV() + (size_t)sq * 64 * 65536 + rem; const float* cd = B.CDEC() + (size_t)sq * 64 * 8 + h;
        float carry = 0.f;
        for (int c0 = 0; c0 < 64; c0 += 8) { float v[8], d[8];
#pragma unroll
            for (int k = 0; k < 8; ++k) { v[k] = st[(size_t)(c0 + k) * 65536]; d[k] = cd[(c0 + k) * 8]; }
#pragma unroll
            for (int k = 0; k < 8; ++k) { pv[(size_t)(c0 + k) * 65536] = (bf16)f2bf(carry); carry = carry * d[k] + v[k]; } }
    }
}
constexpr int S3_CBP = 136, S3_CB = 128 * S3_CBP * 2, S3_AD = 4 * 128 * 2 * 4, S3_SS = 128 * 4 * 4, S3_LDS = S3_CB + S3_AD + S3_SS;
__device__ __forceinline__ void ssd3_phase(const Params& p, const Bufs& B, int l, LAS unsigned char* lds) {
    const int tid = otid(), lane = tid & 63, w = tid >> 6, fr = lane & 15, fq = lane >> 4, hh = w >> 1, lh = w & 1;
    LAS unsigned char* cbl = lds; LAS float* ad = (LAS float*)(lds + S3_CB); LAS float* ss = (LAS float*)(lds + S3_CB + S3_AD);
    for (int task = blockIdx.x; task < NCK * 2; task += gridDim.x) {
        const int ck = task >> 1, gr = task & 1, h = 4 * gr + hh; const size_t row0 = (size_t)ck * SC;
        const bf16* cn = B.CN() + (size_t)(ck * 2 + gr) * SC * 128; const bf16* bn = B.BN() + (size_t)(ck * 2 + gr) * SC * 128;
        for (int i = tid; i < 4 * 128; i += NTHR) { const int h4 = i >> 7, ll = i & 127; ad[i * 2] = B.SAC()[(row0 + ll) * 8 + 4 * gr + h4]; ad[i * 2 + 1] = B.SDT()[(row0 + ll) * 8 + 4 * gr + h4]; }
        {
            bf16x8 af[4];
#pragma unroll
            for (int ks = 0; ks < 4; ++ks) af[ks] = *(const bf16x8*)(cn + (size_t)(16 * w + fr) * 128 + 32 * ks + 8 * fq);
#pragma unroll
            for (int nt = 0; nt < 8; ++nt) { f32x4 acc = zero4();
#pragma unroll
                for (int ks = 0; ks < 4; ++ks) { const bf16x8 bfg = *(const bf16x8*)(bn + (size_t)(16 * nt + fr) * 128 + 32 * ks + 8 * fq); acc = __builtin_amdgcn_mfma_f32_16x16x32_bf16(af[ks], bfg, acc, 0, 0, 0); asm volatile("" :: "v"(af[ks]), "v"(bfg)); }
#pragma unroll
                for (int j = 0; j < 4; ++j) *(LAS unsigned short*)(cbl + ((16 * w + 4 * fq + j) * S3_CBP + 16 * nt + fr) * 2) = (unsigned short)f2bf(acc[j]); }
        }
        __syncthreads();
#pragma unroll 1
        for (int hq = 0; hq < 2; ++hq) {
        f32x4 acc[2][4];
#pragma unroll
        for (int mt = 0; mt < 2; ++mt)
#pragma unroll
            for (int nt = 0; nt < 4; ++nt) acc[mt][nt] = zero4();
        const int l0 = 64 * lh + 32 * hq;
        { const bf16* pv = B.PREV() + (size_t)(ck * 8 + h) * 64 * 128;
#pragma unroll
          for (int ks = 0; ks < 4; ++ks) { bf16x8 bfg[4], af[2];
#pragma unroll
            for (int nt = 0; nt < 4; ++nt) bfg[nt] = *(const bf16x8*)(pv + (size_t)(16 * nt + fr) * 128 + 32 * ks + 8 * fq);
#pragma unroll
            for (int mt = 0; mt < 2; ++mt) af[mt] = *(const bf16x8*)(cn + (size_t)(l0 + 16 * mt + fr) * 128 + 32 * ks + 8 * fq);
#pragma unroll
            for (int mt = 0; mt < 2; ++mt)
#pragma unroll
                for (int nt = 0; nt < 4; ++nt) acc[mt][nt] = __builtin_amdgcn_mfma_f32_16x16x32_bf16(af[mt], bfg[nt], acc[mt][nt], 0, 0, 0);
            asm volatile("" :: "v"(af[0]), "v"(af[1]), "v"(bfg[0]), "v"(bfg[1]), "v"(bfg[2]), "v"(bfg[3])); } }
#pragma unroll
        for (int mt = 0; mt < 2; ++mt)
#pragma unroll
            for (int j = 0; j < 4; ++j) { const float ea = __expf(ad[(hh * 128 + l0 + 16 * mt + 4 * fq + j) * 2]);
#pragma unroll
                for (int nt = 0; nt < 4; ++nt) acc[mt][nt][j] *= ea; }
        { const bf16* xt = B.XT() + (size_t)(ck * 8 + h) * 64 * SC; const float Dh = kin()[18][l * M2H + h];
#pragma unroll
          for (int ks = 0; ks < 4; ++ks) {
            if (32 * ks <= l0 + 31) {
                bf16x8 bfg[4];
#pragma unroll
                for (int nt = 0; nt < 4; ++nt) bfg[nt] = *(const bf16x8*)(xt + (size_t)(16 * nt + fr) * SC + 32 * ks + 8 * fq);
                float as_[8], ds_[8];
#pragma unroll
                for (int j = 0; j < 8; ++j) { as_[j] = ad[(hh * 128 + 32 * ks + 8 * fq + j) * 2]; ds_[j] = ad[(hh * 128 + 32 * ks + 8 * fq + j) * 2 + 1]; }
#pragma unroll
                for (int mt = 0; mt < 2; ++mt) { const int lrow = l0 + 16 * mt + fr;
                    if (32 * ks <= l0 + 16 * mt + 15) {
                        const float al = ad[(hh * 128 + lrow) * 2];
                        const v4u cv = *(const LAS v4u*)(cbl + (lrow * S3_CBP + 32 * ks + 8 * fq) * 2);
                        float cf[8] = {bflo(cv.x), bfhi(cv.x), bflo(cv.y), bfhi(cv.y), bflo(cv.z), bfhi(cv.z), bflo(cv.w), bfhi(cv.w)};
#pragma unroll
                        for (int j = 0; j < 8; ++j) { const int sidx = 32 * ks + 8 * fq + j; float v = cf[j] * __expf(fminf(al - as_[j], 0.f)) * ds_[j]; v = sidx <= lrow ? v : 0.f; cf[j] = v + (sidx == lrow ? Dh : 0.f); }
                        const bf16x8 af = __builtin_bit_cast(bf16x8, (v4u){pk2(cf[0], cf[1]), pk2(cf[2], cf[3]), pk2(cf[4], cf[5]), pk2(cf[6], cf[7])});
#pragma unroll
                        for (int nt = 0; nt < 4; ++nt) acc[mt][nt] = __builtin_amdgcn_mfma_f32_16x16x32_bf16(af, bfg[nt], acc[mt][nt], 0, 0, 0);
                        asm volatile("" :: "v"(af), "v"(bfg[0]), "v"(bfg[1]), "v"(bfg[2]), "v"(bfg[3]));
                    } }
            } } }
        const float* nw = kin()[19] + l * M2I + gr * 256 + hh * 64;
#pragma unroll
        for (int mt = 0; mt < 2; ++mt)
#pragma unroll
            for (int j = 0; j < 4; ++j) { const int lrow = l0 + 16 * mt + 4 * fq + j; const bf16* zr = B.PROJ() + (row0 + lrow) * PROJW + O_Z + gr * 256 + hh * 64; float q = 0.f;
#pragma unroll
                for (int nt = 0; nt < 4; ++nt) { const float zz = bf2f(zr[16 * nt + fr]); const float v = acc[mt][nt][j] * zz * sigm_f(zz); acc[mt][nt][j] = v; q += v * v; }
                q += sx(q, 1); q += sx(q, 2); q += sx(q, 4); q += sx(q, 8);
                if (fr == 0) ss[lrow * 4 + hh] = q; asm volatile("" ::: "memory"); }
        __syncthreads();
#pragma unroll
        for (int mt = 0; mt < 2; ++mt)
#pragma unroll
            for (int j = 0; j < 4; ++j) { const int lrow = l0 + 16 * mt + 4 * fq + j; const f32x4 s4 = *(const LAS f32x4*)(ss + lrow * 4);
                const float rs = __builtin_amdgcn_rsqf((s4[0] + s4[1] + s4[2] + s4[3]) * (1.f / 256.f) + 1e-6f); bf16* yr = B.YA() + (row0 + lrow) * YCW + YC_B + gr * 256 + hh * 64;
#pragma unroll
                for (int nt = 0; nt < 4; ++nt) yr[16 * nt + fr] = (bf16)f2bf(acc[mt][nt][j] * rs * nw[16 * nt + fr]); }
        }
        __syncthreads();
    }
}

constexpr int AT_KP = 104, AT_VP = 68, AT_KB = 64 * AT_KP * 2, AT_VB = 64 * AT_VP * 2, AT_LDS = 2 * AT_KB + 2 * AT_VB;
__device__ __forceinline__ int crow16(int r, int hi) { return (r & 3) + 8 * (r >> 2) + 4 * hi; }
constexpr float AT_THR = 8.f;
__device__ __forceinline__ void attn_tile(const LAS unsigned char* kb, const LAS unsigned char* vb, const bf16x8 (&qr)[6], f32x16& o0, f32x16& o1, float& mref, float& lrun,
                                          int k0, int qrow, int qmin, int q31, int hi, bool first) {
    const float nm = -mref;
    f32x16 s0 = {nm, nm, nm, nm, nm, nm, nm, nm, nm, nm, nm, nm, nm, nm, nm, nm}, s1 = s0;
#pragma unroll
    for (int ks = 0; ks < 6; ++ks) {
        const bf16x8 a0 = *(const LAS bf16x8*)(kb + q31 * (AT_KP * 2) + ks * 32 + hi * 16);
        const bf16x8 a1 = *(const LAS bf16x8*)(kb + (32 + q31) * (AT_KP * 2) + ks * 32 + hi * 16);
        s0 = __builtin_amdgcn_mfma_f32_32x32x16_bf16(a0, qr[ks], s0, 0, 0, 0);
        s1 = __builtin_amdgcn_mfma_f32_32x32x16_bf16(a1, qr[ks], s1, 0, 0, 0);
    }
    v2u vf[4][4];
#pragma unroll
    for (int st = 0; st < 4; ++st) { const LAS unsigned char* v0p = vb + q31 * (AT_VP * 2) + (16 * st + 4 * hi) * 2;
        vf[st][0] = *(const LAS v2u*)(v0p); vf[st][1] = *(const LAS v2u*)(v0p + 16); vf[st][2] = *(const LAS v2u*)(v0p + 32 * (AT_VP * 2)); vf[st][3] = *(const LAS v2u*)(v0p + 32 * (AT_VP * 2) + 16); }
    if (k0 + 63 > qmin) {
#pragma unroll
        for (int r = 0; r < 16; ++r) { const int kv = k0 + crow16(r, hi); if (kv > qrow) s0[r] = -INFINITY; if (kv + 32 > qrow) s1[r] = -INFINITY; }
    }
    float mx = fmaxf(s0[0], s1[0]);
#pragma unroll
    for (int r = 1; r < 16; ++r) mx = fmaxf(mx, fmaxf(s0[r], s1[r]));
    { const auto rr = __builtin_amdgcn_permlane32_swap(__builtin_bit_cast(unsigned, mx), __builtin_bit_cast(unsigned, mx), false, false); mx = fmaxf(__builtin_bit_cast(float, rr[0]), __builtin_bit_cast(float, rr[1])); }
    if (first || __any(mx > AT_THR)) {
        const float dl = first ? mx : fmaxf(mx, 0.f), f = __builtin_amdgcn_exp2f(-dl); mref += dl; lrun *= f;
#pragma unroll
        for (int r = 0; r < 16; ++r) { s0[r] -= dl; s1[r] -= dl; o0[r] *= f; o1[r] *= f; }
    }
    float ps = 0.f;
#pragma unroll
    for (int r = 0; r < 16; ++r) { s0[r] = __builtin_amdgcn_exp2f(s0[r]); s1[r] = __builtin_amdgcn_exp2f(s1[r]); ps += s0[r] + s1[r]; }
    lrun += ps;
#pragma unroll
    for (int st = 0; st < 4; ++st) {
        v4u pw;
        if (st == 0) pw = (v4u){pk2(s0[0], s0[1]), pk2(s0[2], s0[3]), pk2(s0[4], s0[5]), pk2(s0[6], s0[7])};
        if (st == 1) pw = (v4u){pk2(s0[8], s0[9]), pk2(s0[10], s0[11]), pk2(s0[12], s0[13]), pk2(s0[14], s0[15])};
        if (st == 2) pw = (v4u){pk2(s1[0], s1[1]), pk2(s1[2], s1[3]), pk2(s1[4], s1[5]), pk2(s1[6], s1[7])};
        if (st == 3) pw = (v4u){pk2(s1[8], s1[9]), pk2(s1[10], s1[11]), pk2(s1[12], s1[13]), pk2(s1[14], s1[15])};
        const bf16x8 pb = __builtin_bit_cast(bf16x8, pw);
        o0 = __builtin_amdgcn_mfma_f32_32x32x16_bf16(__builtin_bit_cast(bf16x8, (v4u){vf[st][0].x, vf[st][0].y, vf[st][1].x, vf[st][1].y}), pb, o0, 0, 0, 0);
        o1 = __builtin_amdgcn_mfma_f32_32x32x16_bf16(__builtin_bit_cast(bf16x8, (v4u){vf[st][2].x, vf[st][2].y, vf[st][3].x, vf[st][3].y}), pb, o1, 0, 0, 0);
    }
}
__device__ __forceinline__ void attn_unit(const Bufs& B, const int* pos, int b, int h, int qb, LAS unsigned char* lds) {
    const int tid = otid(), lane = tid & 63, w = tid >> 6, q31 = lane & 31, hi = lane >> 5;
    const size_t rb = (size_t)b * SEQ; const int q0 = qb * 256, qmin = q0 + 32 * w, qrow = qmin + q31;
    bf16x8 qr[6];
    {
        v4u qv[6];
#pragma unroll
        for (int ks = 0; ks < 6; ++ks) qv[ks] = *(const v4u*)(B.Q() + (rb + qrow) * 768 + h * 96 + 16 * ks + 8 * hi);
        const float sc = 0.10206207261596577f * 1.4426950408889634f; const float posf = (float)pos[rb + qrow];
        float x1[8], x2[8];
        x1[0] = bflo(qv[4].x); x1[1] = bfhi(qv[4].x); x1[2] = bflo(qv[4].y); x1[3] = bfhi(qv[4].y); x1[4] = bflo(qv[4].z); x1[5] = bfhi(qv[4].z); x1[6] = bflo(qv[4].w); x1[7] = bfhi(qv[4].w);
        x2[0] = bflo(qv[5].x); x2[1] = bfhi(qv[5].x); x2[2] = bflo(qv[5].y); x2[3] = bfhi(qv[5].y); x2[4] = bflo(qv[5].z); x2[5] = bfhi(qv[5].z); x2[6] = bflo(qv[5].w); x2[7] = bfhi(qv[5].w);
#pragma unroll
        for (int j = 0; j < 8; ++j) { const float inv = __builtin_amdgcn_exp2f(-(float)(2 * (8 * hi + j)) * (13.287712379549449f / 32.f)); float sn, cs; fsincos(posf * inv, sn, cs);
            const float a = (x1[j] * cs - x2[j] * sn) * sc, b2 = (x2[j] * cs + x1[j] * sn) * sc; x1[j] = a; x2[j] = b2; }
#pragma unroll
        for (int ks = 0; ks < 4; ++ks) { const v4u v = qv[ks];
            qr[ks] = __builtin_bit_cast(bf16x8, (v4u){pk2(bflo(v.x) * sc, bfhi(v.x) * sc), pk2(bflo(v.y) * sc, bfhi(v.y) * sc), pk2(bflo(v.z) * sc, bfhi(v.z) * sc), pk2(bflo(v.w) * sc, bfhi(v.w) * sc)}); }
        qr[4] = __builtin_bit_cast(bf16x8, (v4u){pk2(x1[0], x1[1]), pk2(x1[2], x1[3]), pk2(x1[4], x1[5]), pk2(x1[6], x1[7])});
        qr[5] = __builtin_bit_cast(bf16x8, (v4u){pk2(x2[0], x2[1]), pk2(x2[2], x2[3]), pk2(x2[4], x2[5]), pk2(x2[6], x2[7])});
    }
    f32x16 o0 = {}, o1 = {}; float mrun = 0.f, lrun = 0.f;
    const int NT = (q0 + 256) / 64;
    const int kr_ = tid >> 3, kc = tid & 7;
    const int rr_ = (tid & 255) >> 2, rc = tid & 3;
    const bf16* kn_src = B.KN() + (rb + kr_) * 512 + h * 64 + kc * 8;
    const bf16* kr_src = B.KR() + (rb + rr_) * 32 + rc * 8;
    const bf16* vt_src = B.VT() + (size_t)(h * 64 + kr_) * VT_P + rb + kc * 8;
    const bool rope_thr = tid < 256;
    LAS unsigned char* const kw = lds + kr_ * (AT_KP * 2) + kc * 16; LAS unsigned char* const rw = lds + rr_ * (AT_KP * 2) + 128 + rc * 16; LAS unsigned char* const vw = lds + 2 * AT_KB + kr_ * (AT_VP * 2) + kc * 16;
#define AT_LOAD(t, gk, gr, gv) do { gk = *(const v4u*)(kn_src + (size_t)(t) * 64 * 512); if (rope_thr) gr = *(const v4u*)(kr_src + (size_t)(t) * 64 * 32); gv = *(const v4u*)(vt_src + (t) * 64); } while (0)
#define AT_STORE(buf, gk, gr, gv) do { *(LAS v4u*)(kw + (buf) * AT_KB) = gk; if (rope_thr) *(LAS v4u*)(rw + (buf) * AT_KB) = gr; *(LAS v2u*)(vw + (buf) * AT_VB) = (v2u){gv.x, gv.y}; *(LAS v2u*)(vw + (buf) * AT_VB + 8) = (v2u){gv.z, gv.w}; } while (0)
    v4u gkA, grA, gvA, gkB, grB, gvB;
    AT_LOAD(0, gkA, grA, gvA); AT_LOAD(1, gkB, grB, gvB);
    AT_STORE(0, gkA, grA, gvA);
    __syncthreads();
    for (int t = 0; t < NT; t += 2) {
        if (t + 2 < NT) AT_LOAD(t + 2, gkA, grA, gvA);
        if (64 * t <= qmin + 31) attn_tile(lds, lds + 2 * AT_KB, qr, o0, o1, mrun, lrun, 64 * t, qrow, qmin, q31, hi, t == 0);
        AT_STORE(1, gkB, grB, gvB);
        __syncthreads();
        if (t + 3 < NT) AT_LOAD(t + 3, gkB, grB, gvB);
        if (64 * (t + 1) <= qmin + 31) attn_tile(lds + AT_KB, lds + 2 * AT_KB + AT_VB, qr, o0, o1, mrun, lrun, 64 * (t + 1), qrow, qmin, q31, hi, false);
        if (t + 2 < NT) AT_STORE(0, gkA, grA, gvA);
        __syncthreads();
    }
#undef AT_LOAD
#undef AT_STORE
    lrun += sx(lrun, 32);
    const float il = 1.f / lrun;
    bf16* orow = B.YA() + (rb + qrow) * YCW + YC_C + h * 64;
#pragma unroll
    for (int g4 = 0; g4 < 4; ++g4) {
        const v2u a = {pk2(o0[4 * g4] * il, o0[4 * g4 + 1] * il), pk2(o0[4 * g4 + 2] * il, o0[4 * g4 + 3] * il)};
        const v2u c = {pk2(o1[4 * g4] * il, o1[4 * g4 + 1] * il), pk2(o1[4 * g4 + 2] * il, o1[4 * g4 + 3] * il)};
        *(v2u*)(orow + 8 * g4 + 4 * hi) = a; *(v2u*)(orow + 32 + 8 * g4 + 4 * hi) = c;
    }
}
__device__ __forceinline__ void attn_phase(const Bufs& B, int pass, LAS unsigned char* lds) {
    const int* pos = (const int*)kin()[1] + (size_t)pass * M;
    const int c = blockIdx.x;
    for (int u = c; u < 2 * 256; u += gridDim.x) {
        const int c8 = u & 255, second = u >> 8; const int cc = (c8 & 7) * 32 + (c8 >> 3);
        const int bh = cc >> 4, s = cc & 15;
        attn_unit(B, pos, bh >> 3, bh & 7, second ? 31 - s : s, lds);
    }
}

template <int N, int K, int J> struct BitonicDesc {
    static __device__ __forceinline__ void run(float (&v)[N]) {
#pragma unroll
        for (int i = 0; i < N; ++i) { const int l = i ^ J; if (l > i) { const bool desc = ((i & K) == 0) || (K == N); const float a = v[i], b = v[l]; const float mx = __builtin_fmaxf(a, b), mn = __builtin_fminf(a, b); v[i] = desc ? mx : mn; v[l] = desc ? mn : mx; } }
        if constexpr (J > 1) BitonicDesc<N, K, J / 2>::run(v); else if constexpr (K < N) BitonicDesc<N, 2 * K, K>::run(v);
    }
};
__device__ __forceinline__ void sort16_desc(float (&v)[16]) { BitonicDesc<16, 2, 1>::run(v); }
__device__ __forceinline__ void merge16_desc(float (&a)[16], const float (&b)[16]) {
#pragma unroll
    for (int i = 0; i < 16; ++i) a[i] = __builtin_fmaxf(a[i], b[15 - i]);
    BitonicDesc<16, 16, 8>::run(a);
}
__device__ __forceinline__ void xmerge16_desc(float (&a)[16]) {
    float o[16];
#pragma unroll
    for (int i = 0; i < 16; ++i) o[i] = sx(a[i], 32);
    merge16_desc(a, o);
}
constexpr int SK_P = 136, SEL_LDS = 2 * PK * SK_P * 2;
__device__ __forceinline__ void sel_phase(const Params& p, const Bufs& B, int l, LAS unsigned char* lds) {
    const int tid = otid(), lane = tid & 63, w = tid >> 6, n = lane & 31, hi = lane >> 5;
    const bf16* sk = (const bf16*)(wl_ptr(p, l) + WO_SK);
    for (int i = tid; i < 2 * PK * 16; i += NTHR) { const int row = i >> 4, ch = i & 15; *(LAS v4u*)(lds + row * (SK_P * 2) + ch * 16) = *(const v4u*)(sk + row * 128 + ch * 8); }
    __syncthreads();
    for (int task = blockIdx.x * NWAVES + w; task < M * 8 / 32; task += gridDim.x * NWAVES) {
        const int pair = task * 32 + n, t = pair >> 3, h = pair & 7;
        const bf16* qrow = B.PQ() + (size_t)t * 2048 + h * 256;
        float a0[16], a1[16];
#pragma unroll
        for (int j = 0; j < 2; ++j) {
            bf16x8 qf[8];
#pragma unroll
            for (int ks = 0; ks < 8; ++ks) qf[ks] = *(const bf16x8*)(qrow + j * 128 + 16 * ks + 8 * hi);
            float run[16];
#pragma unroll
            for (int kb = 0; kb < 4; ++kb) { f32x16 acc = {};
#pragma unroll
                for (int ks = 0; ks < 8; ++ks) { const bf16x8 A = *(const LAS bf16x8*)(lds + ((j * PK + kb * 32 + n) * SK_P + 16 * ks + 8 * hi) * 2); acc = __builtin_amdgcn_mfma_f32_32x32x16_bf16(A, qf[ks], acc, 0, 0, 0); }
                float v[16];
#pragma unroll
                for (int r = 0; r < 16; ++r) v[r] = bitsf((fbits(acc[r]) & ~127u) | (unsigned)(kb * 32 + (r & 3) + 8 * (r >> 2) + 4 * hi));
                sort16_desc(v);
                if (kb == 0) {
#pragma unroll
                    for (int i = 0; i < 16; ++i) run[i] = v[i]; }
                else merge16_desc(run, v);
                asm volatile("" ::: "memory");
            }
            xmerge16_desc(run);
#pragma unroll
            for (int i = 0; i < 16; ++i) { if (j == 0) a0[i] = run[i]; else a1[i] = run[i]; }
        }
        unsigned k0[16], k1[16];
#pragma unroll
        for (int i = 0; i < 16; ++i) { k0[i] = (fbits(a0[i]) & 127u) << 7; k1[i] = fbits(a1[i]) & 127u; }
        float cc[32];
#pragma unroll
        for (int s_ = 0; s_ < 32; ++s_) cc[s_] = -INFINITY;
        {
            int cnt = 0;
#pragma unroll
            for (int i = 0; i < 16; ++i)
#pragma unroll
                for (int j = 0; j < 16; ++j) if ((i + 1) * (j + 1) <= 16) {
                    const float vv = bitsf((fbits(a0[i] + a1[j]) & ~0x3FFFu) | k0[i] | k1[j]);
                    if ((cnt & 1) == 0) { cc[cnt >> 1] = hi ? cc[cnt >> 1] : vv; } else { cc[cnt >> 1] = hi ? vv : cc[cnt >> 1]; }
                    ++cnt; }
        }
        float c0[16], c1[16];
#pragma unroll
        for (int i = 0; i < 16; ++i) { c0[i] = cc[i]; c1[i] = cc[16 + i]; }
        sort16_desc(c0); sort16_desc(c1); merge16_desc(c0, c1); xmerge16_desc(c0);
        const float m0 = bitsf(fbits(c0[0]) & ~0x3FFFu);
        float e[16]; float sum = 0.f;
#pragma unroll
        for (int i = 0; i < 16; ++i) { e[i] = __builtin_amdgcn_exp2f((bitsf(fbits(c0[i]) & ~0x3FFFu) - m0) * 1.4426950408889634f); sum += e[i]; }
        const float inv = 1.f / sum;
        v4u ia, ib; f32x4 ga, gb; const unsigned hm = 0u - (unsigned)hi;
#define SELH(a, b) ((fbits((a)) & ~hm) | (fbits((b)) & hm))
#pragma unroll
        for (int q = 0; q < 4; ++q) { ia[q] = SELH(c0[q], c0[8 + q]) & 0x3FFFu; ib[q] = SELH(c0[4 + q], c0[12 + q]) & 0x3FFFu;
            ga[q] = bitsf(SELH(e[q], e[8 + q])) * inv; gb[q] = bitsf(SELH(e[4 + q], e[12 + q])) * inv; }
#undef SELH
        const size_t ob = (size_t)t * 128 + h * 16 + 8 * hi;
        *(v4u*)(B.IDX() + ob) = ia; *(v4u*)(B.IDX() + ob + 4) = ib; *(f32x4*)(B.GW() + ob) = ga; *(f32x4*)(B.GW() + ob + 4) = gb;
    }
}

__device__ __forceinline__ float ub0(unsigned w) { return (float)(w & 0xffu); }
__device__ __forceinline__ float ub1(unsigned w) { return (float)((w >> 8) & 0xffu); }
__device__ __forceinline__ float ub2(unsigned w) { return (float)((w >> 16) & 0xffu); }
__device__ __forceinline__ float ub3(unsigned w) { return (float)(w >> 24); }
constexpr int EXP_LDS = NWAVES * 8 * 128 * 4;
__device__ __forceinline__ void exp_sort128(unsigned& k0, unsigned& k1, int lane) {
#pragma unroll
    for (int k = 2; k <= 128; k <<= 1) {
#pragma unroll
        for (int j = k >> 1; j > 0; j >>= 1) {
            if (j == 64) { const unsigned lo = k0 < k1 ? k0 : k1, hi = k0 < k1 ? k1 : k0; k0 = lo; k1 = hi; }
            else {
                const unsigned p0 = (unsigned)__builtin_amdgcn_ds_bpermute(((lane ^ j) << 2), (int)k0), p1 = (unsigned)__builtin_amdgcn_ds_bpermute(((lane ^ j) << 2), (int)k1);
                const bool upper = (lane & j) != 0;
                const bool asc0 = (k == 128) ? true : ((lane & k) == 0), asc1 = (k == 128) ? true : (((64 + lane) & k) == 0);
                const unsigned mn0 = k0 < p0 ? k0 : p0, mx0 = k0 < p0 ? p0 : k0, mn1 = k1 < p1 ? k1 : p1, mx1 = k1 < p1 ? p1 : k1;
                k0 = (upper == asc0) ? mx0 : mn0; k1 = (upper == asc1) ? mx1 : mn1;
            }
        }
    }
}
__device__ __forceinline__ void exp_u_group(const unsigned char* TU, int idsel, float gwsel, float susel, float svsel, const v4u& xq, int g, LAS float* crow, int lane) {
    v4u U[8];
#pragma unroll
    for (int e = 0; e < 8; ++e) { const int idk = __builtin_amdgcn_readlane(idsel, (8 * g + e) & 63); U[e] = *(const v4u*)(TU + (size_t)idk * D + 16 * lane); }
    int sd[8];
#pragma unroll
    for (int e = 0; e < 8; ++e) { int a = 0; a = __builtin_amdgcn_sdot4((int)U[e].x, (int)xq.x, a, false); a = __builtin_amdgcn_sdot4((int)U[e].y, (int)xq.y, a, false);
        a = __builtin_amdgcn_sdot4((int)U[e].z, (int)xq.z, a, false); a = __builtin_amdgcn_sdot4((int)U[e].w, (int)xq.w, a, false); sd[e] = a; }
    const bool hi = lane >= 32, b4 = (lane >> 4) & 1, b3 = (lane >> 3) & 1;
    float r[4];
#pragma unroll
    for (int q = 0; q < 4; ++q) { const float keep = (float)(hi ? sd[4 + q] : sd[q]), send = (float)(hi ? sd[q] : sd[4 + q]); r[q] = keep + sx(send, 32); }
    const float r0 = (b4 ? r[2] : r[0]) + sx(b4 ? r[0] : r[2], 16), r1 = (b4 ? r[3] : r[1]) + sx(b4 ? r[1] : r[3], 16);
    float qv = (b3 ? r1 : r0) + sx(b3 ? r0 : r1, 8);
    qv += sx(qv, 4); qv += sx(qv, 2); qv += sx(qv, 1);
    const int src = (8 * g + (lane >> 3)) & 63;
    const float ck = sl(gwsel, src) * gelu_t(qv * sl(susel, src)) * sl(svsel, src);
    if ((lane & 7) == 0) crow[8 * g + (lane >> 3)] = ck;
}
__device__ __forceinline__ void exp_v_group(const unsigned char* TV, int idsel, float csel, int g, f32x2 (&o)[8], int lane) {
    v4u V[8];
#pragma unroll
    for (int e = 0; e < 8; ++e) { const int idk = __builtin_amdgcn_readlane(idsel, (8 * g + e) & 63); V[e] = *(const v4u*)(TV + (size_t)idk * D + 16 * lane); }
#pragma unroll
    for (int e = 0; e < 8; ++e) { const float a = __builtin_bit_cast(float, __builtin_amdgcn_readlane(__builtin_bit_cast(int, csel), (8 * g + e) & 63));
        const f32x2 a2 = {a, a};
#pragma unroll
        for (int q = 0; q < 4; ++q) { const int wq = (int)V[e][q];
            o[2 * q] = __builtin_elementwise_fma(a2, __builtin_amdgcn_cvt_pk_f32_fp8(wq, false), o[2 * q]);
            o[2 * q + 1] = __builtin_elementwise_fma(a2, __builtin_amdgcn_cvt_pk_f32_fp8(wq, true), o[2 * q + 1]); } }
}
__device__ __forceinline__ void exp_phase(const Params& p, const Bufs& B, int l, int pass, int final_, bool dry, LAS unsigned char* lds) {
    const int tid = otid(), lane = tid & 63, w = tid >> 6;
    LAS float* cbuf = (LAS float*)(lds + w * (8 * 128 * 4));
    const int gw_ = blockIdx.x * NWAVES + w, ngw_ = gridDim.x * NWAVES;
    const unsigned char* TU = B.TABU() + (size_t)l * PE * D; const unsigned char* TV = B.TABV() + (size_t)l * PE * D;
    for (int tb_ = gw_; tb_ < M; tb_ += 8 * ngw_) {
        int id0[8], id1[8];
        {
            const float* SUl = B.SU() + l * PE; const float* SVl = B.SV() + l * PE;
            float g0[8], g1[8], su0[8], su1[8], sv0[8], sv1[8]; v4u xq[8];
#pragma unroll
            for (int j = 0; j < 8; ++j) { const int t = min(tb_ + j * ngw_, M - 1);
                const bf16* hrow = B.HB() + ((size_t)pass * M + t) * D;
                const v4u xa = *(const v4u*)(hrow + 16 * lane), xb = *(const v4u*)(hrow + 16 * lane + 8);
                const float xf[16] = {bflo(xa.x), bfhi(xa.x), bflo(xa.y), bfhi(xa.y), bflo(xa.z), bfhi(xa.z), bflo(xa.w), bfhi(xa.w), bflo(xb.x), bfhi(xb.x), bflo(xb.y), bfhi(xb.y), bflo(xb.z), bfhi(xb.z), bflo(xb.w), bfhi(xb.w)};
                float am = 0.f;
#pragma unroll
                for (int i = 0; i < 16; ++i) am = fmaxf(am, fabsf(xf[i]));
#pragma unroll
                for (int o_ = 32; o_ > 0; o_ >>= 1) am = fmaxf(am, sx(am, o_));
                const float sxs = am > 0.f ? am * (1.f / 127.f) : 1.f, xinv = 1.f / sxs;
#pragma unroll
                for (int q = 0; q < 4; ++q) { unsigned wv = 0u;
#pragma unroll
                    for (int e = 0; e < 4; ++e) wv |= ((unsigned)(int)rintf(xf[4 * q + e] * xinv) & 0xffu) << (8 * e);
                    xq[j][q] = wv; }
                const int ia = B.IDX()[(size_t)t * 128 + lane], ib = B.IDX()[(size_t)t * 128 + 64 + lane];
                const float ga = B.GW()[(size_t)t * 128 + lane], gb = B.GW()[(size_t)t * 128 + 64 + lane];
                unsigned k0 = ((unsigned)ia << 7) | (unsigned)lane, k1 = ((unsigned)ib << 7) | (unsigned)(64 + lane);
                exp_sort128(k0, k1, lane);
                id0[j] = (int)(k0 >> 7); id1[j] = (int)(k1 >> 7);
                const int s0 = (int)(k0 & 127u), s1 = (int)(k1 & 127u);
                const float a0 = sl(ga, s0 & 63), b0 = sl(gb, s0 & 63), a1 = sl(ga, s1 & 63), b1 = sl(gb, s1 & 63);
                g0[j] = s0 < 64 ? a0 : b0; g1[j] = s1 < 64 ? a1 : b1;
                su0[j] = SUl[id0[j]] * sxs; su1[j] = SUl[id1[j]] * sxs; sv0[j] = SVl[id0[j]]; sv1[j] = SVl[id1[j]]; }
            for (int g = 0; g < 16; ++g) {
#pragma unroll
                for (int j = 0; j < 8; ++j) exp_u_group(TU, g < 8 ? id0[j] : id1[j], g < 8 ? g0[j] : g1[j], g < 8 ? su0[j] : su1[j], g < 8 ? sv0[j] : sv1[j], xq[j], g, cbuf + j * 128, lane);
            }
        }
        LDS_WAIT(); asm volatile("" ::: "memory");
        const float* g2 = kin()[34] + l * D; const float* b2 = kin()[35] + l * D;
        { constexpr int hr = 0;
            float c0[8], c1[8]; f32x2 o[8][8];
#pragma unroll
            for (int jj = 0; jj < 8; ++jj) { c0[jj] = cbuf[(4 * hr + jj) * 128 + lane]; c1[jj] = cbuf[(4 * hr + jj) * 128 + 64 + lane];
#pragma unroll
                for (int i = 0; i < 8; ++i) o[jj][i] = (f32x2){0.f, 0.f}; }
            for (int g = 0; g < 16; ++g) {
#pragma unroll
                for (int jj = 0; jj < 8; ++jj) exp_v_group(TV, g < 8 ? id0[4 * hr + jj] : id1[4 * hr + jj], g < 8 ? c0[jj] : c1[jj], g, o[jj], lane);
            }
#pragma unroll
            for (int jj = 0; jj < 8; ++jj) { const int t = tb_ + (4 * hr + jj) * ngw_;
                if (t < M) {
                    bf16* hrow = B.HB() + ((size_t)pass * M + t) * D;
                    const v4u xa = *(const v4u*)(hrow + 16 * lane), xb = *(const v4u*)(hrow + 16 * lane + 8);
                    const float xg[16] = {bflo(xa.x), bfhi(xa.x), bflo(xa.y), bfhi(xa.y), bflo(xa.z), bfhi(xa.z), bflo(xa.w), bfhi(xa.w), bflo(xb.x), bfhi(xb.x), bflo(xb.y), bfhi(xb.y), bflo(xb.z), bfhi(xb.z), bflo(xb.w), bfhi(xb.w)};
                    float y[16]; float sm = 0.f;
#pragma unroll
                    for (int i = 0; i < 16; ++i) { y[i] = ALPHA * xg[i] + o[jj][i >> 1][i & 1]; sm += y[i]; }
                    const float mu = wsum(sm) * (1.f / D); float sq = 0.f;
#pragma unroll
                    for (int i = 0; i < 16; ++i) { y[i] -= mu; sq += y[i] * y[i]; }
                    const float rs = __builtin_amdgcn_rsqf(wsum(sq) * (1.f / D) + 1e-5f);
                    const int c0_ = 16 * lane; f32x4 yo[4];
#pragma unroll
                    for (int q = 0; q < 4; ++q) { const f32x4 ga = *(const f32x4*)(g2 + c0_ + 4 * q), ba = *(const f32x4*)(b2 + c0_ + 4 * q);
#pragma unroll
                        for (int e = 0; e < 4; ++e) yo[q][e] = y[4 * q + e] * rs * ga[e] + ba[e]; }
                    if (dry) { if (yo[0][0] == 12345.678f) B.TS()[t] = yo[1][1] + yo[2][2] + yo[3][3]; }
                    else {
                        *(v4u*)(hrow + c0_) = (v4u){pk2(yo[0][0], yo[0][1]), pk2(yo[0][2], yo[0][3]), pk2(yo[1][0], yo[1][1]), pk2(yo[1][2], yo[1][3])};
                        *(v4u*)(hrow + c0_ + 8) = (v4u){pk2(yo[2][0], yo[2][1]), pk2(yo[2][2], yo[2][3]), pk2(yo[3][0], yo[3][1]), pk2(yo[3][2], yo[3][3])};
                        if (final_) { float* orow = p.out + ((size_t)pass * M + t) * D + c0_;
#pragma unroll
                            for (int q = 0; q < 4; ++q) *(f32x4*)(orow + 4 * q) = yo[q]; } }
                }
            }
        }
        LDS_WAIT(); asm volatile("" ::: "memory");
    }
    __syncthreads();
}

__device__ __forceinline__ void rms_phase(const Params& p, const Bufs& B, int l, int pass) {
    const int lane = otid() & 63, w = otid() >> 6;
    const float* gq = kin()[20] + l * QR; const float* gk = kin()[22] + l * KVR;
    const f32x4 g4 = *(const f32x4*)(gq + 4 * lane); const f32x2 k2 = *(const f32x2*)(gk + 2 * lane);
    const int* posr = (const int*)kin()[1] + (size_t)pass * M;
    for (int t = blockIdx.x * NWAVES + w; t < M; t += gridDim.x * NWAVES) {
        const bf16* pr = B.PROJ() + (size_t)t * PROJW;
        const v2u q = *(const v2u*)(pr + O_CQ + 4 * lane); const unsigned k = *(const unsigned*)(pr + O_CKV + 2 * lane);
        const float q0 = bflo(q.x), q1 = bfhi(q.x), q2 = bflo(q.y), q3 = bfhi(q.y), k0 = bflo(k), k1 = bfhi(k);
        const float rq = __builtin_amdgcn_rsqf(wsum(q0 * q0 + q1 * q1 + q2 * q2 + q3 * q3) * (1.f / QR) + 1e-6f), rk = __builtin_amdgcn_rsqf(wsum(k0 * k0 + k1 * k1) * (1.f / KVR) + 1e-6f);
        *(v2u*)(B.CQN() + (size_t)t * 256 + 4 * lane) = (v2u){pk2(q0 * rq * g4[0], q1 * rq * g4[1]), pk2(q2 * rq * g4[2], q3 * rq * g4[3])};
        *(unsigned*)(B.CKVN() + (size_t)t * 256 + 2 * lane) = pk2(k0 * rk * k2[0], k1 * rk * k2[1]);
        *(unsigned*)(B.CKVN() + (size_t)t * 256 + 128 + 2 * lane) = 0u;
        if (lane < 16) {
            const float inv = __builtin_amdgcn_exp2f(-(float)(2 * lane) * (13.287712379549449f / 32.f)); float sn, cs; fsincos((float)posr[t] * inv, sn, cs);
            const float k1 = bf2f(pr[O_KR + lane]), k2r = bf2f(pr[O_KR + 16 + lane]);
            B.KR()[(size_t)t * 32 + lane] = (bf16)f2bf(k1 * cs - k2r * sn); B.KR()[(size_t)t * 32 + 16 + lane] = (bf16)f2bf(k2r * cs + k1 * sn); }
    }
}
__device__ __forceinline__ void ln1_phase(const Params& p, const Bufs& B, int l, int pass) {
    const int lane = otid() & 63, w = otid() >> 6;
    const float* g1 = kin()[28] + l * D; const float* b1 = kin()[29] + l * D;
    for (int t = blockIdx.x * NWAVES + w; t < M; t += gridDim.x * NWAVES) {
        bf16* hrow = B.HB() + ((size_t)pass * M + t) * D; const float* mrow = B.F32() + (size_t)t * D;
        const v4u x0 = *(const v4u*)(hrow + 8 * lane), x1 = *(const v4u*)(hrow + 512 + 8 * lane);
        const f32x4 m0 = *(const f32x4*)(mrow + 8 * lane), m1 = *(const f32x4*)(mrow + 8 * lane + 4), m2 = *(const f32x4*)(mrow + 512 + 8 * lane), m3 = *(const f32x4*)(mrow + 512 + 8 * lane + 4);
        float y[16]; float sm = 0.f;
        y[0] = ALPHA * bflo(x0.x) + m0[0]; y[1] = ALPHA * bfhi(x0.x) + m0[1]; y[2] = ALPHA * bflo(x0.y) + m0[2]; y[3] = ALPHA * bfhi(x0.y) + m0[3];
        y[4] = ALPHA * bflo(x0.z) + m1[0]; y[5] = ALPHA * bfhi(x0.z) + m1[1]; y[6] = ALPHA * bflo(x0.w) + m1[2]; y[7] = ALPHA * bfhi(x0.w) + m1[3];
        y[8] = ALPHA * bflo(x1.x) + m2[0]; y[9] = ALPHA * bfhi(x1.x) + m2[1]; y[10] = ALPHA * bflo(x1.y) + m2[2]; y[11] = ALPHA * bfhi(x1.y) + m2[3];
        y[12] = ALPHA * bflo(x1.z) + m3[0]; y[13] = ALPHA * bfhi(x1.z) + m3[1]; y[14] = ALPHA * bflo(x1.w) + m3[2]; y[15] = ALPHA * bfhi(x1.w) + m3[3];
#pragma unroll
        for (int i = 0; i < 16; ++i) sm += y[i];
        const float mu = wsum(sm) * (1.f / D); float sq = 0.f;
#pragma unroll
        for (int i = 0; i < 16; ++i) { y[i] -= mu; sq += y[i] * y[i]; }
        const float rs = __builtin_amdgcn_rsqf(wsum(sq) * (1.f / D) + 1e-5f);
#pragma unroll
        for (int hf = 0; hf < 2; ++hf) { const int c0 = hf * 512 + 8 * lane;
            const f32x4 ga = *(const f32x4*)(g1 + c0), gb = *(const f32x4*)(g1 + c0 + 4), ba = *(const f32x4*)(b1 + c0), bb = *(const f32x4*)(b1 + c0 + 4);
            f32x4 ya, yb;
#pragma unroll
            for (int q = 0; q < 4; ++q) { ya[q] = y[hf * 8 + q] * rs * ga[q] + ba[q]; yb[q] = y[hf * 8 + 4 + q] * rs * gb[q] + bb[q]; }
            *(v4u*)(hrow + c0) = (v4u){pk2(ya[0], ya[1]), pk2(ya[2], ya[3]), pk2(yb[0], yb[1]), pk2(yb[2], yb[3])}; }
    }
}

constexpr int LDS_BYTES = 147456, MISC_OFF = LDS_BYTES - 128;
constexpr int CW_BAR = 4096;
static_assert(EXP_LDS <= MISC_OFF && S5_LDS <= MISC_OFF && XC_LDS <= MISC_OFF && SEL_LDS <= MISC_OFF && S3_LDS <= MISC_OFF && AT_LDS <= MISC_OFF && 131072 <= MISC_OFF && (CW_BAR + XCD_BAR_WORDS) * 4 <= (int)CTL_ZERO_BYTES, "LDS / control map");
constexpr int NPH_LAYER = 11, NPH = 1 + DEPTH * NPASS * NPH_LAYER;
__global__ void __launch_bounds__(NTHR, 2) mega(Params p, int ph_lo, int ph_hi, int sub) {
    extern __shared__ __attribute__((aligned(16))) unsigned char lds_raw[];
    LAS unsigned char* lds = (LAS unsigned char*)lds_raw;
    const Bufs B = make_bufs(p);
    const int tid = threadIdx.x, bid = blockIdx.x, G = gridDim.x;
    volatile LAS unsigned* MISC = (volatile LAS unsigned*)(lds + MISC_OFF);
    if (tid < 32) MISC[tid] = 0u;
    __syncthreads();
    XcdBarrier bar; bar.bar = (unsigned*)(p.ws + WS_CTL) + CW_BAR; bar.x = 0; bar.st = MISC + 8;
    if (ph_hi - ph_lo > 1) bar = xcd_barrier_post((unsigned*)(p.ws + WS_CTL) + CW_BAR, MISC + 8);
    int ph = 0;
#define OPQ(x) asm volatile("" : "+s"(x) :: "memory")
#ifndef PHMASK
#define PHMASK 0xFFF
#endif
#define PH_EN(b) (((PHMASK) >> (b)) & 1)
#ifndef DUPMASK
#define DUPMASK 0
#endif
#define REP(k) for (int rep_ = 0; rep_ < 1 + (((DUPMASK) >> (k)) & 1); ++rep_)
#define RUN(k) (ph_lo <= (k) && (k) < ph_hi)
#define SEAM(k) do { if (RUN(k) && RUN((k) + 1)) { xcd_barrier(bar); } } while (0)
    if (PH_EN(0) && RUN(ph)) { prologue_phase(p, B, lds); tables_phase(p, B); s5_tables_phase(p); }
    SEAM(ph); ++ph;
    for (int l = 0; l < DEPTH; ++l) {
        for (int pass = 0; pass < NPASS; ++pass) {
            if (PH_EN(1) && RUN(ph)) REP(1) { gemm_ph<G_PROJ>(p, B, l, pass, bid, lds); }
            SEAM(ph); ++ph;
            if (PH_EN(2) && RUN(ph)) REP(2) { if (sub & 1) s5a_phase(p, B, l, lds); if (sub & 2) xc_phase(p, B, l, lds); if (sub & 4) rms_phase(p, B, l, pass); }
            SEAM(ph); ++ph;
            if (PH_EN(3) && RUN(ph)) REP(3) { if (rep_ == 0 && (sub & 1)) s5scan_phase(p, B, l, bid * NTHR + otid(), G * NTHR); if (sub & 2) ssd1_phase(B);
                if (sub & 4) { int c0 = bid; OPQ(c0); gemm_ph<G_Q>(p, B, l, pass, c0, lds); int c1 = (bid + 64) % G; OPQ(c1); gemm_ph<G_KN>(p, B, l, pass, c1, lds); int c2 = (bid + G - 64) % G; OPQ(c2); gemm_ph<G_VT>(p, B, l, pass, c2, lds); } }
            SEAM(ph); ++ph;
            if (PH_EN(4) && RUN(ph)) REP(4) { if (sub & 1) ssd2_phase(B, bid * NTHR + otid(), G * NTHR); if (sub & 4) s5b_phase(p, B, l, lds); }
            SEAM(ph); ++ph;
            if (PH_EN(5) && RUN(ph)) REP(5) { if (sub & 1) attn_phase(B, pass, lds); int lq = l; OPQ(lq); if (sub & 2) ssd3_phase(p, B, lq, lds); int c0 = (bid + 128) % G; OPQ(c0); if (sub & 4) gemm_ph<G_GLU>(p, B, l, pass, c0, lds); }
            SEAM(ph); ++ph;
            if (PH_EN(6) && RUN(ph)) REP(6) { gemm_ph<G_M0>(p, B, l, pass, bid, lds); }
            SEAM(ph); ++ph;
            if (PH_EN(7) && RUN(ph)) REP(7) gemm_ph<G_OUT>(p, B, l, pass, bid, lds);
            SEAM(ph); ++ph;
            if (PH_EN(8) && RUN(ph)) ln1_phase(p, B, l, pass);
            SEAM(ph); ++ph;
            if (PH_EN(9) && RUN(ph)) REP(9) gemm_ph<G_PQ>(p, B, l, pass, bid, lds);
            SEAM(ph); ++ph;
            if (PH_EN(10) && RUN(ph)) REP(10) sel_phase(p, B, l, lds);
            SEAM(ph); ++ph;
            if (PH_EN(11) && RUN(ph)) REP(11) exp_phase(p, B, l, pass, l == DEPTH - 1 ? 1 : 0, rep_ != 0, lds);
            SEAM(ph); ++ph;
        }
    }
#undef RUN
#undef SEAM
}

#ifndef MK_SPLIT
#define MK_SPLIT 0
#endif
extern "C" void kernel_launch(void* const* d_in, const int* in_sizes, int n_in, void* d_out, int out_size, void* d_ws, size_t ws_size, hipStream_t stream) {
    if (n_in != 36 || ws_size < WS_END || out_size != NB * SEQ * D) { fprintf(stderr, "kernel_launch: unexpected sizes (n_in %d, ws %zu, out %d)\n", n_in, ws_size, out_size); return; }
    static int grid = 0;
    if (grid == 0) {
        int dev = 0, cus = 0, per_cu = 0;
        if (hipGetDevice(&dev) != hipSuccess || hipDeviceGetAttribute(&cus, hipDeviceAttributeMultiprocessorCount, dev) != hipSuccess) { fprintf(stderr, "kernel_launch: device query failed\n"); grid = -1; return; }
        if (hipFuncSetAttribute((const void*)mega, hipFuncAttributeMaxDynamicSharedMemorySize, LDS_BYTES) != hipSuccess) { fprintf(stderr, "kernel_launch: hipFuncSetAttribute failed\n"); grid = -1; return; }
        if (hipOccupancyMaxActiveBlocksPerMultiprocessor(&per_cu, (const void*)mega, NTHR, LDS_BYTES) != hipSuccess || per_cu < 1) fprintf(stderr, "kernel_launch: note: occupancy query reports %d workgroups per CU\n", per_cu);
        (void)hipGetLastError();
        grid = cus;
    }
    if (grid < 0) return;
    Params p{};
    for (int i = 0; i < 36; ++i) p.in[i] = (const float*)d_in[i];
    p.out = (float*)d_out; p.ws = (unsigned char*)d_ws;
    (void)hipMemsetAsync((char*)d_ws + WS_CTL, 0, CTL_ZERO_BYTES, stream);
#ifdef PROBE_PRE
    for (int r = 0; r < PROBE_REP; ++r) hipLaunchKernelGGL(mega, dim3(grid), dim3(NTHR), LDS_BYTES, stream, p, NPH - NPH_LAYER + (PROBE_PRE), NPH - NPH_LAYER + (PROBE_PRE) + 1, PROBE_SUB);
#endif
#if MK_SPLIT
    for (int k = 0; k < NPH; ++k) hipLaunchKernelGGL(mega, dim3(grid), dim3(NTHR), LDS_BYTES, stream, p, k, k + 1, -1);
#else
    hipLaunchKernelGGL(mega, dim3(grid), dim3(NTHR), LDS_BYTES, stream, p, 0, NPH, -1);
#endif
#ifdef PROBE_ABS
    for (int r = 0; r < PROBE_REP; ++r) hipLaunchKernelGGL(mega, dim3(grid), dim3(NTHR), LDS_BYTES, stream, p, PROBE_ABS, PROBE_ABS + 1, -1);
#endif
#ifdef PROBE_PH
    for (int r = 0; r < PROBE_REP; ++r) hipLaunchKernelGGL(mega, dim3(grid), dim3(NTHR), LDS_BYTES, stream, p, NPH - NPH_LAYER + (PROBE_PH), NPH - NPH_LAYER + (PROBE_PH) + 1, PROBE_SUB);
#endif
}
```
